# Optimizing an MI355X kernel written in HIP

```python
import jax, jax.numpy as jnp
from jax import lax
import numpy as np

D_MODEL = 1024
BATCH = 16
SEQ = 2048
DEPTH = 2

N_MIXERS = 2
N_MLA_LAYERS = (DEPTH + N_MIXERS - 1) // N_MIXERS
N_RNN_LAYERS = DEPTH // N_MIXERS

N_HEADS = 16
Q_LORA = 384
KV_LORA = 256
QK_NOPE = 64
QK_ROPE = 32
QK_HEAD = QK_NOPE + QK_ROPE
V_HEAD = 64
ROPE_THETA = 10000.0
Q_BLOCK = 128

D_RNN = D_MODEL
RNN_BLOCKS = 4
RNN_BW = D_RNN // RNN_BLOCKS
CONV_W = 4
LRU_C = 8.0

N_EXPERTS = 32
N_GROUPS = 8
EXPERTS_PER_GROUP = N_EXPERTS // N_GROUPS
TOP_K = 2
D_EXPERT = 512
MOE_BLOCK = 128

EPS = 1e-6

kernel_name = "hybrid_mla_rglru_grouped_moe_adaln"


def rmsnorm(x, g):
    xf = x.astype(jnp.float32)
    y = xf * lax.rsqrt(jnp.mean(xf * xf, axis=-1, keepdims=True) + EPS)
    return (y * g.astype(jnp.float32)).astype(x.dtype)


def modulate(x, g, shift, scale):
    return rmsnorm(x, g) * (1 + scale[:, None, :]) + shift[:, None, :]


def rope(x, cos, sin):
    x1, x2 = jnp.split(x, 2, axis=-1)
    c = cos.astype(x.dtype)
    s = sin.astype(x.dtype)
    return jnp.concatenate([x1 * c - x2 * s, x1 * s + x2 * c], axis=-1)


def mla_mixer(h, cos, sin, w_in, q_a_norm, kv_a_norm, w_q_b, w_kv_b, q_norm, k_norm, w_o):
    B, S, _ = h.shape
    lat = h @ w_in
    q_lat, kv_lat, k_pe = jnp.split(lat, [Q_LORA, Q_LORA + KV_LORA], axis=-1)
    q = (rmsnorm(q_lat, q_a_norm) @ w_q_b).reshape(B, S, N_HEADS, QK_HEAD)
    kv = (rmsnorm(kv_lat, kv_a_norm) @ w_kv_b).reshape(B, S, N_HEADS, QK_NOPE + V_HEAD)
    k_nope, v = jnp.split(kv, [QK_NOPE], axis=-1)
    k = jnp.concatenate([k_nope, jnp.broadcast_to(k_pe[:, :, None, :], (B, S, N_HEADS, QK_ROPE))], axis=-1)
    q = rmsnorm(q, q_norm)
    k = rmsnorm(k, k_norm)
    c4 = cos[:, :, None, :]
    s4 = sin[:, :, None, :]
    q = jnp.concatenate([q[..., :QK_NOPE], rope(q[..., QK_NOPE:], c4, s4)], axis=-1)
    k = jnp.concatenate([k[..., :QK_NOPE], rope(k[..., QK_NOPE:], c4, s4)], axis=-1)
    scale = QK_HEAD ** -0.5
    nqb = S // Q_BLOCK
    qb = q.reshape(B, nqb, Q_BLOCK, N_HEADS, QK_HEAD).transpose(1, 0, 2, 3, 4)

    def attend(q_blk):
        s = jnp.einsum('bqhd,bkhd->bhqk', q_blk, k, preferred_element_type=jnp.float32) * scale
        p = jax.nn.softmax(s, axis=-1).astype(v.dtype)
        return jnp.einsum('bhqk,bkhd->bqhd', p, v)

    o = lax.map(attend, qb)
    o = o.transpose(1, 0, 2, 3, 4).reshape(B, S, N_HEADS * V_HEAD)
    return o @ w_o


def dwconv_centred(x, w, b):
    S = x.shape[1]
    left = CONV_W // 2
    xp = jnp.pad(x, ((0, 0), (left, CONV_W - 1 - left), (0, 0)))
    return sum(xp[:, k:k + S] * w[k] for k in range(CONV_W)) + b


def block_diag(x, w, b):
    B, S, _ = x.shape
    xb = x.reshape(B, S, RNN_BLOCKS, RNN_BW)
    return jnp.einsum('bsnd,nde->bsne', xb, w).reshape(B, S, D_RNN) + b


def _lru_combine(e1, e2):
    a1, b1 = e1
    a2, b2 = e2
    return a1 * a2, a2 * b1 + b2


def lru_scan(xc, lam, w_r, b_r, w_i, b_i, reverse):
    f32 = jnp.float32
    r = jax.nn.sigmoid(block_diag(xc, w_r, b_r).astype(f32))
    i = jax.nn.sigmoid(block_diag(xc, w_i, b_i).astype(f32))
    log_a = -LRU_C * r * jax.nn.softplus(-lam.astype(f32))
    a = jnp.exp(log_a)
    mult = jnp.sqrt(-jnp.expm1(2.0 * log_a))
    S = xc.shape[1]
    first = (jnp.arange(S) == (S - 1 if reverse else 0))[None, :, None]
    mult = jnp.where(first, 1.0, mult)
    bx = mult * i * xc.astype(f32)
    _, hs = lax.associative_scan(_lru_combine, (a, bx), reverse=reverse, axis=1)
    return hs


def rglru_mixer(h, w_in, conv_w, conv_b, lam_f, w_rf, b_rf, w_if, b_if, lam_b, w_rb, b_rb, w_ib, b_ib, w_o):
    gate, xb = jnp.split(h @ w_in, 2, axis=-1)
    xc = dwconv_centred(xb, conv_w, conv_b)
    hf = lru_scan(xc, lam_f, w_rf, b_rf, w_if, b_if, reverse=False)
    hb = lru_scan(xc, lam_b, w_rb, b_rb, w_ib, b_ib, reverse=True)
    y = jax.nn.gelu(gate) * (hf + hb).astype(h.dtype)
    return y @ w_o


def route(xt, w_router, router_bias):
    T = xt.shape[0]
    scores = jax.nn.sigmoid(jnp.dot(xt, w_router, preferred_element_type=jnp.float32))
    biased = scores + router_bias.astype(jnp.float32)
    grp = biased.reshape(T, N_GROUPS, EXPERTS_PER_GROUP)
    gscore = lax.top_k(grp, TOP_K)[0].sum(-1)
    g_sel = jnp.argmax(gscore, axis=-1)
    in_group = (jnp.arange(N_EXPERTS) // EXPERTS_PER_GROUP)[None, :] == g_sel[:, None]
    masked = jnp.where(in_group, biased, -jnp.inf)
    _, idx = lax.top_k(masked, TOP_K)
    w = jnp.take_along_axis(scores, idx, axis=-1)
    w = w / jnp.sum(w, axis=-1, keepdims=True)
    return idx, w


def moe(xt, idx, wts, w_gu, w_dn):
    T, D = xt.shape
    A = T * TOP_K
    P = A + N_EXPERTS * MOE_BLOCK
    nb = P // MOE_BLOCK
    e_flat = idx.reshape(A)
    order = jnp.argsort(e_flat)
    e_sorted = e_flat[order]
    counts = jnp.bincount(e_flat, length=N_EXPERTS)
    start = jnp.cumsum(counts) - counts
    padded = ((counts + MOE_BLOCK - 1) // MOE_BLOCK) * MOE_BLOCK
    pend = jnp.cumsum(padded)
    pstart = pend - padded
    dest_sorted = pstart[e_sorted] + (jnp.arange(A) - start[e_sorted])
    dest = jnp.zeros((A,), jnp.int32).at[order].set(dest_sorted.astype(jnp.int32))
    row_tok = jnp.full((P,), T, jnp.int32).at[dest].set((jnp.arange(A) // TOP_K).astype(jnp.int32))
    xs = jnp.concatenate([xt, jnp.zeros((1, D), xt.dtype)], axis=0)[row_tok]
    blk_exp = jnp.minimum(jnp.searchsorted(pend, jnp.arange(nb) * MOE_BLOCK, side='right'), N_EXPERTS - 1)

    def expert_block(args):
        xb, e = args
        g, u = jnp.split(xb @ w_gu[e], 2, axis=-1)
        return (jax.nn.silu(g) * u) @ w_dn[e]

    ys = lax.map(expert_block, (xs.reshape(nb, MOE_BLOCK, D), blk_exp)).reshape(P, D)
    y = ys[dest].reshape(T, TOP_K, D)
    return jnp.einsum('tk,tkd->td', wts.astype(y.dtype), y)


def _normal(k, shape, fan_in, scale=1.0):
    return jax.random.normal(k, shape, jnp.float32) * (scale * fan_in ** -0.5)


def _gain(k, shape):
    return 1.0 + 0.05 * jax.random.normal(k, shape, jnp.float32)


def _small(k, shape, s=0.02):
    return s * jax.random.normal(k, shape, jnp.float32)


def _lru_lambda(k, shape):
    a0 = jax.random.uniform(k, shape, jnp.float32, 0.9, 0.999)
    p = a0 ** (1.0 / LRU_C)
    return jnp.log(p) - jnp.log1p(-p)


def setup_inputs(seed: int = 0) -> dict:
    key = jax.random.key(seed)
    ks = iter(jax.random.split(key, 48))
    NM, NR = N_MLA_LAYERS, N_RNN_LAYERS
    d = {}
    d['x'] = jax.random.normal(next(ks), (BATCH, SEQ, D_MODEL), jnp.float32)
    d['c'] = jax.random.normal(next(ks), (BATCH, D_MODEL), jnp.float32)
    offs = jax.random.randint(next(ks), (BATCH, 1), 0, 1024, jnp.int32)
    d['positions'] = (offs + jnp.arange(SEQ, dtype=jnp.int32)[None, :]).astype(jnp.int32)
    d['norm_mix'] = _gain(next(ks), (DEPTH, D_MODEL))
    d['norm_ffn'] = _gain(next(ks), (DEPTH, D_MODEL))
    d['w_ada'] = _normal(next(ks), (DEPTH, D_MODEL, 6 * D_MODEL), D_MODEL, 0.5)
    d['b_ada'] = _small(next(ks), (DEPTH, 6 * D_MODEL))
    d['mla_w_in'] = _normal(next(ks), (NM, D_MODEL, Q_LORA + KV_LORA + QK_ROPE), D_MODEL)
    d['mla_q_a_norm'] = _gain(next(ks), (NM, Q_LORA))
    d['mla_kv_a_norm'] = _gain(next(ks), (NM, KV_LORA))
    d['mla_w_q_b'] = _normal(next(ks), (NM, Q_LORA, N_HEADS * QK_HEAD), Q_LORA)
    d['mla_w_kv_b'] = _normal(next(ks), (NM, KV_LORA, N_HEADS * (QK_NOPE + V_HEAD)), KV_LORA)
    d['mla_q_norm'] = _gain(next(ks), (NM, QK_HEAD))
    d['mla_k_norm'] = _gain(next(ks), (NM, QK_HEAD))
    d['mla_w_o'] = _normal(next(ks), (NM, N_HEADS * V_HEAD, D_MODEL), N_HEADS * V_HEAD)
    d['rnn_w_in'] = _normal(next(ks), (NR, D_MODEL, 2 * D_RNN), D_MODEL)
    d['rnn_conv_w'] = _normal(next(ks), (NR, CONV_W, D_RNN), CONV_W)
    d['rnn_conv_b'] = _small(next(ks), (NR, D_RNN))
    d['rnn_lam_f'] = _lru_lambda(next(ks), (NR, D_RNN))
    d['rnn_w_rf'] = _normal(next(ks), (NR, RNN_BLOCKS, RNN_BW, RNN_BW), RNN_BW)
    d['rnn_b_rf'] = _small(next(ks), (NR, D_RNN), 0.1)
    d['rnn_w_if'] = _normal(next(ks), (NR, RNN_BLOCKS, RNN_BW, RNN_BW), RNN_BW)
    d['rnn_b_if'] = _small(next(ks), (NR, D_RNN), 0.1)
    d['rnn_lam_b'] = _lru_lambda(next(ks), (NR, D_RNN))
    d['rnn_w_rb'] = _normal(next(ks), (NR, RNN_BLOCKS, RNN_BW, RNN_BW), RNN_BW)
    d['rnn_b_rb'] = _small(next(ks), (NR, D_RNN), 0.1)
    d['rnn_w_ib'] = _normal(next(ks), (NR, RNN_BLOCKS, RNN_BW, RNN_BW), RNN_BW)
    d['rnn_b_ib'] = _small(next(ks), (NR, D_RNN), 0.1)
    d['rnn_w_o'] = _normal(next(ks), (NR, D_RNN, D_MODEL), D_RNN)
    d['w_router'] = _normal(next(ks), (D_MODEL, N_EXPERTS), D_MODEL)
    d['router_bias'] = _small(next(ks), (N_EXPERTS,), 0.01)
    d['moe_w_gu'] = _normal(next(ks), (DEPTH, N_EXPERTS, D_MODEL, 2 * D_EXPERT), D_MODEL)
    d['moe_w_dn'] = _normal(next(ks), (DEPTH, N_EXPERTS, D_EXPERT, D_MODEL), D_EXPERT)
    return d


def reference(x, c, positions, norm_mix, norm_ffn, w_ada, b_ada,
              mla_w_in, mla_q_a_norm, mla_kv_a_norm, mla_w_q_b, mla_w_kv_b, mla_q_norm, mla_k_norm, mla_w_o,
              rnn_w_in, rnn_conv_w, rnn_conv_b,
              rnn_lam_f, rnn_w_rf, rnn_b_rf, rnn_w_if, rnn_b_if,
              rnn_lam_b, rnn_w_rb, rnn_b_rb, rnn_w_ib, rnn_b_ib, rnn_w_o,
              w_router, router_bias, moe_w_gu, moe_w_dn):
    B, S, D = x.shape
    half = QK_ROPE // 2
    inv_freq = ROPE_THETA ** (-jnp.arange(half, dtype=jnp.float32) / half)
    ang = positions.astype(jnp.float32)[..., None] * inv_freq
    cos, sin = jnp.cos(ang), jnp.sin(ang)
    c_act = jax.nn.silu(c)
    for i in range(DEPTH):
        mod = c_act @ w_ada[i] + b_ada[i]
        sh1, sc1, g1, sh2, sc2, g2 = jnp.split(mod, 6, axis=-1)
        h = modulate(x, norm_mix[i], sh1, sc1)
        j = i // N_MIXERS
        if i % N_MIXERS == 0:
            m = mla_mixer(h, cos, sin, mla_w_in[j], mla_q_a_norm[j], mla_kv_a_norm[j], mla_w_q_b[j],
                          mla_w_kv_b[j], mla_q_norm[j], mla_k_norm[j], mla_w_o[j])
        else:
            m = rglru_mixer(h, rnn_w_in[j], rnn_conv_w[j], rnn_conv_b[j],
                            rnn_lam_f[j], rnn_w_rf[j], rnn_b_rf[j], rnn_w_if[j], rnn_b_if[j],
                            rnn_lam_b[j], rnn_w_rb[j], rnn_b_rb[j], rnn_w_ib[j], rnn_b_ib[j], rnn_w_o[j])
        x = x + g1[:, None, :] * m
        h = modulate(x, norm_ffn[i], sh2, sc2)
        ht = h.reshape(B * S, D)
        idx, wts = route(ht, w_router, router_bias)
        y = moe(ht, idx, wts, moe_w_gu[i], moe_w_dn[i])
        x = x + g2[:, None, :] * y.reshape(B, S, D)
    return x
```

```cpp
#include <hip/hip_runtime.h>
#include <stdint.h>
#include <stdio.h>

constexpr int T = 32768, D = 1024, NB = 16, SQ = 2048, NH = 16;
constexpr int QL = 384, KVL = 256, LATN = 672, LATP = 768;
constexpr int NE = 32, DE = 512;
constexpr float EPS = 1e-6f;
constexpr bool QFUSE = true;
constexpr bool MOE0_FP8 = true, MOE1_FP8 = true;
constexpr bool RNN_FP8 = false;
constexpr float F8_SY = 4.f;
constexpr bool DN1_FP8 = true;
constexpr float F8_SH = 16.f, F8_SW = 64.f, F8_SA = 8.f;
constexpr float QSCALE = 0.10206207261596577f * 1.4426950408889634f;

typedef unsigned short bf16_t;
typedef float f32x4 __attribute__((ext_vector_type(4)));
typedef unsigned u32x2 __attribute__((ext_vector_type(2)));
typedef unsigned u32x4 __attribute__((ext_vector_type(4)));

__device__ __forceinline__ int otid() { int t = (int)__builtin_amdgcn_workitem_id_x(); asm volatile("" : "+v"(t)); return t; }
__device__ __forceinline__ float bf2f(bf16_t v) { return __uint_as_float(((unsigned)v) << 16); }
__device__ __forceinline__ bf16_t f2bf(float f) { unsigned u = __float_as_uint(f); return (bf16_t)((u + 0x7fffu + ((u >> 16) & 1u)) >> 16); }
__device__ __forceinline__ unsigned pk2(float lo, float hi) { return (unsigned)f2bf(lo) | ((unsigned)f2bf(hi) << 16); }
__device__ __forceinline__ unsigned pk4_fp8_(float a, float b, float c, float d) {
    a = fminf(fmaxf(a, -448.f), 448.f); b = fminf(fmaxf(b, -448.f), 448.f); c = fminf(fmaxf(c, -448.f), 448.f); d = fminf(fmaxf(d, -448.f), 448.f);
    int r = 0; r = __builtin_amdgcn_cvt_pk_fp8_f32(a, b, r, false); r = __builtin_amdgcn_cvt_pk_fp8_f32(c, d, r, true); return (unsigned)r; }
__device__ __forceinline__ float wave_sum(float v) {
#pragma unroll
    for (int o = 1; o < 64; o <<= 1) v += __shfl_xor(v, o);
    return v;
}
__device__ __forceinline__ float sigmoidf_(float x) { return 1.f / (1.f + __expf(-x)); }
__device__ __forceinline__ float siluf_(float x) { return x * sigmoidf_(x); }
__device__ __forceinline__ float gelu_tanh(float x) { const float u = 0.7978845608028654f * (x + 0.044715f * x * x * x); return 0.5f * x * (1.f + tanhf(u)); }

constexpr size_t MiB = 1u << 20;
constexpr size_t WS_CTL = 0;
constexpr size_t WS_MOD = 1 * MiB;
constexpr size_t WS_COS = 2 * MiB;
constexpr size_t WS_SIN = 4 * MiB;
constexpr size_t WS_RTE = 6 * MiB;
constexpr size_t WS_TOK = 7 * MiB;
constexpr size_t WS_SSQ = 11 * MiB;
constexpr size_t WS_DST = 12 * MiB;
constexpr size_t WS_WSO = 16 * MiB;
constexpr size_t WS_W1T = 20 * MiB;
constexpr size_t WS_WQT = 22 * MiB;
constexpr size_t WS_WKVT = 24 * MiB;
constexpr size_t WS_WOT = 25 * MiB;
constexpr size_t WS_WRINT = 27 * MiB;
constexpr size_t WS_WGT = 31 * MiB;
constexpr size_t WS_WROT = 33 * MiB;
constexpr size_t WS_WGU = 36 * MiB;
constexpr size_t WS_WDN = 164 * MiB;
constexpr size_t WS_WGU8 = WS_WGU;
constexpr size_t WS_WDN8 = WS_WDN;
constexpr size_t WS_HB = 228 * MiB;
constexpr size_t WS_X1 = 292 * MiB;
constexpr size_t WS_H2 = 356 * MiB;
constexpr size_t WS_X2 = 420 * MiB;
constexpr size_t WS_U = 484 * MiB;
constexpr size_t WS_LAT = WS_U;
constexpr size_t WS_Q = WS_U + 48 * MiB;
constexpr size_t WS_K = WS_U + 144 * MiB;
constexpr size_t WS_V = WS_U + 240 * MiB;
constexpr size_t WS_O = WS_U + 304 * MiB;
constexpr size_t WS_SSQP = WS_U + 368 * MiB;
constexpr size_t WS_ROPEK = WS_U + 372 * MiB;
constexpr size_t WS_PESSQ = WS_U + 376 * MiB;
constexpr size_t WS_ACT = WS_U;
constexpr size_t WS_YS = WS_U + 72 * MiB;
constexpr size_t WS_YF = WS_U + 448 * MiB;
constexpr size_t WS_H2F = WS_U + 200 * MiB;
constexpr size_t WS_AF = WS_U;
constexpr size_t WS_AB = WS_U + 128 * MiB;
constexpr size_t WS_BXF = WS_U + 256 * MiB;
constexpr size_t WS_BXB = WS_U + 320 * MiB;
constexpr size_t WS_GG = WS_U + 384 * MiB;
constexpr size_t WS_SF = WS_U;
constexpr size_t WS_SB = WS_U + 128 * MiB;
constexpr size_t WS_SUM = WS_U + 256 * MiB;
constexpr size_t WS_SMAX = 11 * MiB + 768 * 1024;
constexpr size_t WS_SPL = 11 * MiB + 512 * 1024;
constexpr size_t WS_END = 1024 * MiB;
constexpr int CW_CNT = 1024;

struct Params { const void* in[33]; float* out; unsigned char* ws; };
__host__ __device__ __forceinline__ size_t kidx(int bh, int s, int d) { return ((size_t)(bh * 32 + (s >> 6)) * 12 + (d >> 3)) * 512 + (s & 63) * 8 + (d & 7); }
__host__ __device__ __forceinline__ size_t vidx(int bh, int s, int d) { return ((size_t)(bh * 32 + (s >> 6)) * 2 + (d >> 5)) * 2048 + (s & 63) * 32 + (d & 31); }

#define IN_F(i) ((const float*)p.in[i])
#define WSP(T_, off) ((T_*)(p.ws + (off)))

template <int K, int N, class F>
__device__ __forceinline__ void rowgemm(const F& f, float* lds) {
    constexpr int R = 8, NC = (N + 511) / 512;
    float* As = lds;
    float* Cs = lds + R * K;
    int* info = (int*)(Cs + R * N);
    const int tid = otid();
    const int nun = f.nunits();
    for (int u = blockIdx.x; u < nun; u += gridDim.x) {
        f.prep(u, info);
        __syncthreads();
        for (int i = tid; i < R * K; i += 512) { const int r = i / K, k = i % K; As[i] = f.a(u, info, r, k); }
        __syncthreads();
        float acc[NC][R];
#pragma unroll
        for (int c = 0; c < NC; ++c)
#pragma unroll
            for (int r = 0; r < R; ++r) acc[c][r] = 0.f;
        for (int k = 0; k < K; k += 4) {
            float bv[NC][4];
#pragma unroll
            for (int c = 0; c < NC; ++c) { const int n = tid + c * 512;
#pragma unroll
                for (int kk = 0; kk < 4; ++kk) bv[c][kk] = (n < N) ? f.b(u, info, k + kk, n) : 0.f; }
#pragma unroll
            for (int r = 0; r < R; ++r) { const f32x4 av = *(const f32x4*)(As + r * K + k);
#pragma unroll
                for (int c = 0; c < NC; ++c) { acc[c][r] += av[0] * bv[c][0]; acc[c][r] += av[1] * bv[c][1]; acc[c][r] += av[2] * bv[c][2]; acc[c][r] += av[3] * bv[c][3]; } }
        }
#pragma unroll
        for (int c = 0; c < NC; ++c) { const int n = tid + c * 512; if (n < N) {
#pragma unroll
            for (int r = 0; r < R; ++r) Cs[r * N + n] = acc[c][r]; } }
        __syncthreads();
        f.epi(u, info, Cs);
        __syncthreads();
    }
}

__device__ __forceinline__ void ph_prologue(const Params& p, float* lds) {
    const int tid = otid();
    float* cact = lds;
    float* red = lds + 16 * 1024;
    const float* c = IN_F(1);
    { float cv[32];
#pragma unroll
      for (int k = 0; k < 32; ++k) cv[k] = c[tid + 512 * k];
#pragma unroll
      for (int k = 0; k < 32; ++k) cact[tid + 512 * k] = siluf_(cv[k]); }
    __syncthreads();
    const float* wada = IN_F(5); const float* bada = IN_F(6);
    float* mod = WSP(float, WS_MOD);
    const int cl = tid & 31, ks = tid >> 5;
    for (int t = blockIdx.x; t < 384; t += gridDim.x) {
        const int l = t / 192, col0 = (t % 192) * 32;
        float acc[16];
#pragma unroll
        for (int b = 0; b < 16; ++b) acc[b] = 0.f;
        const float* w = wada + (size_t)l * 1024 * 6144 + col0 + cl;
#pragma unroll 1
        for (int k0 = ks * 64; k0 < ks * 64 + 64; k0 += 32) { float wv[32];
#pragma unroll
            for (int q = 0; q < 32; ++q) wv[q] = __builtin_nontemporal_load(w + (size_t)(k0 + q) * 6144);
#pragma unroll
            for (int q = 0; q < 32; ++q) {
#pragma unroll
                for (int b = 0; b < 16; ++b) acc[b] += cact[b * 1024 + k0 + q] * wv[q];
                asm volatile("" ::: "memory"); } }
#pragma unroll
        for (int b = 0; b < 16; ++b) red[(ks * 16 + b) * 32 + cl] = acc[b];
        __syncthreads();
        { const int b = tid >> 5; float s = 0.f;
#pragma unroll
          for (int q = 0; q < 16; ++q) s += red[(q * 16 + b) * 32 + cl];
          mod[((size_t)l * 16 + b) * 6144 + col0 + cl] = s + bada[l * 6144 + col0 + cl]; }
        __syncthreads();
    }
    { float* spl = WSP(float, WS_SPL); for (int i = blockIdx.x * 512 + tid; i < 2048; i += gridDim.x * 512) { const float lam = (i < 1024) ? IN_F(18)[i] : IN_F(23)[i - 1024]; spl[i] = -8.f * 1.4426950408889634f * log1pf(expf(-lam)); } }
    if (blockIdx.x == 0 && tid < 64) { float mq = 0.f, mk = 0.f; for (int i = tid; i < 96; i += 64) { mq = fmaxf(mq, fabsf(IN_F(12)[i])); mk = fmaxf(mk, fabsf(IN_F(13)[i])); }
#pragma unroll
        for (int o = 1; o < 64; o <<= 1) { mq = fmaxf(mq, __shfl_xor(mq, o)); mk = fmaxf(mk, __shfl_xor(mk, o)); }
        if (tid == 0) *WSP(float, WS_SMAX) = 1.02f * 96.f * mq * mk * QSCALE + 0.01f; }
    const int* pos = (const int*)p.in[2];
    float* ct = WSP(float, WS_COS); float* st = WSP(float, WS_SIN);
    for (int i = blockIdx.x * 512 + tid; i < T * 16; i += gridDim.x * 512) {
        const int tok = i >> 4, j = i & 15;
        const float inv = exp2f(-(float)j * (13.287712379549449f / 16.f));
        const float ang = (float)pos[tok] * inv;
        const double rev = (double)ang * 0.15915494309189535;
        const float fr = (float)(rev - floor(rev));
        ct[i] = __builtin_amdgcn_cosf(fr); st[i] = __builtin_amdgcn_sinf(fr);
    }
}

__device__ __forceinline__ void row_load_f32(const float* row, int lane, float (&v)[16]) {
#pragma unroll
    for (int j = 0; j < 4; ++j) { const f32x4 x = *(const f32x4*)(row + j * 256 + lane * 4); v[4 * j] = x[0]; v[4 * j + 1] = x[1]; v[4 * j + 2] = x[2]; v[4 * j + 3] = x[3]; }
}
__device__ __forceinline__ void row_load_bf16(const bf16_t* row, int lane, float (&v)[16]) {
#pragma unroll
    for (int j = 0; j < 4; ++j) { const u32x2 x = *(const u32x2*)(row + j * 256 + lane * 4);
        v[4 * j] = __uint_as_float(x[0] << 16); v[4 * j + 1] = __uint_as_float(x[0] & 0xffff0000u); v[4 * j + 2] = __uint_as_float(x[1] << 16); v[4 * j + 3] = __uint_as_float(x[1] & 0xffff0000u); }
}
__device__ __forceinline__ void row_store_bf16(bf16_t* row, int lane, const float (&v)[16]) {
#pragma unroll
    for (int j = 0; j < 4; ++j) { u32x2 x; x[0] = pk2(v[4 * j], v[4 * j + 1]); x[1] = pk2(v[4 * j + 2], v[4 * j + 3]); *(u32x2*)(row + j * 256 + lane * 4) = x; }
}
__device__ __forceinline__ void row_modulate(float (&v)[16], int lane, const float* g, const float* sh, const float* sc) {
    float s = 0.f;
#pragma unroll
    for (int i = 0; i < 16; ++i) s += v[i] * v[i];
    const float rstd = rsqrtf(wave_sum(s) * (1.f / 1024.f) + EPS);
#pragma unroll
    for (int j = 0; j < 4; ++j) { const int c0 = j * 256 + lane * 4;
        const f32x4 gg = *(const f32x4*)(g + c0), s1 = *(const f32x4*)(sc + c0), s0 = *(const f32x4*)(sh + c0);
#pragma unroll
        for (int i = 0; i < 4; ++i) v[4 * j + i] = v[4 * j + i] * rstd * gg[i] * (1.f + s1[i]) + s0[i]; }
}

__device__ __forceinline__ int vblock() { const int G = gridDim.x, c = blockIdx.x; return (G % 8 == 0) ? (c % 8) * (G / 8) + c / 8 : c; }
__device__ __forceinline__ void ph_norm0(const Params& p) {
    const int lane = otid() & 63, gw = vblock() * 8 + (otid() >> 6), ngw = gridDim.x * 8;
    const float* x = IN_F(0); const float* g = IN_F(3); const float* mod = WSP(float, WS_MOD); bf16_t* hb = WSP(bf16_t, WS_HB);
#pragma unroll 1
    for (int run = gw; run < T / 16; run += ngw) { const int row0 = run * 16, b = row0 >> 11; const float* mb = mod + (size_t)b * 6144;
        float gm[16], sh[16];
#pragma unroll
        for (int j = 0; j < 4; ++j) { const int c0 = j * 256 + lane * 4; const f32x4 gg = *(const f32x4*)(g + c0), s1 = *(const f32x4*)(mb + 1024 + c0), s0 = *(const f32x4*)(mb + c0);
#pragma unroll
            for (int i = 0; i < 4; ++i) { gm[4 * j + i] = gg[i] * (1.f + s1[i]); sh[4 * j + i] = s0[i]; } }
        f32x4 nx[4], ny[4];
#pragma unroll
        for (int j = 0; j < 4; ++j) { nx[j] = __builtin_nontemporal_load((const f32x4*)(x + (size_t)row0 * D + j * 256 + lane * 4)); ny[j] = __builtin_nontemporal_load((const f32x4*)(x + (size_t)(row0 + 1) * D + j * 256 + lane * 4)); }
#pragma unroll 1
        for (int k = 0; k < 16; ++k) { const int row = row0 + k, nrow = row0 + (k < 14 ? k + 2 : 15); float v[16];
#pragma unroll
            for (int j = 0; j < 4; ++j) { v[4 * j] = nx[j][0]; v[4 * j + 1] = nx[j][1]; v[4 * j + 2] = nx[j][2]; v[4 * j + 3] = nx[j][3]; nx[j] = ny[j]; }
#pragma unroll
            for (int j = 0; j < 4; ++j) ny[j] = __builtin_nontemporal_load((const f32x4*)(x + (size_t)nrow * D + j * 256 + lane * 4));
            float s_ = 0.f;
#pragma unroll
            for (int i = 0; i < 16; ++i) s_ += v[i] * v[i];
            const float rstd = rsqrtf(wave_sum(s_) * (1.f / 1024.f) + EPS);
#pragma unroll
            for (int i = 0; i < 16; ++i) v[i] = v[i] * rstd * gm[i] + sh[i];
            row_store_bf16(hb + (size_t)row * D, lane, v); } }
}

struct FLat { const Params& p;
    __device__ __forceinline__ int nunits() const { return T / 8; }
    __device__ __forceinline__ void prep(int, int*) const {}
    __device__ __forceinline__ float a(int u, const int*, int r, int k) const { return bf2f(WSP(const bf16_t, WS_HB)[(size_t)(u * 8 + r) * D + k]); }
    __device__ __forceinline__ float b(int, const int*, int k, int n) const { return IN_F(7)[(size_t)k * LATN + n]; }
    __device__ __forceinline__ void epi(int u, const int*, const float* Cs) const {
        bf16_t* lat = WSP(bf16_t, WS_LAT); float* ssq = WSP(float, WS_SSQ);
        const int tid = otid(), r = tid >> 6, lane = tid & 63; const int row = u * 8 + r;
        float s0 = 0.f, s1 = 0.f;
        for (int n = lane; n < LATN; n += 64) { const float v = Cs[r * LATN + n]; lat[(size_t)row * LATP + n] = f2bf(v); if (n < QL) s0 += v * v; else if (n < QL + KVL) s1 += v * v; }
        s0 = wave_sum(s0); s1 = wave_sum(s1);
        if (lane == 0) { ssq[row * 2] = s0; ssq[row * 2 + 1] = s1; }
    }
};
struct FQ { const Params& p;
    __device__ __forceinline__ int nunits() const { return T / 8; }
    __device__ __forceinline__ void prep(int, int*) const {}
    __device__ __forceinline__ float a(int u, const int*, int r, int k) const { const int row = u * 8 + r;
        const float rstd = rsqrtf(WSP(const float, WS_SSQ)[row * 2] * (1.f / QL) + EPS);
        return bf2f(WSP(const bf16_t, WS_LAT)[(size_t)row * LATP + k]) * rstd * IN_F(8)[k]; }
    __device__ __forceinline__ float b(int, const int*, int k, int n) const { return IN_F(10)[(size_t)k * 1536 + n]; }
    __device__ __forceinline__ void epi(int u, const int*, const float* Cs) const {
        const int tid = otid(); if (tid >= 128) return;
        const int r = tid >> 4, h = tid & 15, row = u * 8 + r, b = row >> 11, s = row & 2047;
        const float* c = Cs + r * 1536 + h * 96; const float* gn = IN_F(12);
        float ss = 0.f; for (int d = 0; d < 96; ++d) ss += c[d] * c[d];
        const float rstd = rsqrtf(ss * (1.f / 96.f) + EPS) ;
        bf16_t* q = WSP(bf16_t, WS_Q) + ((size_t)(b * NH + h) * SQ + s) * 96;
        for (int d = 0; d < 64; ++d) q[d] = f2bf(c[d] * rstd * gn[d] * QSCALE);
        const float* ct = WSP(const float, WS_COS) + (size_t)row * 16; const float* st = WSP(const float, WS_SIN) + (size_t)row * 16;
        for (int i = 0; i < 16; ++i) { const float x1 = c[64 + i] * rstd * gn[64 + i], x2 = c[80 + i] * rstd * gn[80 + i];
            q[64 + i] = f2bf((x1 * ct[i] - x2 * st[i]) * QSCALE); q[80 + i] = f2bf((x1 * st[i] + x2 * ct[i]) * QSCALE); }
    }
};
struct FKV { const Params& p;
    __device__ __forceinline__ int nunits() const { return T / 8; }
    __device__ __forceinline__ void prep(int, int*) const {}
    __device__ __forceinline__ float a(int u, const int*, int r, int k) const { const int row = u * 8 + r;
        const float rstd = rsqrtf(WSP(const float, WS_SSQ)[row * 2 + 1] * (1.f / KVL) + EPS);
        return bf2f(WSP(const bf16_t, WS_LAT)[(size_t)row * LATP + QL + k]) * rstd * IN_F(9)[k]; }
    __device__ __forceinline__ float b(int, const int*, int k, int n) const { return IN_F(11)[(size_t)k * 2048 + n]; }
    __device__ __forceinline__ void epi(int u, const int*, const float* Cs) const {
        const int tid = otid(); if (tid >= 128) return;
        const int r = tid >> 4, h = tid & 15, row = u * 8 + r, b = row >> 11, s = row & 2047;
        const float* c = Cs + r * 2048 + h * 128; const float* gn = IN_F(13);
        const bf16_t* pe = WSP(const bf16_t, WS_LAT) + (size_t)row * LATP + QL + KVL;
        float ss = 0.f; for (int d = 0; d < 64; ++d) ss += c[d] * c[d];
        for (int j = 0; j < 32; ++j) { const float v = bf2f(pe[j]); ss += v * v; }
        const float rstd = rsqrtf(ss * (1.f / 96.f) + EPS);
        bf16_t* kk = WSP(bf16_t, WS_K); bf16_t* vv = WSP(bf16_t, WS_V); const int bh = b * NH + h;
        for (int d = 0; d < 64; ++d) { kk[kidx(bh, s, d)] = f2bf(c[d] * rstd * gn[d]); vv[vidx(bh, s, d)] = f2bf(c[64 + d]); }
        const float* ct = WSP(const float, WS_COS) + (size_t)row * 16; const float* st = WSP(const float, WS_SIN) + (size_t)row * 16;
        for (int i = 0; i < 16; ++i) { const float x1 = bf2f(pe[i]) * rstd * gn[64 + i], x2 = bf2f(pe[16 + i]) * rstd * gn[80 + i];
            kk[kidx(bh, s, 64 + i)] = f2bf(x1 * ct[i] - x2 * st[i]); kk[kidx(bh, s, 80 + i)] = f2bf(x1 * st[i] + x2 * ct[i]); }
    }
};

__device__ __forceinline__ void ph_attn(const Params& p, float* lds) {
    constexpr int KT = 16;
    float* Ks = lds;
    float* Vs = lds + KT * 96;
    const int tid = otid();
    const bf16_t* Qg = WSP(const bf16_t, WS_Q); const bf16_t* Kg = WSP(const bf16_t, WS_K); const bf16_t* Vg = WSP(const bf16_t, WS_V);
    bf16_t* Og = WSP(bf16_t, WS_O);
    for (int u = blockIdx.x; u < 1024; u += gridDim.x) {
        const int bh = u >> 2, qc = u & 3, s = qc * 512 + tid;
        unsigned qp[48];
        { const bf16_t* qptr = Qg + ((size_t)bh * SQ + s) * 96;
#pragma unroll
          for (int d = 0; d < 48; d += 4) { const u32x4 x = *(const u32x4*)(qptr + 2 * d); qp[d] = x[0]; qp[d + 1] = x[1]; qp[d + 2] = x[2]; qp[d + 3] = x[3]; } }
        float o[64];
#pragma unroll
        for (int d = 0; d < 64; ++d) o[d] = 0.f;
        float m = -INFINITY, l = 0.f;
        for (int t0 = 0; t0 < SQ; t0 += KT) {
            __syncthreads();
            for (int i = tid; i < KT * 96; i += 512) Ks[i] = bf2f(Kg[kidx(bh, t0 + i / 96, i % 96)]);
            for (int i = tid; i < KT * 64; i += 512) Vs[i] = bf2f(Vg[vidx(bh, t0 + i / 64, i % 64)]);
            __syncthreads();
#pragma unroll 1
            for (int j = 0; j < KT; ++j) { float a = 0.f;
#pragma unroll
                for (int d = 0; d < 96; d += 4) { const f32x4 kv = *(const f32x4*)(Ks + j * 96 + d); const unsigned w0 = qp[d >> 1], w1 = qp[(d >> 1) + 1];
                    a += __uint_as_float(w0 << 16) * kv[0]; a += __uint_as_float(w0 & 0xffff0000u) * kv[1]; a += __uint_as_float(w1 << 16) * kv[2]; a += __uint_as_float(w1 & 0xffff0000u) * kv[3]; }
                const float mn = fmaxf(m, a), alpha = exp2f(m - mn), pj = exp2f(a - mn); m = mn;
                l = l * alpha + pj;
#pragma unroll
                for (int d = 0; d < 64; d += 4) { const f32x4 vv = *(const f32x4*)(Vs + j * 64 + d);
                    o[d] = o[d] * alpha + pj * vv[0]; o[d + 1] = o[d + 1] * alpha + pj * vv[1]; o[d + 2] = o[d + 2] * alpha + pj * vv[2]; o[d + 3] = o[d + 3] * alpha + pj * vv[3]; } }
        }
        const float rl = 1.f / l; const int b = bh >> 4, h = bh & 15;
        bf16_t* op = Og + ((size_t)(b * SQ + s)) * D + h * 64;
#pragma unroll
        for (int d = 0; d < 64; d += 8) { u32x4 x;
#pragma unroll
            for (int i = 0; i < 4; ++i) x[i] = pk2(o[d + 2 * i] * rl, o[d + 2 * i + 1] * rl);
            *(u32x4*)(op + d) = x; }
    }
}

template <bool RESID_F32>
struct FRes { const Params& p; const bf16_t* A; const float* W; const void* resid; const float* gate  ; bf16_t* out;
    __device__ __forceinline__ int nunits() const { return T / 8; }
    __device__ __forceinline__ void prep(int, int*) const {}
    __device__ __forceinline__ float a(int u, const int*, int r, int k) const { return bf2f(A[(size_t)(u * 8 + r) * D + k]); }
    __device__ __forceinline__ float b(int, const int*, int k, int n) const { return W[(size_t)k * D + n]; }
    __device__ __forceinline__ void epi(int u, const int*, const float* Cs) const {
        for (int i = otid(); i < 8 * D; i += 512) { const int r = i >> 10, n = i & 1023, row = u * 8 + r, b = row >> 11;
            const float rv = RESID_F32 ? ((const float*)resid)[(size_t)row * D + n] : bf2f(((const bf16_t*)resid)[(size_t)row * D + n]);
            out[(size_t)row * D + n] = f2bf(rv + gate[(size_t)b * 6144 + n] * Cs[i]); }
    }
};

__device__ __forceinline__ void ph_router(const Params& p, int layer, const bf16_t* xin) {
    const int lane = otid() & 63, gw = blockIdx.x * 8 + (otid() >> 6), ngw = gridDim.x * 8;
    const float* g = IN_F(4) + layer * D; const float* mod = WSP(float, WS_MOD) + (size_t)layer * 16 * 6144;
    const float* wr = IN_F(29); const float* rb = IN_F(30);
    bf16_t* h2 = WSP(bf16_t, WS_H2);
    int* re = WSP(int, WS_RTE); int* rp = re + T * 2; float* rw = (float*)(rp + T * 2);
    int* tok = WSP(int, WS_TOK); unsigned* cnt = WSP(unsigned, WS_CTL) + CW_CNT + layer * 32;
    for (int row = gw; row < T; row += ngw) { const int b = row >> 11; float v[16];
        row_load_bf16(xin + (size_t)row * D, lane, v);
        row_modulate(v, lane, g, mod + (size_t)b * 6144 + 3072, mod + (size_t)b * 6144 + 4096);
        row_store_bf16(h2 + (size_t)row * D, lane, v);
        float lg[32];
#pragma unroll
        for (int e = 0; e < 32; ++e) lg[e] = 0.f;
#pragma unroll
        for (int j = 0; j < 4; ++j)
#pragma unroll
            for (int i = 0; i < 4; ++i) { const float* w = wr + (size_t)(j * 256 + lane * 4 + i) * 32; const float hv = v[4 * j + i];
#pragma unroll
                for (int e = 0; e < 32; e += 4) { const f32x4 wv = *(const f32x4*)(w + e); lg[e] += hv * wv[0]; lg[e + 1] += hv * wv[1]; lg[e + 2] += hv * wv[2]; lg[e + 3] += hv * wv[3]; } }
#pragma unroll
        for (int e = 0; e < 32; ++e) lg[e] = wave_sum(lg[e]);
        float best = -INFINITY; int e1 = 0, e2 = 1; float s1 = 0.f, s2 = 0.f;
#pragma unroll
        for (int gq = 0; gq < 8; ++gq) {
            float sc[4], bi[4];
#pragma unroll
            for (int i = 0; i < 4; ++i) { sc[i] = 1.f / (1.f + expf(-lg[4 * gq + i])); bi[i] = sc[i] + rb[4 * gq + i]; }
            int i1 = 0; float v1 = bi[0], t1 = sc[0];
#pragma unroll
            for (int i = 1; i < 4; ++i) if (bi[i] > v1) { v1 = bi[i]; t1 = sc[i]; i1 = i; }
            int i2 = -1; float v2 = -INFINITY, t2 = 0.f;
#pragma unroll
            for (int i = 0; i < 4; ++i) if (i != i1 && bi[i] > v2) { v2 = bi[i]; t2 = sc[i]; i2 = i; }
            const float gs = v1 + v2;
            if (gs > best) { best = gs; e1 = 4 * gq + i1; e2 = 4 * gq + i2; s1 = t1; s2 = t2; }
        }
        if (lane == 0) {
            const float inv = 1.f / (s1 + s2);
            const int p1 = (int)atomicAdd(cnt + e1, 1u), p2 = (int)atomicAdd(cnt + e2, 1u);
            re[row * 2] = e1; re[row * 2 + 1] = e2; rp[row * 2] = p1; rp[row * 2 + 1] = p2; rw[row * 2] = s1 * inv; rw[row * 2 + 1] = s2 * inv;
            tok[(size_t)e1 * T + p1] = row; tok[(size_t)e2 * T + p2] = row;
            int* dstp = WSP(int, WS_DST); float* wso = WSP(float, WS_WSO);
            dstp[(size_t)e1 * T + p1] = row * 2; dstp[(size_t)e2 * T + p2] = row * 2 + 1; wso[(size_t)e1 * T + p1] = s1 * inv; wso[(size_t)e2 * T + p2] = s2 * inv;
        }
    }
}

struct MoeUnit {
    static __device__ __forceinline__ void prep(const Params& p, int layer, int u, int* info) {
        if (otid() == 0) {
            const unsigned* cnt = WSP(const unsigned, WS_CTL) + CW_CNT + layer * 32; const int* tok = WSP(const int, WS_TOK);
            int e = 0, g0 = 0, seg = 0;
            for (; e < 32; ++e) { const int c = (int)cnt[e], ng = (c + 7) >> 3; if (u < g0 + ng) break; g0 += ng; seg += ((c + 255) >> 8) << 8; }
            if (e >= 32) { info[0] = -1; }
            else { const int c = (int)cnt[e], pos0 = (u - g0) * 8; info[0] = e; info[1] = pos0; info[2] = c; info[3] = seg;
                for (int r = 0; r < 8; ++r) info[8 + r] = (pos0 + r < c) ? tok[(size_t)e * T + pos0 + r] : -1; }
        }
    }
};
struct FGu { const Params& p; int layer;
    __device__ __forceinline__ int nunits() const { return (2 * T) / 8 + 32; }
    __device__ __forceinline__ void prep(int u, int* info) const { MoeUnit::prep(p, layer, u, info); }
    __device__ __forceinline__ float a(int, const int* info, int r, int k) const { const int t = info[8 + r]; return (info[0] >= 0 && t >= 0) ? bf2f(WSP(const bf16_t, WS_H2)[(size_t)t * D + k]) : 0.f; }
    __device__ __forceinline__ float b(int, const int* info, int k, int n) const { const int e = info[0] < 0 ? 0 : info[0]; return IN_F(31)[((size_t)(layer * 32 + e) * 1024 + k) * 1024 + n]; }
    __device__ __forceinline__ void epi(int, const int* info, const float* Cs) const {
        if (info[0] < 0) return;
        bf16_t* act = WSP(bf16_t, WS_ACT);
        for (int i = otid(); i < 8 * DE; i += 512) { const int r = i >> 9, c = i & 511;
            if (info[8 + r] >= 0) act[(size_t)(info[3] + info[1] + r) * DE + c] = f2bf(siluf_(Cs[r * 1024 + c]) * Cs[r * 1024 + 512 + c]); }
    }
};
struct FDn { const Params& p; int layer;
    __device__ __forceinline__ int nunits() const { return (2 * T) / 8 + 32; }
    __device__ __forceinline__ void prep(int u, int* info) const { MoeUnit::prep(p, layer, u, info); }
    __device__ __forceinline__ float a(int, const int* info, int r, int k) const { return (info[0] >= 0 && info[8 + r] >= 0) ? bf2f(WSP(const bf16_t, WS_ACT)[(size_t)(info[3] + info[1] + r) * DE + k]) : 0.f; }
    __device__ __forceinline__ float b(int, const int* info, int k, int n) const { const int e = info[0] < 0 ? 0 : info[0]; return IN_F(32)[((size_t)(layer * 32 + e) * 512 + k) * 1024 + n]; }
    __device__ __forceinline__ void epi(int, const int* info, const float* Cs) const {
        if (info[0] < 0) return;
        const int* re = WSP(const int, WS_RTE); const float* rw = (const float*)(re + T * 4);
        bf16_t* ys = WSP(bf16_t, WS_YS);
        for (int i = otid(); i < 8 * D; i += 512) { const int r = i >> 10, n = i & 1023; const int t = info[8 + r];
            if (t >= 0) { const int slot = (re[t * 2] == info[0]) ? 0 : 1; ys[((size_t)t * 2 + slot) * D + n] = f2bf(rw[t * 2 + slot] * Cs[i]); } }
    }
};

__device__ __forceinline__ void ph_combine(const Params& p, int layer, const bf16_t* xmid) {
    const int lane = otid() & 63, gw = vblock() * 8 + (otid() >> 6), ngw = gridDim.x * 8;
    const float* mod = WSP(float, WS_MOD); const bf16_t* ys = WSP(const bf16_t, WS_YS);
#pragma unroll 1
    for (int run = gw; run < T / 16; run += ngw) { const int row0 = run * 16, b = row0 >> 11;
        const float* g2 = mod + ((size_t)layer * 16 + b) * 6144 + 5120; const float* m1 = mod + ((size_t)16 + b) * 6144;
        float gt[16], gm[16], sh[16];
#pragma unroll
        for (int j = 0; j < 4; ++j) { const int c0 = j * 256 + lane * 4; const f32x4 gg = *(const f32x4*)(g2 + c0);
#pragma unroll
            for (int i = 0; i < 4; ++i) gt[4 * j + i] = gg[i];
            if (layer == 0) { const f32x4 gn = *(const f32x4*)(IN_F(3) + D + c0), s1 = *(const f32x4*)(m1 + 1024 + c0), s0 = *(const f32x4*)(m1 + c0);
#pragma unroll
                for (int i = 0; i < 4; ++i) { gm[4 * j + i] = gn[i] * (1.f + s1[i]); sh[4 * j + i] = s0[i]; } } }
        u32x2 nv[4], n0[4], n1[4];
#pragma unroll
        for (int j = 0; j < 4; ++j) { nv[j] = __builtin_nontemporal_load((const u32x2*)(xmid + (size_t)row0 * D + j * 256 + lane * 4)); n0[j] = __builtin_nontemporal_load((const u32x2*)(ys + (size_t)row0 * 2 * D + j * 256 + lane * 4)); n1[j] = __builtin_nontemporal_load((const u32x2*)(ys + (size_t)row0 * 2 * D + D + j * 256 + lane * 4)); }
#pragma unroll 1
        for (int k = 0; k < 16; ++k) { const int row = row0 + k, nrow = row0 + (k < 15 ? k + 1 : k); float v[16];
#pragma unroll
            for (int j = 0; j < 4; ++j) {
                const float a0 = __uint_as_float(nv[j][0] << 16), a1 = __uint_as_float(nv[j][0] & 0xffff0000u), a2 = __uint_as_float(nv[j][1] << 16), a3 = __uint_as_float(nv[j][1] & 0xffff0000u);
                const float p0 = __uint_as_float(n0[j][0] << 16), p1 = __uint_as_float(n0[j][0] & 0xffff0000u), p2 = __uint_as_float(n0[j][1] << 16), p3 = __uint_as_float(n0[j][1] & 0xffff0000u);
                const float q0 = __uint_as_float(n1[j][0] << 16), q1 = __uint_as_float(n1[j][0] & 0xffff0000u), q2 = __uint_as_float(n1[j][1] << 16), q3 = __uint_as_float(n1[j][1] & 0xffff0000u);
                v[4 * j] = a0 + gt[4 * j] * (p0 + q0); v[4 * j + 1] = a1 + gt[4 * j + 1] * (p1 + q1); v[4 * j + 2] = a2 + gt[4 * j + 2] * (p2 + q2); v[4 * j + 3] = a3 + gt[4 * j + 3] * (p3 + q3); }
#pragma unroll
            for (int j = 0; j < 4; ++j) { nv[j] = __builtin_nontemporal_load((const u32x2*)(xmid + (size_t)nrow * D + j * 256 + lane * 4)); n0[j] = __builtin_nontemporal_load((const u32x2*)(ys + (size_t)nrow * 2 * D + j * 256 + lane * 4)); n1[j] = __builtin_nontemporal_load((const u32x2*)(ys + (size_t)nrow * 2 * D + D + j * 256 + lane * 4)); }
            if (layer == 0) {
                row_store_bf16(WSP(bf16_t, WS_X2) + (size_t)row * D, lane, v);
                float s_ = 0.f;
#pragma unroll
                for (int i = 0; i < 16; ++i) s_ += v[i] * v[i];
                const float rstd = rsqrtf(wave_sum(s_) * (1.f / 1024.f) + EPS);
#pragma unroll
                for (int i = 0; i < 16; ++i) v[i] = v[i] * rstd * gm[i] + sh[i];
                if (RNN_FP8) {
#pragma unroll
                    for (int j = 0; j < 4; ++j) *(unsigned*)(WSP(unsigned char, WS_HB) + (size_t)row * D + j * 256 + lane * 4) = pk4_fp8_(v[4 * j] * F8_SH, v[4 * j + 1] * F8_SH, v[4 * j + 2] * F8_SH, v[4 * j + 3] * F8_SH); }
                else row_store_bf16(WSP(bf16_t, WS_HB) + (size_t)row * D, lane, v);
            } else {
#pragma unroll
                for (int j = 0; j < 4; ++j) { f32x4 o = {v[4 * j], v[4 * j + 1], v[4 * j + 2], v[4 * j + 3]}; __builtin_nontemporal_store(o, (f32x4*)(p.out + (size_t)row * D + j * 256 + lane * 4)); }
            }
        } }
}

struct FRin { const Params& p;
    __device__ __forceinline__ int nunits() const { return T / 8; }
    __device__ __forceinline__ void prep(int, int*) const {}
    __device__ __forceinline__ float a(int u, const int*, int r, int k) const { return bf2f(WSP(const bf16_t, WS_HB)[(size_t)(u * 8 + r) * D + k]); }
    __device__ __forceinline__ float b(int, const int*, int k, int n) const { return IN_F(15)[(size_t)k * 2048 + n]; }
    __device__ __forceinline__ void epi(int u, const int*, const float* Cs) const {
        bf16_t* gg = WSP(bf16_t, WS_GG); bf16_t* xb = WSP(bf16_t, WS_X1);
        for (int i = otid(); i < 8 * 2048; i += 512) { const int r = i >> 11, n = i & 2047, row = u * 8 + r;
            if (n < 1024) gg[(size_t)row * D + n] = f2bf(gelu_tanh(Cs[i])); else xb[(size_t)row * D + n - 1024] = f2bf(Cs[i]); }
    }
};
__device__ __forceinline__ void ph_conv(const Params& p) {
    const bf16_t* xb = WSP(const bf16_t, WS_X1); bf16_t* xc = WSP(bf16_t, WS_H2);
    const float* cw = IN_F(16); const float* cb = IN_F(17);
    for (int it = blockIdx.x * 512 + otid(); it < (T / 16) * 128; it += gridDim.x * 512) {
        const int cg = it & 127, rb = it >> 7, c0 = cg * 8, row0 = rb * 16, s0 = row0 & 2047;
        float w[4][8], bias[8];
#pragma unroll
        for (int k = 0; k < 4; ++k) { const f32x4 a = *(const f32x4*)(cw + k * D + c0), b2 = *(const f32x4*)(cw + k * D + c0 + 4);
#pragma unroll
            for (int j = 0; j < 4; ++j) { w[k][j] = a[j]; w[k][4 + j] = b2[j]; } }
        { const f32x4 a = *(const f32x4*)(cb + c0), b2 = *(const f32x4*)(cb + c0 + 4);
#pragma unroll
          for (int j = 0; j < 4; ++j) { bias[j] = a[j]; bias[4 + j] = b2[j]; } }
        u32x4 win[19];
#pragma unroll
        for (int r = 0; r < 19; ++r) { const int ss = s0 + r - 2; win[r] = (ss >= 0 && ss < SQ) ? *(const u32x4*)(xb + (size_t)(row0 + r - 2) * D + c0) : (u32x4){0u, 0u, 0u, 0u}; }
#pragma unroll
        for (int r = 0; r < 16; ++r) { float a[8];
#pragma unroll
            for (int j = 0; j < 8; ++j) a[j] = bias[j];
#pragma unroll
            for (int k = 0; k < 4; ++k)
#pragma unroll
                for (int q = 0; q < 4; ++q) { const unsigned x = win[r + k][q]; a[2 * q] += __uint_as_float(x << 16) * w[k][2 * q]; a[2 * q + 1] += __uint_as_float(x & 0xffff0000u) * w[k][2 * q + 1]; }
            u32x4 o; o[0] = pk2(a[0], a[1]); o[1] = pk2(a[2], a[3]); o[2] = pk2(a[4], a[5]); o[3] = pk2(a[6], a[7]);
            *(u32x4*)(xc + (size_t)(row0 + r) * D + c0) = o; }
    }
}
struct FGate { const Params& p;
    __device__ __forceinline__ int nunits() const { return (T / 8) * 4; }
    __device__ __forceinline__ void prep(int, int*) const {}
    __device__ __forceinline__ float a(int u, const int*, int r, int k) const { const int n = u & 3, rg = u >> 2; return bf2f(WSP(const bf16_t, WS_H2)[(size_t)(rg * 8 + r) * D + n * 256 + k]); }
    __device__ __forceinline__ float b(int u, const int*, int k, int j) const { const int n = u & 3, gate = j >> 8, e = j & 255;
        const float* W = gate == 0 ? IN_F(19) : gate == 1 ? IN_F(21) : gate == 2 ? IN_F(24) : IN_F(26);
        return W[((size_t)n * 256 + k) * 256 + e]; }
    __device__ __forceinline__ void epi(int u, const int*, const float* Cs) const {
        const int n = u & 3, rg = u >> 2;
        float* af = WSP(float, WS_AF); bf16_t* bxf = WSP(bf16_t, WS_BXF); float* ab = WSP(float, WS_AB); bf16_t* bxb = WSP(bf16_t, WS_BXB);
        const bf16_t* xc = WSP(const bf16_t, WS_H2);
        for (int i = otid(); i < 8 * 256; i += 512) { const int r = i >> 8, e = i & 255, row = rg * 8 + r, c = n * 256 + e, s = row & 2047;
            const float x = bf2f(xc[(size_t)row * D + c]);
            const float rf = sigmoidf_(Cs[r * 1024 + e] + IN_F(20)[c]), jf = sigmoidf_(Cs[r * 1024 + 256 + e] + IN_F(22)[c]);
            const float rb = sigmoidf_(Cs[r * 1024 + 512 + e] + IN_F(25)[c]), jb = sigmoidf_(Cs[r * 1024 + 768 + e] + IN_F(27)[c]);
            const float laf = -8.f * rf * log1pf(expf(-IN_F(18)[c])), lab = -8.f * rb * log1pf(expf(-IN_F(23)[c]));
            const float mf = (s == 0) ? 1.f : sqrtf(-expm1f(2.f * laf)), mb = (s == SQ - 1) ? 1.f : sqrtf(-expm1f(2.f * lab));
            const size_t o = (size_t)row * D + c;
            af[o] = expf(laf); bxf[o] = f2bf(mf * jf * x); ab[o] = expf(lab); bxb[o] = f2bf(mb * jb * x); }
    }
};
__device__ __forceinline__ void ph_scan(const Params& p) {
    float* af = WSP(float, WS_AF); const bf16_t* bxf = WSP(const bf16_t, WS_BXF); const float* ab = WSP(const float, WS_AB); const bf16_t* bxb = WSP(const bf16_t, WS_BXB);
    bf16_t* gy = WSP(bf16_t, WS_GG);
    const int wave = otid() >> 6, lane = otid() & 63;
    if (wave == 0)
    for (int u = blockIdx.x; u < 256; u += gridDim.x) { const int b = u >> 4, c = (u & 15) * 64 + lane;
        const size_t base = (size_t)b * SQ * D + c; float h = 0.f;
#pragma unroll 8
        for (int t = 0; t < SQ; ++t) { const size_t o = base + (size_t)t * D; h = af[o] * h + bf2f(bxf[o]); af[o] = h; }
        h = 0.f;
#pragma unroll 8
        for (int t = SQ - 1; t >= 0; --t) { const size_t o = base + (size_t)t * D; h = ab[o] * h + bf2f(bxb[o]); gy[o] = f2bf(bf2f(gy[o]) * (af[o] + h)); }
    }
}

#define LAS __attribute__((address_space(3)))
typedef short bf16x8 __attribute__((ext_vector_type(8)));
namespace g8 {
constexpr int BM = 256, BK = 64, HALF = 128, HTB = HALF * BK * 2, STAGE_BYTES = 8 * HTB;
__host__ __device__ __forceinline__ int lds_byte(int r, int c) { const int st = (r >> 4) * 2 + (c >> 5), rr = r & 15, cc = c & 31, ob = rr * 64 + cc * 2; return st * 1024 + (ob ^ (((ob >> 9) & 1) << 5)); }
__host__ __device__ __forceinline__ void stage_rc(int b, int& R, int& C) { const int st = b / 1024, sb = b % 1024, swz = sb ^ (((sb >> 9) & 1) << 5); R = (st >> 1) * 16 + swz / 64; C = (st & 1) * 32 + (swz % 64) / 2; }
__host__ __device__ __forceinline__ int perm32(int rho) { const int n = rho >> 4, i = rho & 15; return 8 * (i >> 2) + 4 * n + (i & 3); }

struct Unit { const char* a; const char* b; const int* rows; int nvalid; int pm, pn, e, row0; };

__device__ __forceinline__ unsigned cvt_pk_bf16(float lo, float hi) { unsigned r; asm volatile("v_cvt_pk_bf16_f32 %0, %1, %2" : "=v"(r) : "v"(lo), "v"(hi)); return r; }

template <class Epi, class Sched, bool GATHER, bool FP8 = false>
__device__ __forceinline__ void gemm_phase(LAS unsigned char* lds, const int KB, const int ldaB, const Sched& S, const Epi& E) {
    int tid_ = otid();
    const int tid = tid_, wid = __builtin_amdgcn_readfirstlane(tid >> 6), lane = tid & 63, wr = wid >> 2, wc = wid & 3, fr = lane & 15, fq = lane >> 4;
    const int nt = KB / 128;
    int Rr[2], Cc[2]; unsigned voffB[2];
#pragma unroll
    for (int i = 0; i < 2; ++i) { int R, C; stage_rc(tid * 16 + i * 8192, R, C); const int Rb = (R & ~31) + perm32(R & 31); Rr[i] = R; Cc[i] = C; voffB[i] = (unsigned)(Rb * KB + C * 2); }
    const size_t kstep = (size_t)(BK * 2);
    const size_t hstep = (size_t)HALF * KB;
    const unsigned ldsw = (unsigned)wid * 1024u;
    const int aoff = lds_byte(wr * 64 + fr, fq * 8), boff = lds_byte(wc * 32 + fr, fq * 8);
#define G8_SA(b, h) (((b) * 2 + (h)) * HTB)
#define G8_SB(b, h) ((4 + (b) * 2 + (h)) * HTB)
#define G8_STAGE(bufoff, gbase, voff) do { _Pragma("unroll") for (int _i = 0; _i < 2; ++_i) \
        __builtin_amdgcn_global_load_lds((const unsigned*)((const char*)(gbase) + (voff)[_i]), (LAS unsigned*)(lds + (bufoff) + ldsw + _i * 8192), 16, 0, 0); } while (0)
#define G8_LD8(addr) __builtin_shufflevector(*(const LAS v4i_*)(addr), *(const LAS v4i_*)((addr) + 1024), 0, 1, 2, 3, 4, 5, 6, 7)
#define G8_LDA(dst, b, h) do { _Pragma("unroll") for (int m = 0; m < 4; ++m) dst[m] = G8_LD8(lds + G8_SA(b, h) + aoff + m * 2048); } while (0)
#define G8_LDB(dst, b, h) do { _Pragma("unroll") for (int n = 0; n < 2; ++n) dst[n] = G8_LD8(lds + G8_SB(b, h) + boff + n * 2048); } while (0)
#define G8_H0(x) __builtin_bit_cast(bf16x8, __builtin_shufflevector(x, x, 0, 1, 2, 3))
#define G8_H1(x) __builtin_bit_cast(bf16x8, __builtin_shufflevector(x, x, 4, 5, 6, 7))
#define G8_MMA(ai, bj, At, Bt) do { __builtin_amdgcn_s_setprio(1); _Pragma("unroll") for (int m = 0; m < 4; ++m) _Pragma("unroll") for (int n = 0; n < 2; ++n) { \
        if constexpr (FP8) acc[ai][bj][m][n] = __builtin_amdgcn_mfma_scale_f32_16x16x128_f8f6f4(Bt[n], At[m], acc[ai][bj][m][n], 0, 0, 0, 127, 0, 127); \
        else { acc[ai][bj][m][n] = __builtin_amdgcn_mfma_f32_16x16x32_bf16(G8_H0(Bt[n]), G8_H0(At[m]), acc[ai][bj][m][n], 0, 0, 0); \
               acc[ai][bj][m][n] = __builtin_amdgcn_mfma_f32_16x16x32_bf16(G8_H1(Bt[n]), G8_H1(At[m]), acc[ai][bj][m][n], 0, 0, 0); } } \
        __builtin_amdgcn_s_setprio(0); } while (0)
#define G8_WAIT_V(n) asm volatile("s_waitcnt vmcnt(" #n ")" ::: "memory")
#define G8_WAIT_L(n) asm volatile("s_waitcnt lgkmcnt(" #n ")" ::: "memory")
#define G8_BAR __builtin_amdgcn_s_barrier()
#define G8_SCHED __builtin_amdgcn_sched_barrier(0)
#define G8_AOFF(dst, u) do { _Pragma("unroll") for (int h = 0; h < 2; ++h) _Pragma("unroll") for (int i = 0; i < 2; ++i) { const int rl = h * HALF + Rr[i]; \
        if constexpr (GATHER) { const int rr = (rl < (u).nvalid) ? (u).rows[rl] : (u).rows[0]; dst[h][i] = (unsigned)(rr * ldaB + Cc[i] * 2); } \
        else dst[h][i] = (unsigned)(rl * ldaB + Cc[i] * 2); } } while (0)
    Unit cur, nxt; int ui = 0;
    if (!S.next(0, cur)) return;
    f32x4 acc[2][2][4][2];
#pragma unroll
    for (int a = 0; a < 2; ++a)
#pragma unroll
        for (int b = 0; b < 2; ++b)
#pragma unroll
            for (int m = 0; m < 4; ++m)
#pragma unroll
                for (int n = 0; n < 2; ++n) acc[a][b][m][n] = (f32x4){0.f, 0.f, 0.f, 0.f};
    typedef int v8i_ __attribute__((ext_vector_type(8))); typedef int v4i_ __attribute__((ext_vector_type(4)));
    v8i_ At[4], B0[2], B1[2];
    unsigned vA[2][2];
    LAS int* xr = (LAS int*)(lds + 131072 + 2048 + wid * 256);
    G8_AOFF(vA, cur);
    const char* cA = cur.a; const char* cB = cur.b;
    G8_STAGE(G8_SB(0, 0), cB, voffB); G8_STAGE(G8_SB(0, 1), cB + hstep, voffB); G8_STAGE(G8_SA(0, 0), cA, vA[0]); G8_STAGE(G8_SA(0, 1), cA, vA[1]);
    if (wr == 1) G8_BAR;
    G8_WAIT_V(2); G8_BAR;
    G8_STAGE(G8_SB(1, 0), cB + kstep, voffB); G8_STAGE(G8_SA(1, 0), cA + kstep, vA[0]); G8_STAGE(G8_SB(1, 1), cB + hstep + kstep, voffB);
    G8_WAIT_V(6); G8_BAR;
    for (;;) {
        const bool has_next = S.next(ui + 1, nxt);
        const char* nA = has_next ? nxt.a : cA; const char* nB = has_next ? nxt.b : cB;
#pragma unroll 1
        for (int t = 0; t < nt; t += 2) {
            const bool last = (t == nt - 2);
            const char* a1 = cA + (size_t)(t + 1) * kstep;
            const char* a2 = last ? nA : cA + (size_t)(t + 2) * kstep; const char* b2 = last ? nB : cB + (size_t)(t + 2) * kstep;
            const char* a3 = a2 + kstep; const char* b3 = b2 + kstep;
            G8_LDB(B0, 0, 0); G8_LDB(B1, 0, 1); G8_SCHED; G8_LDA(At, 0, 0); G8_STAGE(G8_SA(1, 1), a1, vA[1]);
            if constexpr (GATHER) {
                if (t == 0 && has_next) { const int hi_ = lane >> 4, h_ = hi_ >> 1, i_ = hi_ & 1; int rl = h_ * HALF + ((wid + 8 * i_) >> 1) * 16 + (lane & 15); rl = rl < nxt.nvalid ? rl : 0;
                    __builtin_amdgcn_global_load_lds((const unsigned*)(nxt.rows + rl), (LAS unsigned*)xr, 4, 0, 0); }
            }
            G8_WAIT_V(8); G8_WAIT_L(0); G8_BAR; G8_MMA(0, 0, At, B0); G8_MMA(0, 1, At, B1); G8_BAR; G8_SCHED;
            if constexpr (!GATHER && FP8) {
                if (last && has_next) { const int t2_ = otid();
#pragma unroll
                    for (int i = 0; i < 2; ++i) { int R_, C_; stage_rc(t2_ * 16 + i * 8192, R_, C_); const int Rb_ = (R_ & ~31) + perm32(R_ & 31);
                        vA[0][i] = (unsigned)(R_ * ldaB + C_ * 2); vA[1][i] = (unsigned)((HALF + R_) * ldaB + C_ * 2); voffB[i] = (unsigned)(Rb_ * KB + C_ * 2); } }
            }
            if constexpr (GATHER) {
                if (last && has_next) {
#pragma unroll
                    for (int h = 0; h < 2; ++h)
#pragma unroll
                        for (int i = 0; i < 2; ++i) vA[h][i] = (unsigned)(xr[(h * 2 + i) * 16 + (lane >> 2)] * ldaB + Cc[i] * 2); }
            }
            G8_LDA(At, 0, 1); G8_STAGE(G8_SB(0, 0), b2, voffB); G8_STAGE(G8_SB(0, 1), b2 + hstep, voffB); G8_STAGE(G8_SA(0, 0), a2, vA[0]);
            G8_WAIT_V(8); G8_WAIT_L(0); G8_BAR; G8_MMA(1, 0, At, B0); G8_MMA(1, 1, At, B1); G8_BAR; G8_SCHED;
            G8_LDB(B0, 1, 0); G8_LDB(B1, 1, 1); G8_SCHED; G8_LDA(At, 1, 0); G8_STAGE(G8_SA(0, 1), a2, vA[1]);
            G8_WAIT_V(8); G8_WAIT_L(0); G8_BAR; G8_MMA(0, 0, At, B0); G8_MMA(0, 1, At, B1); G8_BAR; G8_SCHED;
            G8_LDA(At, 1, 1); G8_STAGE(G8_SB(1, 0), b3, voffB); G8_STAGE(G8_SB(1, 1), b3 + hstep, voffB); G8_STAGE(G8_SA(1, 0), a3, vA[0]);
            G8_WAIT_V(8); G8_WAIT_L(0); G8_BAR; G8_MMA(1, 0, At, B0); G8_MMA(1, 1, At, B1); G8_BAR; G8_SCHED;
        }
        if (wr == 0) G8_BAR;
        E(acc, cur, wr, wc, fr, fq);
        if (!has_next) break;
#pragma unroll
        for (int a = 0; a < 2; ++a)
#pragma unroll
            for (int b = 0; b < 2; ++b)
#pragma unroll
                for (int m = 0; m < 4; ++m)
#pragma unroll
                    for (int n = 0; n < 2; ++n) acc[a][b][m][n] = (f32x4){0.f, 0.f, 0.f, 0.f};
        cur = nxt; cA = nA; cB = nB; ++ui;
        if (wr == 1) G8_BAR;
    }
    G8_WAIT_V(0);
    G8_BAR;
#undef G8_SA
#undef G8_SB
#undef G8_STAGE
#undef G8_LD8
#undef G8_H0
#undef G8_H1
#undef G8_LDA
#undef G8_LDB
#undef G8_MMA
#undef G8_AOFF
}

struct DenseSched { const char* A; const char* B; int nM, nN, nwg, G, c, lda, K;
    __device__ __forceinline__ void init(const void* A_, int lda_, const void* B_, int K_, int M, int N) { A = (const char*)A_; B = (const char*)B_; lda = lda_; K = K_; nM = M / 256; nN = N / 256; nwg = nM * nN; G = gridDim.x; c = blockIdx.x; }
    __device__ __forceinline__ bool next(int i, Unit& u) const {
        const long L = (long)i * G + c; if (L >= nwg) return false;
        int wgid = (int)L; { const int q = nwg / 8, r = nwg % 8, xcd = wgid % 8, off = wgid / 8; wgid = (xcd < r ? xcd * (q + 1) : r * (q + 1) + (xcd - r) * q) + off; }
        const int nig = 8 * nN, gid = wgid / nig, fm = gid * 8, gsz = (nM - fm) < 8 ? (nM - fm) : 8;
        u.pm = fm + ((wgid % nig) % gsz); u.pn = (wgid % nig) / gsz; u.e = 0; u.row0 = u.pm * 256; u.rows = nullptr; u.nvalid = 256;
        u.a = A + (size_t)u.pm * 256 * lda * 2; u.b = B + (size_t)u.pn * 256 * K * 2; return true; }
};
struct MoeSched { const LAS int* tab; const char* A; const char* B; const int* tok; int ldaB, KB  , G, vc; size_t bstride; bool gather;
    __device__ __forceinline__ bool next(int i, Unit& u) const {
        const int L = i * G + vc; const int ntile = tab[32]; if (L >= ntile * 4) return false;
        const int tl = L >> 2; u.pn = L & 3;
        const int e = __builtin_amdgcn_readfirstlane(tab[192 + tl]);
        const int t0 = __builtin_amdgcn_readfirstlane(tl - tab[e]), segr = __builtin_amdgcn_readfirstlane(tab[128 + e]), cn = __builtin_amdgcn_readfirstlane(tab[64 + e]);
        u.e = e; u.pm = t0; u.row0 = segr + t0 * 256; const int nv = cn - t0 * 256; u.nvalid = nv < 256 ? nv : 256;
        u.rows = tok + (size_t)e * T + t0 * 256;
        u.a = gather ? A : A + (size_t)u.row0 * ldaB; u.b = B + (size_t)e * bstride + (size_t)u.pn * 256 * KB; return true; }
};
__device__ __forceinline__ void moe_tables(const Params& p, int layer, LAS int* tab) {
    __syncthreads();
    if (otid() < 32) { const unsigned* cnt = WSP(const unsigned, WS_CTL) + CW_CNT + layer * 32; const int e = otid();
        const int c = (int)__hip_atomic_load(cnt + e, __ATOMIC_RELAXED, __HIP_MEMORY_SCOPE_AGENT), nt_ = (c + 255) >> 8; int incl = nt_;
#pragma unroll
        for (int o = 1; o < 32; o <<= 1) { const int v = __shfl_up(incl, o, 32); if (e >= o) incl += v; }
        const int tp = incl - nt_; tab[e] = tp; tab[64 + e] = c; tab[128 + e] = tp << 8; if (e == 31) tab[32] = incl; }
    __syncthreads();
    { const int t = otid(); if (t < 320) { int e = 0;
#pragma unroll 1
        for (int q = 1; q < 32; ++q) e += (tab[q] <= t) ? 1 : 0;
        tab[192 + t] = e; } }
    __syncthreads();
}

__device__ __forceinline__ float frcp(float x) { return __builtin_amdgcn_rcpf(x); }
__device__ __forceinline__ float fsig(float x) { return frcp(1.f + __builtin_amdgcn_exp2f(-1.4426950408889634f * x)); }
__device__ __forceinline__ float fast_tanh(float x) { const float e = __builtin_amdgcn_exp2f(2.885390081777927f * x); return 1.f - 2.f * frcp(e + 1.f); }
__device__ __forceinline__ float gelu_fast(float x) { const float u = 0.7978845608028654f * (x + 0.044715f * x * x * x); return 0.5f * x * (1.f + fast_tanh(u)); }
template <bool RF32> struct EpiRes { const void* resid; const float* gate; bf16_t* out; float inv;
    __device__ __forceinline__ void operator()(const f32x4 (&acc)[2][2][4][2], const Unit& u, int wr, int wc, int fr, int fq) const {
        const int b = u.row0 >> 11; f32x4 gv[2][2];
#pragma unroll
        for (int bj = 0; bj < 2; ++bj)
#pragma unroll
            for (int n = 0; n < 2; ++n) gv[bj][n] = *(const f32x4*)(gate + (size_t)b * 6144 + u.pn * 256 + bj * 128 + wc * 32 + 8 * fq + 4 * n) * inv;
        const size_t o0 = ((size_t)u.row0 + wr * 64 + fr) * D + u.pn * 256 + wc * 32 + 8 * fq;
#pragma unroll
        for (int ai = 0; ai < 2; ++ai) {
            f32x4 r0[4][2], r1[4][2];
#pragma unroll
            for (int m = 0; m < 4; ++m)
#pragma unroll
                for (int bj = 0; bj < 2; ++bj) { const size_t o = o0 + (size_t)(ai * 128 + m * 16) * D + bj * 128;
                    if constexpr (RF32) { r0[m][bj] = __builtin_nontemporal_load((const f32x4*)((const float*)resid + o)); r1[m][bj] = __builtin_nontemporal_load((const f32x4*)((const float*)resid + o + 4)); }
                    else { const u32x4 x = *(const u32x4*)((const bf16_t*)resid + o);
                        r0[m][bj] = (f32x4){__uint_as_float(x[0] << 16), __uint_as_float(x[0] & 0xffff0000u), __uint_as_float(x[1] << 16), __uint_as_float(x[1] & 0xffff0000u)};
                        r1[m][bj] = (f32x4){__uint_as_float(x[2] << 16), __uint_as_float(x[2] & 0xffff0000u), __uint_as_float(x[3] << 16), __uint_as_float(x[3] & 0xffff0000u)}; } }
#pragma unroll
            for (int m = 0; m < 4; ++m)
#pragma unroll
                for (int bj = 0; bj < 2; ++bj) { const size_t o = o0 + (size_t)(ai * 128 + m * 16) * D + bj * 128;
                    const f32x4 v0 = r0[m][bj] + gv[bj][0] * acc[ai][bj][m][0], v1 = r1[m][bj] + gv[bj][1] * acc[ai][bj][m][1];
                    u32x4 w; w[0] = cvt_pk_bf16(v0[0], v0[1]); w[1] = cvt_pk_bf16(v0[2], v0[3]); w[2] = cvt_pk_bf16(v1[0], v1[1]); w[3] = cvt_pk_bf16(v1[2], v1[3]);
                    *(u32x4*)(out + o) = w; }
            asm volatile("" ::: "memory"); }
    }
};
struct EpiRin { bf16_t* gg; bf16_t* xb; float inv;
    __device__ __forceinline__ void operator()(const f32x4 (&acc)[2][2][4][2], const Unit& u, int wr, int wc, int fr, int fq) const {
        const bool isg = u.pn < 4; bf16_t* dst = isg ? gg : xb; const int cbase = (u.pn & 3) * 256;
#pragma unroll
        for (int ai = 0; ai < 2; ++ai)
#pragma unroll
            for (int m = 0; m < 4; ++m) { const size_t row = (size_t)u.row0 + ai * 128 + wr * 64 + m * 16 + fr;
#pragma unroll
                for (int bj = 0; bj < 2; ++bj) { f32x4 v0 = acc[ai][bj][m][0] * inv, v1 = acc[ai][bj][m][1] * inv;
                    if (isg) {
#pragma unroll
                        for (int j = 0; j < 4; ++j) { v0[j] = gelu_fast(v0[j]); v1[j] = gelu_fast(v1[j]); } }
                    u32x4 w; w[0] = cvt_pk_bf16(v0[0], v0[1]); w[1] = cvt_pk_bf16(v0[2], v0[3]); w[2] = cvt_pk_bf16(v1[0], v1[1]); w[3] = cvt_pk_bf16(v1[2], v1[3]);
                    *(u32x4*)(dst + row * D + cbase + bj * 128 + wc * 32 + 8 * fq) = w; }
                asm volatile("" ::: "memory"); }
    }
};
struct EpiGu { bf16_t* act; float inv;
    __device__ __forceinline__ void operator()(const f32x4 (&acc)[2][2][4][2], const Unit& u, int wr, int wc, int fr, int fq) const {
#pragma unroll
        for (int ai = 0; ai < 2; ++ai)
#pragma unroll
            for (int m = 0; m < 4; ++m) { const size_t row = (size_t)u.row0 + ai * 128 + wr * 64 + m * 16 + fr; float v[8];
#pragma unroll
                for (int n = 0; n < 2; ++n)
#pragma unroll
                    for (int j = 0; j < 4; ++j) { const float g = acc[ai][0][m][n][j] * inv, uu = acc[ai][1][m][n][j] * inv; v[4 * n + j] = g * uu * fsig(g); }
                u32x4 w; w[0] = cvt_pk_bf16(v[0], v[1]); w[1] = cvt_pk_bf16(v[2], v[3]); w[2] = cvt_pk_bf16(v[4], v[5]); w[3] = cvt_pk_bf16(v[6], v[7]);
                *(u32x4*)(act + row * DE + u.pn * 128 + wc * 32 + 8 * fq) = w;
                asm volatile("" ::: "memory"); }
    }
};
struct EpiDnLite { const int* dst; const float* wso; bf16_t* ys; float oscale;
    __device__ __forceinline__ void operator()(const f32x4 (&acc)[2][2][4][2], const Unit& u, int wr, int wc, int fr, int fq) const {
        const int* dp = dst + (size_t)u.e * T + u.pm * 256; const float* wp = wso + (size_t)u.e * T + u.pm * 256;
        const int cofs = u.pn * 256 + wc * 32 + 8 * fq;
#pragma unroll
        for (int ai = 0; ai < 2; ++ai)
#pragma unroll
            for (int m = 0; m < 4; ++m) { const int rl = ai * 128 + wr * 64 + m * 16 + fr;
                if (rl < u.nvalid) { const int d = dp[rl]; const float w = wp[rl] * oscale; bf16_t* orow = ys + (size_t)d * D + cofs;
#pragma unroll
                    for (int bj = 0; bj < 2; ++bj) { const f32x4 v0 = acc[ai][bj][m][0] * w, v1 = acc[ai][bj][m][1] * w;
                        u32x4 x; x[0] = cvt_pk_bf16(v0[0], v0[1]); x[1] = cvt_pk_bf16(v0[2], v0[3]); x[2] = cvt_pk_bf16(v1[0], v1[1]); x[3] = cvt_pk_bf16(v1[2], v1[3]);
                        *(u32x4*)(orow + bj * 128) = x; } }
                asm volatile("" ::: "memory"); }
    }
};
__device__ __forceinline__ unsigned pk4_fp8(float a, float b, float c, float d) {
    a = fminf(fmaxf(a, -448.f), 448.f); b = fminf(fmaxf(b, -448.f), 448.f); c = fminf(fmaxf(c, -448.f), 448.f); d = fminf(fmaxf(d, -448.f), 448.f);
    int r = 0; r = __builtin_amdgcn_cvt_pk_fp8_f32(a, b, r, false); r = __builtin_amdgcn_cvt_pk_fp8_f32(c, d, r, true); return (unsigned)r; }
struct EpiGu8 { unsigned char* act;
    __device__ __forceinline__ void operator()(const f32x4 (&acc)[2][2][4][2], const Unit& u, int wr, int wc, int fr, int fq) const {
        constexpr float inv = 1.f / (F8_SH * F8_SW);
#pragma unroll
        for (int ai = 0; ai < 2; ++ai)
#pragma unroll
            for (int m = 0; m < 4; ++m) { const size_t row = (size_t)u.row0 + ai * 128 + wr * 64 + m * 16 + fr; float v[8];
#pragma unroll
                for (int n = 0; n < 2; ++n)
#pragma unroll
                    for (int j = 0; j < 4; ++j) { const float g = acc[ai][0][m][n][j] * inv, uu = acc[ai][1][m][n][j] * inv; v[4 * n + j] = g * uu * fsig(g) * F8_SA; }
                u32x2 w; w[0] = pk4_fp8(v[0], v[1], v[2], v[3]); w[1] = pk4_fp8(v[4], v[5], v[6], v[7]);
                *(u32x2*)(act + row * DE + u.pn * 128 + wc * 32 + 8 * fq) = w;
                asm volatile("" ::: "memory"); }
    }
};
struct EpiDn { const int* dst; const float* wso; bf16_t* ys; float oscale;
    __device__ __forceinline__ void operator()(const f32x4 (&acc)[2][2][4][2], const Unit& u, int wr, int wc, int fr, int fq) const {
        const int* dp = dst + (size_t)u.e * T + u.pm * 256; const float* wp = wso + (size_t)u.e * T + u.pm * 256;
        const int cofs = u.pn * 256 + wc * 32 + 8 * fq;
        int dd[8]; float ww[8];
#pragma unroll
        for (int g = 0; g < 8; ++g) { const int rl = (g >> 2) * 128 + wr * 64 + (g & 3) * 16 + fr; const bool ok = rl < u.nvalid; dd[g] = ok ? dp[rl] : -1; ww[g] = ok ? wp[rl] * oscale : 0.f; }
#pragma unroll
        for (int g = 0; g < 8; ++g) { const int ai = g >> 2, m = g & 3;
            if (dd[g] >= 0) { bf16_t* orow = ys + (size_t)dd[g] * D + cofs; const float w = ww[g];
#pragma unroll
                for (int bj = 0; bj < 2; ++bj) { const f32x4 v0 = acc[ai][bj][m][0] * w, v1 = acc[ai][bj][m][1] * w;
                    u32x4 x; x[0] = cvt_pk_bf16(v0[0], v0[1]); x[1] = cvt_pk_bf16(v0[2], v0[3]); x[2] = cvt_pk_bf16(v1[0], v1[1]); x[3] = cvt_pk_bf16(v1[2], v1[3]);
                    *(u32x4*)(orow + bj * 128) = x; } } }
    }
};
__device__ __forceinline__ float quad_sum(float v) { v += __shfl_xor(v, 16); v += __shfl_xor(v, 32); return v; }
struct EpiLat { bf16_t* lat; float* ssqp; float* ropek; float* pessq; const float* cs; const float* sn; const float* knorm;
    __device__ __forceinline__ void operator()(const f32x4 (&acc)[2][2][4][2], const Unit& u, int wr, int wc, int fr, int fq) const {
        f32x4 cq[8], sq_[8];
        const bool pe_wave = (u.pn == 2 && wc == 0);
        if (pe_wave) {
#pragma unroll
            for (int g = 0; g < 8; ++g) { const size_t row = (size_t)u.row0 + (g >> 2) * 128 + wr * 64 + (g & 3) * 16 + fr; cq[g] = *(const f32x4*)(cs + row * 16 + 4 * fq); sq_[g] = *(const f32x4*)(sn + row * 16 + 4 * fq); } }
#pragma unroll
        for (int ai = 0; ai < 2; ++ai)
#pragma unroll
            for (int m = 0; m < 4; ++m) { const size_t row = (size_t)u.row0 + ai * 128 + wr * 64 + m * 16 + fr;
#pragma unroll
                for (int bj = 0; bj < 2; ++bj) { const f32x4 v0 = acc[ai][bj][m][0], v1 = acc[ai][bj][m][1]; const int col = u.pn * 256 + bj * 128 + wc * 32 + 8 * fq;
                    u32x4 w; w[0] = cvt_pk_bf16(v0[0], v0[1]); w[1] = cvt_pk_bf16(v0[2], v0[3]); w[2] = cvt_pk_bf16(v1[0], v1[1]); w[3] = cvt_pk_bf16(v1[2], v1[3]);
                    *(u32x4*)(lat + row * LATP + col) = w;
                    const int sl = u.pn * 2 + bj;
                    if (sl < 5) { float ss = 0.f;
#pragma unroll
                        for (int j = 0; j < 4; ++j) ss += v0[j] * v0[j] + v1[j] * v1[j];
                        ss = quad_sum(ss); if (fq == 0) ssqp[(size_t)(sl * 4 + wc) * T + row] = ss; }
                    else if (wc == 0) {
                        float ss = 0.f; f32x4 o1, o2; const f32x4 c4 = cq[ai * 4 + m], s4 = sq_[ai * 4 + m];
                        const f32x4 g1 = *(const f32x4*)(knorm + 64 + 4 * fq), g2 = *(const f32x4*)(knorm + 80 + 4 * fq);
#pragma unroll
                        for (int j = 0; j < 4; ++j) { ss += v0[j] * v0[j] + v1[j] * v1[j]; const float x1 = v0[j] * g1[j], x2 = v1[j] * g2[j]; o1[j] = x1 * c4[j] - x2 * s4[j]; o2[j] = x1 * s4[j] + x2 * c4[j]; }
                        ss = quad_sum(ss); if (fq == 0) pessq[row] = ss;
                        *(f32x4*)(ropek + row * 32 + 4 * fq) = o1; *(f32x4*)(ropek + row * 32 + 16 + 4 * fq) = o2; } }
                asm volatile("" ::: "memory"); }
    }
};
struct MlaXchg { LAS float* part; LAS float* rr; LAS float* pe; };
__device__ __forceinline__ MlaXchg mla_xchg(LAS unsigned char* lds) { MlaXchg x; x.part = (LAS float*)(lds + 131072 + 4096); x.rr = x.part + 2048; x.pe = x.rr + 256; return x; }
struct EpiQ { LAS unsigned char* lds; const float* ssqp; const float* qnorm; const float* cs; const float* sn; bf16_t* q;
    __device__ __forceinline__ void operator()(const f32x4 (&acc)[2][2][4][2], const Unit& u, int wr, int wc, int fr, int fq) const {
        const MlaXchg X = mla_xchg(lds); const int tid = otid();
        int lb = wr * 64 + fr; asm volatile("" : "+v"(lb));
        if (tid < 256) { float ss = 0.f;
#pragma unroll
            for (int sl = 0; sl < 12; ++sl) ss += ssqp[(size_t)sl * T + u.row0 + tid];
            X.rr[tid] = rsqrtf(ss * (1.f / QL) + EPS); }
        { LAS float* pw = X.part + wc * 512 + lb;
#pragma unroll
        for (int ai = 0; ai < 2; ++ai)
#pragma unroll
            for (int m = 0; m < 4; ++m)
#pragma unroll
                for (int bj = 0; bj < 2; ++bj) { const f32x4 v0 = acc[ai][bj][m][0], v1 = acc[ai][bj][m][1]; float ss = 0.f;
#pragma unroll
                    for (int j = 0; j < 4; ++j) ss += v0[j] * v0[j] + v1[j] * v1[j];
                    ss = quad_sum(ss); if (fq == 0) pw[bj * 256 + ai * 128 + m * 16] = ss; } }
        asm volatile("s_waitcnt lgkmcnt(0)" ::: "memory"); __builtin_amdgcn_s_barrier();
        if (wc == 3) return;
        const int b = u.row0 >> 11; const LAS float* pr = X.part + lb; const LAS float* prr = X.rr + lb;
#pragma unroll
        for (int ai = 0; ai < 2; ++ai) {
        f32x4 cq[4], sq_[4];
        if (wc == 2) {
#pragma unroll
            for (int g = 0; g < 4; ++g) { const size_t row = (size_t)u.row0 + ai * 128 + g * 16 + lb; cq[g] = *(const f32x4*)(cs + row * 16 + 4 * fq); sq_[g] = *(const f32x4*)(sn + row * 16 + 4 * fq); } }
#pragma unroll
            for (int m = 0; m < 4; ++m) { const int rl = ai * 128 + m * 16 + lb; const int row = u.row0 + rl, sq = row & 2047; const float r = prr[ai * 128 + m * 16];
#pragma unroll
                for (int bj = 0; bj < 2; ++bj) { const float tot = pr[(0 * 2 + bj) * 256 + ai * 128 + m * 16] + pr[(1 * 2 + bj) * 256 + ai * 128 + m * 16] + pr[(2 * 2 + bj) * 256 + ai * 128 + m * 16];
                    const float sc = r * rsqrtf(r * r * tot * (1.f / 96.f) + EPS) * QSCALE; const int h = u.pn * 2 + bj;
                    bf16_t* qp = q + ((size_t)(b * NH + h) * SQ + sq) * 96; const f32x4 v0 = acc[ai][bj][m][0], v1 = acc[ai][bj][m][1];
                    if (wc < 2) { const int d0 = wc * 32 + 8 * fq; const f32x4 g0 = *(const f32x4*)(qnorm + d0), g1 = *(const f32x4*)(qnorm + d0 + 4);
                        u32x4 w; w[0] = cvt_pk_bf16(v0[0] * sc * g0[0], v0[1] * sc * g0[1]); w[1] = cvt_pk_bf16(v0[2] * sc * g0[2], v0[3] * sc * g0[3]);
                        w[2] = cvt_pk_bf16(v1[0] * sc * g1[0], v1[1] * sc * g1[1]); w[3] = cvt_pk_bf16(v1[2] * sc * g1[2], v1[3] * sc * g1[3]);
                        *(u32x4*)(qp + d0) = w; }
                    else { const f32x4 c4 = cq[m], s4 = sq_[m];
                        const f32x4 g1 = *(const f32x4*)(qnorm + 64 + 4 * fq), g2 = *(const f32x4*)(qnorm + 80 + 4 * fq); float o1[4], o2[4];
#pragma unroll
                        for (int j = 0; j < 4; ++j) { const float x1 = v0[j] * sc * g1[j], x2 = v1[j] * sc * g2[j]; o1[j] = x1 * c4[j] - x2 * s4[j]; o2[j] = x1 * s4[j] + x2 * c4[j]; }
                        u32x2 w1, w2; w1[0] = cvt_pk_bf16(o1[0], o1[1]); w1[1] = cvt_pk_bf16(o1[2], o1[3]); w2[0] = cvt_pk_bf16(o2[0], o2[1]); w2[1] = cvt_pk_bf16(o2[2], o2[3]);
                        *(u32x2*)(qp + 64 + 4 * fq) = w1; *(u32x2*)(qp + 80 + 4 * fq) = w2; } }
                asm volatile("" ::: "memory"); } }
    }
};
struct EpiKV { LAS unsigned char* lds; const float* ssqp; const float* pessq; const float* ropek; const float* knorm; bf16_t* k; bf16_t* v;
    __device__ __forceinline__ void operator()(const f32x4 (&acc)[2][2][4][2], const Unit& u, int wr, int wc, int fr, int fq) const {
        const MlaXchg X = mla_xchg(lds); const int tid = otid();
        int lb = wr * 64 + fr; asm volatile("" : "+v"(lb));
        if (tid < 256) { float ss = 0.f;
#pragma unroll
            for (int sl = 12; sl < 20; ++sl) ss += ssqp[(size_t)sl * T + u.row0 + tid];
            X.rr[tid] = rsqrtf(ss * (1.f / KVL) + EPS); X.pe[tid] = pessq[u.row0 + tid]; }
        if (wc < 2) { LAS float* pw = X.part + wc * 512 + lb;
#pragma unroll
            for (int ai = 0; ai < 2; ++ai)
#pragma unroll
                for (int m = 0; m < 4; ++m)
#pragma unroll
                    for (int bj = 0; bj < 2; ++bj) { const f32x4 v0 = acc[ai][bj][m][0], v1 = acc[ai][bj][m][1]; float ss = 0.f;
#pragma unroll
                        for (int j = 0; j < 4; ++j) ss += v0[j] * v0[j] + v1[j] * v1[j];
                        ss = quad_sum(ss); if (fq == 0) pw[bj * 256 + ai * 128 + m * 16] = ss; } }
        asm volatile("s_waitcnt lgkmcnt(0)" ::: "memory"); __builtin_amdgcn_s_barrier();
        const int b = u.row0 >> 11; const LAS float* pr = X.part + lb; const LAS float* prr = X.rr + lb; const LAS float* ppe = X.pe + lb;
        f32x4 rks[8];
        if (wc >= 2) {
#pragma unroll
            for (int g = 0; g < 8; ++g) rks[g] = *(const f32x4*)(ropek + (size_t)(u.row0 + (g >> 2) * 128 + (g & 3) * 16 + lb) * 32 + (wc - 2) * 16 + 4 * fq); }
#pragma unroll
        for (int ai = 0; ai < 2; ++ai)
#pragma unroll
            for (int m = 0; m < 4; ++m) { const int rl = ai * 128 + m * 16 + lb; const int row = u.row0 + rl, sq = row & 2047; const float r = prr[ai * 128 + m * 16], pes = ppe[ai * 128 + m * 16];
#pragma unroll
                for (int bj = 0; bj < 2; ++bj) { const float tot = pr[(0 * 2 + bj) * 256 + ai * 128 + m * 16] + pr[(1 * 2 + bj) * 256 + ai * 128 + m * 16];
                    const float rh = rsqrtf((r * r * tot + pes) * (1.f / 96.f) + EPS); const int h = u.pn * 2 + bj; const size_t hs = (size_t)(b * NH + h) * SQ + sq;
                    const f32x4 v0 = acc[ai][bj][m][0], v1 = acc[ai][bj][m][1];
                    if (wc < 2) { const int d0 = wc * 32 + 8 * fq; const float sc = r * rh; const f32x4 g0 = *(const f32x4*)(knorm + d0), g1 = *(const f32x4*)(knorm + d0 + 4);
                        u32x4 w; w[0] = cvt_pk_bf16(v0[0] * sc * g0[0], v0[1] * sc * g0[1]); w[1] = cvt_pk_bf16(v0[2] * sc * g0[2], v0[3] * sc * g0[3]);
                        w[2] = cvt_pk_bf16(v1[0] * sc * g1[0], v1[1] * sc * g1[1]); w[3] = cvt_pk_bf16(v1[2] * sc * g1[2], v1[3] * sc * g1[3]);
                        *(u32x4*)(k + kidx(b * NH + h, sq, d0)) = w; }
                    else { const int d0 = (wc - 2) * 32 + 8 * fq;
                        u32x4 w; w[0] = cvt_pk_bf16(v0[0] * r, v0[1] * r); w[1] = cvt_pk_bf16(v0[2] * r, v0[3] * r); w[2] = cvt_pk_bf16(v1[0] * r, v1[1] * r); w[3] = cvt_pk_bf16(v1[2] * r, v1[3] * r);
                        *(u32x4*)(v + vidx(b * NH + h, sq, d0)) = w;
                        const int e0 = (wc - 2) * 16 + 4 * fq; const f32x4 rk = rks[ai * 4 + m];
                        u32x2 w2; w2[0] = cvt_pk_bf16(rk[0] * rh, rk[1] * rh); w2[1] = cvt_pk_bf16(rk[2] * rh, rk[3] * rh);
                        *(u32x2*)(k + kidx(b * NH + h, sq, 64 + e0)) = w2; } }
                asm volatile("" ::: "memory"); }
    }
};
struct GateSched { const char* A; const char* B; int G, c;
    __device__ __forceinline__ bool next(int i, Unit& u) const {
        const int L = i * G + c; if (L >= 2048) return false;
        const int nb = L >> 9, r = L & 511; u.pm = r >> 2; u.pn = r & 3; u.e = nb; u.row0 = u.pm * 256; u.rows = nullptr; u.nvalid = 256;
        u.a = A + ((size_t)u.pm * 256 * 1024 + nb * 256) * 2; u.b = B + ((size_t)nb * 1024 + u.pn * 256) * 256 * 2; return true; }
};
struct EpiGate { const bf16_t* xc; const float* brf; const float* bif; const float* brb; const float* bib; const float* spl; unsigned* sf; unsigned* sb;
    __device__ __forceinline__ void operator()(const f32x4 (&acc)[2][2][4][2], const Unit& u, int wr, int wc, int fr, int fq) const {
        int lb = wr * 64 + fr; asm volatile("" : "+v"(lb));
        const int c0 = u.e * 256 + u.pn * 64 + wc * 16 + 4 * fq;
        const f32x4 b0 = *(const f32x4*)(brf + c0) * -1.4426950408889634f, b1 = *(const f32x4*)(bif + c0) * -1.4426950408889634f, b2 = *(const f32x4*)(brb + c0) * -1.4426950408889634f, b3 = *(const f32x4*)(bib + c0) * -1.4426950408889634f;
        const f32x4 pf = *(const f32x4*)(spl + c0), pb = *(const f32x4*)(spl + 1024 + c0);
        u32x2 xws[8];
#pragma unroll
        for (int g = 0; g < 8; ++g) xws[g] = *(const u32x2*)(xc + (size_t)(u.row0 + (g >> 2) * 128 + (g & 3) * 16 + lb) * D + c0);
#pragma unroll
        for (int ai = 0; ai < 2; ++ai)
#pragma unroll
            for (int m = 0; m < 4; ++m) { const int row = u.row0 + ai * 128 + m * 16 + lb, sq = row & 2047; const size_t o = (size_t)row * D + c0;
                const u32x2 xw = xws[ai * 4 + m]; const float x[4] = {__uint_as_float(xw[0] << 16), __uint_as_float(xw[0] & 0xffff0000u), __uint_as_float(xw[1] << 16), __uint_as_float(xw[1] & 0xffff0000u)};
                u32x4 wf, wb;
#pragma unroll
                for (int j = 0; j < 4; ++j) {
                    const float rf = frcp(1.f + __builtin_amdgcn_exp2f(acc[ai][0][m][0][j] + b0[j])), jf = frcp(1.f + __builtin_amdgcn_exp2f(acc[ai][0][m][1][j] + b1[j]));
                    const float rb = frcp(1.f + __builtin_amdgcn_exp2f(acc[ai][1][m][0][j] + b2[j])), jb = frcp(1.f + __builtin_amdgcn_exp2f(acc[ai][1][m][1][j] + b3[j]));
                    const float af = __builtin_amdgcn_exp2f(pf[j] * rf), ab = __builtin_amdgcn_exp2f(pb[j] * rb);
                    const float omf = 1.f - af, omb = 1.f - ab;
                    const float mf = (sq == 0) ? 1.f : __builtin_amdgcn_sqrtf(omf * (1.f + af)), mb = (sq == SQ - 1) ? 1.f : __builtin_amdgcn_sqrtf(omb * (1.f + ab));
                    wf[j] = cvt_pk_bf16(omf, mf * jf * x[j]); wb[j] = cvt_pk_bf16(omb, mb * jb * x[j]); }
                *(u32x4*)(sf + o) = wf; *(u32x4*)(sb + o) = wb;
                asm volatile("" ::: "memory"); }
    }
};
}

namespace att {
typedef float f32x16 __attribute__((ext_vector_type(16)));
typedef short s16x4 __attribute__((ext_vector_type(4)));
typedef short v4i16_t __attribute__((ext_vector_type(4)));
constexpr int NSLOT = 3, KSLOT = 12288, VSLOT = 8192, LDS_K = 0, LDS_V = NSLOT * KSLOT, LDS_WS = LDS_V + NSLOT * VSLOT, LDS_OST = LDS_WS + 8 * 256;
constexpr float THR = 8.f;
__device__ __forceinline__ int crow(int r, int hi) { return (r & 3) + 8 * (r >> 2) + 4 * hi; }
typedef float f32x2_t __attribute__((ext_vector_type(2))); typedef __bf16 bf16x2_t __attribute__((ext_vector_type(2)));
__device__ __forceinline__ unsigned cvtpk(float lo, float hi) { f32x2_t v = {lo, hi}; bf16x2_t b = __builtin_convertvector(v, bf16x2_t); return __builtin_bit_cast(unsigned, b); }
__device__ __forceinline__ s16x4 vtr(const LAS unsigned char* p) { return __builtin_bit_cast(s16x4, __builtin_amdgcn_ds_read_tr16_b64_v4i16((LAS v4i16_t*)p)); }

__device__ __forceinline__ float max3f(float a, float b, float c) { return __builtin_fmaxf(__builtin_fmaxf(a, b), c); }
__device__ __forceinline__ float rowmax32(const f32x16& p0, const f32x16& p1) {
    float a = max3f(p0[0], p0[1], p1[0]), b = max3f(p0[2], p0[3], p1[1]); a = max3f(a, p1[2], p1[3]);
#pragma unroll
    for (int r = 4; r < 16; r += 4) { a = max3f(a, p0[r], p0[r + 1]); b = max3f(b, p0[r + 2], p0[r + 3]); a = max3f(a, p1[r], p1[r + 1]); b = max3f(b, p1[r + 2], p1[r + 3]); }
    float m = fmaxf(a, b);
    auto rr = __builtin_amdgcn_permlane32_swap(__float_as_uint(m), __float_as_uint(m), false, false);
    return fmaxf(__uint_as_float(rr[0]), __uint_as_float(rr[1]));
}
__device__ __forceinline__ void attn_unit(int bh, int qb, const bf16_t* Q, const bf16_t* K, const bf16_t* V, bf16_t* O, LAS unsigned char* lds) {
    const int tid = otid(), lane = tid & 63, r32 = lane & 31, hi = lane >> 5; const int wid = __builtin_amdgcn_readfirstlane(tid >> 6);
    const bf16_t* Kh = K + (size_t)bh * SQ * 96; const bf16_t* Vh = V + (size_t)bh * SQ * 64;
    const bf16_t* Qw = Q + ((size_t)bh * SQ + qb * 256 + wid * 32) * 96;
    LAS float* wsf = (LAS float*)(lds + LDS_WS) + wid * 64;
    const bf16_t* ksrc0 = Kh + (size_t)lane * 96 + wid * 8;
    const bf16_t* ksrc1 = Kh + (size_t)lane * 96 + (wid + 8) * 8;
    const bf16_t* vsrc = Vh + (size_t)(16 * (wid & 3) + (lane >> 2)) * 64 + (wid >> 2) * 32 + (lane & 3) * 8;
#define ATT_DMA_K(t, slot) do { \
        __builtin_amdgcn_global_load_lds((const unsigned*)(ksrc0 + (size_t)(t) * 64 * 96), (LAS unsigned*)(lds + LDS_K + (slot) * KSLOT + wid * 1024), 16, 0, 0); \
        if (wid < 4) __builtin_amdgcn_global_load_lds((const unsigned*)(ksrc1 + (size_t)(t) * 64 * 96), (LAS unsigned*)(lds + LDS_K + (slot) * KSLOT + (wid + 8) * 1024), 16, 0, 0); } while (0)
#define ATT_DMA_V(t, slot) __builtin_amdgcn_global_load_lds((const unsigned*)(vsrc + (size_t)(t) * 64 * 64), (LAS unsigned*)(lds + LDS_V + (slot) * VSLOT + wid * 1024), 16, 0, 0)
    ATT_DMA_K(0, 0); ATT_DMA_V(0, 0); ATT_DMA_K(1, 1);
    bf16x8 qr[6];
#pragma unroll
    for (int d0 = 0; d0 < 6; ++d0) qr[d0] = *(const bf16x8*)(Qw + (size_t)r32 * 96 + d0 * 16 + hi * 8);
    f32x16 o[2], negm;
#pragma unroll
    for (int r = 0; r < 16; ++r) { o[0][r] = 0.f; o[1][r] = 0.f; negm[r] = 0.f; }
    float mhat = 0.f, l = 0.f;
    const int kfo = hi * 1024 + r32 * 16;
    const int vfo = ((lane >> 4) & 1) * 32 + (lane & 3) * 8 + (4 * hi + ((lane & 15) >> 2)) * 64;
    asm volatile("s_waitcnt vmcnt(0)" ::: "memory"); __builtin_amdgcn_s_barrier();
    constexpr int NT = SQ / 64;
    f32x16 pA0, pA1, pB0, pB1;
    bool resc = false;
#define ATT_QK(C0, C1, slot) do { const LAS unsigned char* kb_ = lds + LDS_K + (slot) * KSLOT + kfo; C0 = negm; C1 = negm; \
        _Pragma("unroll") for (int d0 = 0; d0 < 6; ++d0) { const bf16x8 b0_ = *(const LAS bf16x8*)(kb_ + d0 * 2048), b1_ = *(const LAS bf16x8*)(kb_ + d0 * 2048 + 512); \
            C0 = __builtin_amdgcn_mfma_f32_32x32x16_bf16(b0_, qr[d0], C0, 0, 0, 0); C1 = __builtin_amdgcn_mfma_f32_32x32x16_bf16(b1_, qr[d0], C1, 0, 0, 0); } } while (0)
#define ATT_DECIDE(C0, C1) do { const float rm_ = rowmax32(C0, C1); resc = false; \
        if (__builtin_expect(__any(rm_ > THR), 0)) { const float dl_ = fmaxf(rm_, 0.f); mhat += dl_; \
            _Pragma("unroll") for (int r = 0; r < 16; ++r) { C0[r] -= dl_; C1[r] -= dl_; negm[r] = -mhat; } \
            const float f_ = __builtin_amdgcn_exp2f(-dl_); l *= f_; if (hi == 0) wsf[r32] = f_; resc = true; } } while (0)
#define ATT_EXP(C0, C1) do { _Pragma("unroll") for (int r = 0; r < 16; ++r) { C0[r] = __builtin_amdgcn_exp2f(C0[r]); C1[r] = __builtin_amdgcn_exp2f(C1[r]); } } while (0)
#define ATT_PACK(P0, P1) do { float s_ = 0.f; _Pragma("unroll") for (int r = 0; r < 16; ++r) s_ += P0[r] + P1[r]; l += s_; \
        _Pragma("unroll") for (int i = 0; i < 4; ++i) { pw0[i] = cvtpk(P0[2 * i], P0[2 * i + 1]); pw1[i] = cvtpk(P0[8 + 2 * i], P0[8 + 2 * i + 1]); pw2[i] = cvtpk(P1[2 * i], P1[2 * i + 1]); pw3[i] = cvtpk(P1[8 + 2 * i], P1[8 + 2 * i + 1]); } } while (0)
#define ATT_VLOAD(slot) do { const LAS unsigned char* vb_ = lds + LDS_V + (slot) * VSLOT + vfo; \
        _Pragma("unroll") for (int i = 0; i < 8; ++i) { vlo[i] = vtr(vb_ + (i >> 2) * 4096 + (i & 3) * 1024); vhi[i] = vtr(vb_ + (i >> 2) * 4096 + (i & 3) * 1024 + 512); } } while (0)
#define ATT_VF(i) (bf16x8){vlo[i][0], vlo[i][1], vlo[i][2], vlo[i][3], vhi[i][0], vhi[i][1], vhi[i][2], vhi[i][3]}
#define ATT_PVEXP(C0, C1) do { \
        o[0] = __builtin_amdgcn_mfma_f32_32x32x16_bf16(__builtin_bit_cast(bf16x8, pw0), ATT_VF(0), o[0], 0, 0, 0); C0[0] = __builtin_amdgcn_exp2f(C0[0]); C0[1] = __builtin_amdgcn_exp2f(C0[1]); C0[2] = __builtin_amdgcn_exp2f(C0[2]); C0[3] = __builtin_amdgcn_exp2f(C0[3]); \
        o[1] = __builtin_amdgcn_mfma_f32_32x32x16_bf16(__builtin_bit_cast(bf16x8, pw0), ATT_VF(4), o[1], 0, 0, 0); C0[4] = __builtin_amdgcn_exp2f(C0[4]); C0[5] = __builtin_amdgcn_exp2f(C0[5]); C0[6] = __builtin_amdgcn_exp2f(C0[6]); C0[7] = __builtin_amdgcn_exp2f(C0[7]); \
        o[0] = __builtin_amdgcn_mfma_f32_32x32x16_bf16(__builtin_bit_cast(bf16x8, pw1), ATT_VF(1), o[0], 0, 0, 0); C0[8] = __builtin_amdgcn_exp2f(C0[8]); C0[9] = __builtin_amdgcn_exp2f(C0[9]); C0[10] = __builtin_amdgcn_exp2f(C0[10]); C0[11] = __builtin_amdgcn_exp2f(C0[11]); \
        o[1] = __builtin_amdgcn_mfma_f32_32x32x16_bf16(__builtin_bit_cast(bf16x8, pw1), ATT_VF(5), o[1], 0, 0, 0); C0[12] = __builtin_amdgcn_exp2f(C0[12]); C0[13] = __builtin_amdgcn_exp2f(C0[13]); C0[14] = __builtin_amdgcn_exp2f(C0[14]); C0[15] = __builtin_amdgcn_exp2f(C0[15]); \
        o[0] = __builtin_amdgcn_mfma_f32_32x32x16_bf16(__builtin_bit_cast(bf16x8, pw2), ATT_VF(2), o[0], 0, 0, 0); C1[0] = __builtin_amdgcn_exp2f(C1[0]); C1[1] = __builtin_amdgcn_exp2f(C1[1]); C1[2] = __builtin_amdgcn_exp2f(C1[2]); C1[3] = __builtin_amdgcn_exp2f(C1[3]); \
        o[1] = __builtin_amdgcn_mfma_f32_32x32x16_bf16(__builtin_bit_cast(bf16x8, pw2), ATT_VF(6), o[1], 0, 0, 0); C1[4] = __builtin_amdgcn_exp2f(C1[4]); C1[5] = __builtin_amdgcn_exp2f(C1[5]); C1[6] = __builtin_amdgcn_exp2f(C1[6]); C1[7] = __builtin_amdgcn_exp2f(C1[7]); \
        o[0] = __builtin_amdgcn_mfma_f32_32x32x16_bf16(__builtin_bit_cast(bf16x8, pw3), ATT_VF(3), o[0], 0, 0, 0); C1[8] = __builtin_amdgcn_exp2f(C1[8]); C1[9] = __builtin_amdgcn_exp2f(C1[9]); C1[10] = __builtin_amdgcn_exp2f(C1[10]); C1[11] = __builtin_amdgcn_exp2f(C1[11]); \
        o[1] = __builtin_amdgcn_mfma_f32_32x32x16_bf16(__builtin_bit_cast(bf16x8, pw3), ATT_VF(7), o[1], 0, 0, 0); C1[12] = __builtin_amdgcn_exp2f(C1[12]); C1[13] = __builtin_amdgcn_exp2f(C1[13]); C1[14] = __builtin_amdgcn_exp2f(C1[14]); C1[15] = __builtin_amdgcn_exp2f(C1[15]); \
        _Pragma("unroll") for (int g_ = 0; g_ < 8; ++g_) { __builtin_amdgcn_sched_group_barrier(0x8, 1, 0); __builtin_amdgcn_sched_group_barrier(0x2, 4, 0); } } while (0)
#define ATT_PV() do { \
        _Pragma("unroll") for (int i = 0; i < 8; ++i) { const int d0_ = i >> 2, ks_ = i & 3; const u32x4 pw_ = ks_ == 0 ? pw0 : ks_ == 1 ? pw1 : ks_ == 2 ? pw2 : pw3; \
            o[d0_] = __builtin_amdgcn_mfma_f32_32x32x16_bf16(__builtin_bit_cast(bf16x8, pw_), ATT_VF(i), o[d0_], 0, 0, 0); } } while (0)
#define ATT_RESC() do { if (resc) { asm volatile("s_waitcnt lgkmcnt(0)" ::: "memory"); \
        _Pragma("unroll") for (int r = 0; r < 16; ++r) { const float f_ = wsf[crow(r, hi)]; o[0][r] *= f_; o[1][r] *= f_; } } } while (0)
#define ATT_WAITBAR(full) do { if (full) asm volatile("s_waitcnt vmcnt(0) lgkmcnt(0)" ::: "memory"); \
        else if (wid < 4) asm volatile("s_waitcnt vmcnt(3) lgkmcnt(0)" ::: "memory"); else asm volatile("s_waitcnt vmcnt(2) lgkmcnt(0)" ::: "memory"); \
        __builtin_amdgcn_s_barrier(); } while (0)
#define ATT_STEP(C0, C1, P0, P1, t, ks, vs, kn) do { u32x4 pw0, pw1, pw2, pw3; s16x4 vlo[8], vhi[8]; \
        if ((t) + 2 < NT) ATT_DMA_K((t) + 2, vs); if ((t) + 1 < NT) ATT_DMA_V((t) + 1, kn); \
        ATT_QK(C0, C1, ks); ATT_VLOAD(vs); ATT_PACK(P0, P1); ATT_DECIDE(C0, C1); ATT_PVEXP(C0, C1); \
        ATT_WAITBAR((t) + 2 >= NT); ATT_RESC(); } while (0)
    ATT_DMA_K(2, 2); ATT_DMA_V(1, 1);
    ATT_QK(pA0, pA1, 0); ATT_DECIDE(pA0, pA1); ATT_EXP(pA0, pA1);
    ATT_WAITBAR(false);
    int ks = 1, vs = 0, kn = 2;
#pragma unroll 1
    for (int t = 1; t + 1 < NT; t += 2) {
        ATT_STEP(pB0, pB1, pA0, pA1, t, ks, vs, kn);
        vs = ks; ks = kn; kn = kn == 2 ? 0 : kn + 1;
        ATT_STEP(pA0, pA1, pB0, pB1, t + 1, ks, vs, kn);
        vs = ks; ks = kn; kn = kn == 2 ? 0 : kn + 1;
    }
    ATT_STEP(pB0, pB1, pA0, pA1, NT - 1, ks, vs, kn);
    { u32x4 pw0, pw1, pw2, pw3; s16x4 vlo[8], vhi[8]; ATT_VLOAD(ks); ATT_PACK(pB0, pB1); ATT_PV(); }
    { auto rr = __builtin_amdgcn_permlane32_swap(__float_as_uint(l), __float_as_uint(l), false, false); l = __uint_as_float(rr[0]) + __uint_as_float(rr[1]); }
    if (hi == 0) wsf[32 + r32] = l;
    asm volatile("s_waitcnt lgkmcnt(0)" ::: "memory");
    LAS bf16_t* stg = (LAS bf16_t*)(lds + LDS_OST) + wid * 2048;
#pragma unroll
    for (int r = 0; r < 16; ++r) { const int orow = crow(r, hi); const float rl = __builtin_amdgcn_rcpf(wsf[32 + orow]);
        stg[orow * 64 + r32] = f2bf(o[0][r] * rl); stg[orow * 64 + 32 + r32] = f2bf(o[1][r] * rl); }
    asm volatile("s_waitcnt lgkmcnt(0)" ::: "memory");
    const int b = bh >> 4, h = bh & 15;
    bf16_t* Ow = O + ((size_t)b * SQ + qb * 256 + wid * 32) * D + h * 64;
#pragma unroll
    for (int i = 0; i < 4; ++i) { const int row = i * 8 + (lane >> 3), ch = lane & 7; const u32x4 v = *(const LAS u32x4*)(stg + row * 64 + ch * 8); *(u32x4*)(Ow + (size_t)row * D + ch * 8) = v; }
    asm volatile("s_waitcnt lgkmcnt(0)" ::: "memory"); __builtin_amdgcn_s_barrier();
#undef ATT_DMA_K
#undef ATT_DMA_V
#undef ATT_QK
#undef ATT_DECIDE
#undef ATT_EXP
#undef ATT_PACK
#undef ATT_PV
#undef ATT_PVEXP
#undef ATT_VLOAD
#undef ATT_VF
#undef ATT_RESC
#undef ATT_WAITBAR
#undef ATT_STEP
}
#define SBAR() __builtin_amdgcn_sched_barrier(0)
#define PINV(x) asm volatile("" : "+v"(x))
struct QfArgs { const bf16_t* lat; const bf16_t* wqt; const float* ssqp; const float* qnorm; const float* cs; const float* sn; };
constexpr int LDS_WQ = LDS_OST;
__device__ __forceinline__ int rope_phys_a(int d) { return 8 * ((d >> 2) & 3) + 4 * (d >> 4) + (d & 3); }
template <bool QF>
__device__ __forceinline__ void attn_unit2(int bh, int qb, const bf16_t* Q, const bf16_t* K, const bf16_t* V, bf16_t* O, LAS unsigned char* lds, const float smax, const QfArgs& qa, bf16x8 (&lf)[24], const bf16_t* lat_next) {
    const int tid = otid(), lane = tid & 63, r32 = lane & 31, hi = lane >> 5; const int wid = __builtin_amdgcn_readfirstlane(tid >> 6);
    const bf16_t* Kh = K + (size_t)bh * SQ * 96; const bf16_t* Vh = V + (size_t)bh * SQ * 64;
    const bf16_t* Qw = Q + ((size_t)bh * SQ + qb * 256 + wid * 32) * 96;
    LAS float* wsf = (LAS float*)(lds + LDS_WS) + wid * 64;
    const bf16_t* ksrc0 = Kh + (size_t)wid * 512 + lane * 8;
    const bf16_t* ksrc1 = Kh + (size_t)(wid + 8) * 512 + lane * 8;
    const bf16_t* vsrc = Vh + (size_t)(wid >> 2) * 2048 + (16 * (wid & 3) + (lane >> 2)) * 32 + (lane & 3) * 8;
#define A2_GLDS(gsrc, ldsaddr) do { unsigned keep_; asm volatile("s_mov_b32 %0, m0\n\ts_mov_b32 m0, %2\n\ts_nop 0\n\tglobal_load_lds_dwordx4 %1, off\n\ts_mov_b32 m0, %0" : "=&s"(keep_) : "v"(gsrc), "s"((unsigned)__builtin_amdgcn_readfirstlane((int)(ldsaddr))) : "memory"); } while (0)
    const unsigned lds0 = (unsigned)(uintptr_t)lds;
#define A2_DMA_K(t, slot) do { \
        A2_GLDS(ksrc0 + (size_t)(t) * 64 * 96, lds0 + LDS_K + (slot) * KSLOT + wid * 1024); \
        if (wid < 4) A2_GLDS(ksrc1 + (size_t)(t) * 64 * 96, lds0 + LDS_K + (slot) * KSLOT + (wid + 8) * 1024); } while (0)
#define A2_DMA_V(t, slot) A2_GLDS(vsrc + (size_t)(t) * 64 * 64, lds0 + LDS_V + (slot) * VSLOT + wid * 1024)
#define A2_WAITBAR(NL, NH) do { if (wid < 4) asm volatile("s_waitcnt vmcnt(" #NL ") lgkmcnt(0)\n\ts_barrier" ::: "memory"); else asm volatile("s_waitcnt vmcnt(" #NH ") lgkmcnt(0)\n\ts_barrier" ::: "memory"); } while (0)
    bf16x8 qr[6];
    if constexpr (!QF) {
#pragma unroll
        for (int d0 = 0; d0 < 6; ++d0) qr[d0] = *(const bf16x8*)(Qw + (size_t)r32 * 96 + d0 * 16 + hi * 8);
        A2_DMA_K(0, 0); A2_DMA_V(0, 0); A2_DMA_K(1, 1); A2_DMA_K(2, 2);
    } else {
        const size_t trow = (size_t)(bh >> 4) * SQ + qb * 256 + wid * 32 + r32;
        float ssq_ = 0.f;
#pragma unroll
        for (int sl = 0; sl < 12; ++sl) ssq_ += qa.ssqp[(size_t)sl * T + trow];
        const f32x4 c0 = *(const f32x4*)(qa.cs + trow * 16 + 4 * hi), c1 = *(const f32x4*)(qa.cs + trow * 16 + 8 + 4 * hi);
        const f32x4 s0 = *(const f32x4*)(qa.sn + trow * 16 + 4 * hi), s1 = *(const f32x4*)(qa.sn + trow * 16 + 8 + 4 * hi);
        A2_DMA_K(0, 0); A2_DMA_V(0, 0); A2_DMA_K(1, 1); A2_DMA_K(2, 2);
        f32x16 dq[3];
#pragma unroll
        for (int r = 0; r < 16; ++r) { dq[0][r] = 0.f; dq[1][r] = 0.f; dq[2][r] = 0.f; }
        const LAS unsigned char* wq0 = lds + LDS_WQ + lane * 16;
        bf16x8 wa[3], wb[3];
#define A2_WQLD(W, ks) do { W[0] = *(const LAS bf16x8*)(wq0 + (ks) * 1024); W[1] = *(const LAS bf16x8*)(wq0 + 24576 + (ks) * 1024); W[2] = *(const LAS bf16x8*)(wq0 + 49152 + (ks) * 1024); } while (0)
#define A2_WQMM(W, ks) do { dq[0] = __builtin_amdgcn_mfma_f32_32x32x16_bf16(W[0], lf[ks], dq[0], 0, 0, 0); dq[1] = __builtin_amdgcn_mfma_f32_32x32x16_bf16(W[1], lf[ks], dq[1], 0, 0, 0); dq[2] = __builtin_amdgcn_mfma_f32_32x32x16_bf16(W[2], lf[ks], dq[2], 0, 0, 0); } while (0)
        A2_WQLD(wa, 0); SBAR();
#pragma unroll
        for (int ks = 0; ks < 24; ks += 2) {
            A2_WQLD(wb, ks + 1); SBAR(); A2_WQMM(wa, ks); SBAR();
            if (ks + 2 < 24) { A2_WQLD(wa, ks + 2); SBAR(); } A2_WQMM(wb, ks + 1); SBAR(); }
#undef A2_WQLD
#undef A2_WQMM
        const float rq = rsqrtf(ssq_ * (1.f / QL) + EPS);
        float tot = 0.f;
#pragma unroll
        for (int blk = 0; blk < 3; ++blk)
#pragma unroll
            for (int r = 0; r < 16; ++r) tot += dq[blk][r] * dq[blk][r];
        { auto rr = __builtin_amdgcn_permlane32_swap(__float_as_uint(tot), __float_as_uint(tot), false, false); tot = __uint_as_float(rr[0]) + __uint_as_float(rr[1]); }
        const float scq = rq * rsqrtf(rq * rq * tot * (1.f / 96.f) + EPS) * QSCALE;
#pragma unroll
        for (int blk = 0; blk < 3; ++blk)
#pragma unroll
            for (int k = 0; k < 4; ++k) { const f32x4 g = *(const LAS f32x4*)(lds + LDS_WQ + 73728 + (32 * blk + 8 * k + 4 * hi) * 4);
#pragma unroll
                for (int j = 0; j < 4; ++j) dq[blk][4 * k + j] *= scq * g[j]; }
#pragma unroll
        for (int r = 0; r < 8; ++r) { const float c = r < 4 ? c0[r & 3] : c1[r & 3], sv = r < 4 ? s0[r & 3] : s1[r & 3];
            const float x1 = dq[2][r], x2 = dq[2][r + 8]; dq[2][r] = x1 * c - x2 * sv; dq[2][r + 8] = x1 * sv + x2 * c; }
#pragma unroll
        for (int blk = 0; blk < 3; ++blk)
#pragma unroll
            for (int s2 = 0; s2 < 2; ++s2) {
                const unsigned a0 = cvtpk(dq[blk][8 * s2 + 0], dq[blk][8 * s2 + 1]), a1 = cvtpk(dq[blk][8 * s2 + 2], dq[blk][8 * s2 + 3]);
                const unsigned b0 = cvtpk(dq[blk][8 * s2 + 4], dq[blk][8 * s2 + 5]), b1 = cvtpk(dq[blk][8 * s2 + 6], dq[blk][8 * s2 + 7]);
                const unsigned x0 = hi ? a0 : b0, x1 = hi ? a1 : b1;
                const unsigned y0 = (unsigned)__shfl_xor((int)x0, 32), y1 = (unsigned)__shfl_xor((int)x1, 32);
                u32x4 w; w[0] = hi ? y0 : a0; w[1] = hi ? y1 : a1; w[2] = hi ? b0 : y0; w[3] = hi ? b1 : y1;
                qr[2 * blk + s2] = __builtin_bit_cast(bf16x8, w); }
    }
    f32x16 o[2], negm;
#pragma unroll
    for (int r = 0; r < 16; ++r) { o[0][r] = 0.f; o[1][r] = 0.f; negm[r] = -smax; }
    PINV(negm);
    float l_reg = 0.f;
    const LAS unsigned char* kp0 = lds + LDS_K + hi * 1024 + r32 * 16;
    const LAS unsigned char* vp0 = lds + LDS_V + ((lane >> 4) & 1) * 32 + (lane & 3) * 8 + (4 * hi + ((lane & 15) >> 2)) * 64;
    constexpr int NT = SQ / 64;
    bf16x8 kf[12];
#define A2_KLOAD2(slot, j) do { kf[2 * (j)] = *(const LAS bf16x8*)(kp0 + (slot) * KSLOT + (j) * 2048); kf[2 * (j) + 1] = *(const LAS bf16x8*)(kp0 + (slot) * KSLOT + (j) * 2048 + 512); } while (0)
    f32x16 pA0, pA1, pB0, pB1;
    A2_WAITBAR(5, 3);
#pragma unroll
    for (int j = 0; j < 6; ++j) A2_KLOAD2(0, j);
    pA0 = negm; pA1 = negm;
#pragma unroll
    for (int d0 = 0; d0 < 6; ++d0) { pA0 = __builtin_amdgcn_mfma_f32_32x32x16_bf16(kf[2 * d0], qr[d0], pA0, 0, 0, 0); pA1 = __builtin_amdgcn_mfma_f32_32x32x16_bf16(kf[2 * d0 + 1], qr[d0], pA1, 0, 0, 0); }
#pragma unroll
    for (int r = 0; r < 16; ++r) { pA0[r] = __builtin_amdgcn_exp2f(pA0[r]); if (r < 8) pA1[r] = __builtin_amdgcn_exp2f(pA1[r]); }
    A2_WAITBAR(0, 0);
    A2_DMA_K(3, 0); A2_DMA_V(1, 1);
    int sp = 0, sc = 1, sn = 2;
#pragma unroll
    for (int j = 0; j < 6; ++j) A2_KLOAD2(sc, j);
    A2_WAITBAR(3, 2);
#define A2_VRD(i) do { vlo[i] = vtr(vp_ + ((i) >> 2) * 4096 + ((i) & 3) * 1024); vhi[i] = vtr(vp_ + ((i) >> 2) * 4096 + ((i) & 3) * 1024 + 512); } while (0)
#define A2_VF(i) (bf16x8){vlo[i][0], vlo[i][1], vlo[i][2], vlo[i][3], vhi[i][0], vhi[i][1], vhi[i][2], vhi[i][3]}
#define A2_PAF(k) __builtin_bit_cast(bf16x8, pw##k)
#define A2_GAPA(MF, A0, A1, A2_, W0, W1) do { MF; sacc += A0; sacc += A1; sacc += A2_; PINV(sacc); W0; W1; SBAR(); } while (0)
#define A2_EX4(X, B) do { X[B] = __builtin_amdgcn_exp2f(X[B]); X[B + 1] = __builtin_amdgcn_exp2f(X[B + 1]); X[B + 2] = __builtin_amdgcn_exp2f(X[B + 2]); X[B + 3] = __builtin_amdgcn_exp2f(X[B + 3]); PINV(X); } while (0)
#define A2_EX3(a, b, c) do { a = __builtin_amdgcn_exp2f(a); b = __builtin_amdgcn_exp2f(b); c = __builtin_amdgcn_exp2f(c); } while (0)
#define A2_NOP do { } while (0)
#define A2_STEP(C0, C1, P0, P1, t) do { SBAR(); \
        const LAS unsigned char* vp_ = vp0 + sp * VSLOT; s16x4 vlo[8], vhi[8]; u32x4 pw0, pw1, pw2, pw3; \
        const bool gk_ = (t) + 3 < NT, gv_ = (t) + 1 < NT; \
        A2_VRD(0); SBAR(); float sacc = P0[0] + P0[1]; \
        P1[8] = __builtin_amdgcn_exp2f(P1[8]); P1[9] = __builtin_amdgcn_exp2f(P1[9]); PINV(P1); A2_GAPA(C0 = __builtin_amdgcn_mfma_f32_32x32x16_bf16(kf[0], qr[0], negm, 0, 0, 0), P0[2], P0[3], P0[4], pw0[0] = cvtpk(P0[0], P0[1]), pw0[1] = cvtpk(P0[2], P0[3])); \
        A2_VRD(4); SBAR(); P1[10] = __builtin_amdgcn_exp2f(P1[10]); P1[11] = __builtin_amdgcn_exp2f(P1[11]); PINV(P1); A2_GAPA(C1 = __builtin_amdgcn_mfma_f32_32x32x16_bf16(kf[1], qr[0], negm, 0, 0, 0), P0[5], P0[6], P0[7], pw0[2] = cvtpk(P0[4], P0[5]), pw0[3] = cvtpk(P0[6], P0[7])); \
        A2_VRD(1); SBAR(); P1[12] = __builtin_amdgcn_exp2f(P1[12]); P1[13] = __builtin_amdgcn_exp2f(P1[13]); PINV(P1); A2_GAPA(C0 = __builtin_amdgcn_mfma_f32_32x32x16_bf16(kf[2], qr[1], C0, 0, 0, 0), P0[8], P0[9], P0[10], pw1[0] = cvtpk(P0[8], P0[9]), pw1[1] = cvtpk(P0[10], P0[11])); \
        A2_VRD(5); SBAR(); P1[14] = __builtin_amdgcn_exp2f(P1[14]); P1[15] = __builtin_amdgcn_exp2f(P1[15]); PINV(P1); A2_GAPA(C1 = __builtin_amdgcn_mfma_f32_32x32x16_bf16(kf[3], qr[1], C1, 0, 0, 0), P0[11], P0[12], P0[13], pw1[2] = cvtpk(P0[12], P0[13]), pw1[3] = cvtpk(P0[14], P0[15])); \
        A2_VRD(2); SBAR(); A2_GAPA(C0 = __builtin_amdgcn_mfma_f32_32x32x16_bf16(kf[4], qr[2], C0, 0, 0, 0), P0[14], P0[15], P1[0], pw2[0] = cvtpk(P1[0], P1[1]), pw2[1] = cvtpk(P1[2], P1[3])); \
        A2_VRD(6); SBAR(); A2_GAPA(C1 = __builtin_amdgcn_mfma_f32_32x32x16_bf16(kf[5], qr[2], C1, 0, 0, 0), P1[1], P1[2], P1[3], pw2[2] = cvtpk(P1[4], P1[5]), pw2[3] = cvtpk(P1[6], P1[7])); \
        A2_VRD(3); SBAR(); A2_GAPA(C0 = __builtin_amdgcn_mfma_f32_32x32x16_bf16(kf[6], qr[3], C0, 0, 0, 0), P1[4], P1[5], P1[6], pw3[0] = cvtpk(P1[8], P1[9]), pw3[1] = cvtpk(P1[10], P1[11])); \
        A2_VRD(7); SBAR(); A2_GAPA(C1 = __builtin_amdgcn_mfma_f32_32x32x16_bf16(kf[7], qr[3], C1, 0, 0, 0), P1[7], P1[8], P1[9], pw3[2] = cvtpk(P1[12], P1[13]), pw3[3] = cvtpk(P1[14], P1[15])); \
        A2_GAPA(C0 = __builtin_amdgcn_mfma_f32_32x32x16_bf16(kf[8], qr[4], C0, 0, 0, 0), P1[10], P1[11], P1[12], A2_NOP, A2_NOP); \
        A2_GAPA(C1 = __builtin_amdgcn_mfma_f32_32x32x16_bf16(kf[9], qr[4], C1, 0, 0, 0), P1[13], P1[14], P1[15], A2_NOP, A2_NOP); \
        if (gk_) { A2_DMA_K((t) + 3, sc); } if (gv_) { A2_DMA_V((t) + 1, sn); } SBAR(); \
        C0 = __builtin_amdgcn_mfma_f32_32x32x16_bf16(kf[10], qr[5], C0, 0, 0, 0); C1 = __builtin_amdgcn_mfma_f32_32x32x16_bf16(kf[11], qr[5], C1, 0, 0, 0); SBAR(); \
        l_reg += sacc; SBAR(); \
        o[0] = __builtin_amdgcn_mfma_f32_32x32x16_bf16(A2_PAF(0), A2_VF(0), o[0], 0, 0, 0); A2_EX3(C0[0], C0[1], C0[2]); PINV(C0); SBAR(); \
        o[1] = __builtin_amdgcn_mfma_f32_32x32x16_bf16(A2_PAF(0), A2_VF(4), o[1], 0, 0, 0); A2_EX3(C0[3], C0[4], C0[5]); PINV(C0); SBAR(); \
        if (gv_) { A2_KLOAD2(sn, 0); SBAR(); } o[0] = __builtin_amdgcn_mfma_f32_32x32x16_bf16(A2_PAF(1), A2_VF(1), o[0], 0, 0, 0); A2_EX3(C0[6], C0[7], C0[8]); PINV(C0); SBAR(); \
        if (gv_) { A2_KLOAD2(sn, 1); SBAR(); } o[1] = __builtin_amdgcn_mfma_f32_32x32x16_bf16(A2_PAF(1), A2_VF(5), o[1], 0, 0, 0); A2_EX3(C0[9], C0[10], C0[11]); PINV(C0); SBAR(); \
        if (gv_) { A2_KLOAD2(sn, 2); SBAR(); } o[0] = __builtin_amdgcn_mfma_f32_32x32x16_bf16(A2_PAF(2), A2_VF(2), o[0], 0, 0, 0); A2_EX3(C0[12], C0[13], C0[14]); PINV(C0); SBAR(); \
        if (gv_) { A2_KLOAD2(sn, 3); SBAR(); } o[1] = __builtin_amdgcn_mfma_f32_32x32x16_bf16(A2_PAF(2), A2_VF(6), o[1], 0, 0, 0); A2_EX3(C0[15], C1[0], C1[1]); PINV(C0); PINV(C1); SBAR(); \
        if (gv_) { A2_KLOAD2(sn, 4); SBAR(); } o[0] = __builtin_amdgcn_mfma_f32_32x32x16_bf16(A2_PAF(3), A2_VF(3), o[0], 0, 0, 0); A2_EX3(C1[2], C1[3], C1[4]); PINV(C1); SBAR(); \
        if (gv_) { A2_KLOAD2(sn, 5); SBAR(); } o[1] = __builtin_amdgcn_mfma_f32_32x32x16_bf16(A2_PAF(3), A2_VF(7), o[1], 0, 0, 0); A2_EX3(C1[5], C1[6], C1[7]); PINV(C1); SBAR(); \
        if (gk_) A2_WAITBAR(3, 2); else A2_WAITBAR(0, 0); \
        { const int t_ = sp; sp = sc; sc = sn; sn = t_; } } while (0)
    if (wid < 4) __builtin_amdgcn_s_setprio(1);
#pragma unroll 1
    for (int t = 1; t + 1 < NT; t += 2) { A2_STEP(pB0, pB1, pA0, pA1, t); A2_STEP(pA0, pA1, pB0, pB1, t + 1); }
    __builtin_amdgcn_s_setprio(0);
    A2_STEP(pB0, pB1, pA0, pA1, NT - 1);
    if constexpr (QF) {
#pragma unroll
        for (int ks = 0; ks < 24; ++ks) lf[ks] = *(const bf16x8*)(lat_next + ks * 16); }
    { float sacc = 0.f;
#pragma unroll
      for (int r = 8; r < 16; ++r) pB1[r] = __builtin_amdgcn_exp2f(pB1[r]);
#pragma unroll
      for (int r = 0; r < 16; ++r) sacc += pB0[r] + pB1[r];
      l_reg += sacc;
      u32x4 pw0, pw1, pw2, pw3;
#pragma unroll
      for (int i = 0; i < 4; ++i) { pw0[i] = cvtpk(pB0[2 * i], pB0[2 * i + 1]); pw1[i] = cvtpk(pB0[8 + 2 * i], pB0[8 + 2 * i + 1]); pw2[i] = cvtpk(pB1[2 * i], pB1[2 * i + 1]); pw3[i] = cvtpk(pB1[8 + 2 * i], pB1[8 + 2 * i + 1]); }
      const LAS unsigned char* vp_ = vp0 + sp * VSLOT; s16x4 vlo[8], vhi[8];
#pragma unroll
      for (int i = 0; i < 8; ++i) A2_VRD(i);
#pragma unroll
      for (int i = 0; i < 8; ++i) { const int d0_ = i >> 2, ks_ = i & 3; const u32x4 pw_ = ks_ == 0 ? pw0 : ks_ == 1 ? pw1 : ks_ == 2 ? pw2 : pw3;
          o[d0_] = __builtin_amdgcn_mfma_f32_32x32x16_bf16(__builtin_bit_cast(bf16x8, pw_), A2_VF(i), o[d0_], 0, 0, 0); } }
    float l = l_reg;
    { auto rr = __builtin_amdgcn_permlane32_swap(__float_as_uint(l), __float_as_uint(l), false, false); l = __uint_as_float(rr[0]) + __uint_as_float(rr[1]); }
    if (hi == 0) wsf[32 + r32] = l;
    asm volatile("s_waitcnt lgkmcnt(0)" ::: "memory");
    LAS bf16_t* stg = (LAS bf16_t*)(lds + (QF ? LDS_K : LDS_OST)) + wid * 2048;
#pragma unroll
    for (int r = 0; r < 16; ++r) { const int orow = crow(r, hi); const float rl = __builtin_amdgcn_rcpf(wsf[32 + orow]);
        stg[orow * 64 + r32] = f2bf(o[0][r] * rl); stg[orow * 64 + 32 + r32] = f2bf(o[1][r] * rl); }
    asm volatile("s_waitcnt lgkmcnt(0)" ::: "memory");
    const int b = bh >> 4, h = bh & 15;
    bf16_t* Ow = O + ((size_t)b * SQ + qb * 256 + wid * 32) * D + h * 64;
#pragma unroll
    for (int i = 0; i < 4; ++i) { const int row = i * 8 + (lane >> 3), ch = lane & 7; const u32x4 v = *(const LAS u32x4*)(stg + row * 64 + ch * 8); *(u32x4*)(Ow + (size_t)row * D + ch * 8) = v; }
    if constexpr (QF) { asm volatile("s_waitcnt lgkmcnt(0)" ::: "memory"); __builtin_amdgcn_s_barrier(); }
    else { asm volatile("s_waitcnt vmcnt(0) lgkmcnt(0)" ::: "memory"); __builtin_amdgcn_s_barrier(); }
#undef A2_GLDS
#undef A2_DMA_K
#undef A2_DMA_V
#undef A2_WAITBAR
#undef A2_KLOAD2
#undef A2_VRD
#undef A2_VF
#undef A2_PAF
#undef A2_GAPA
#undef A2_EX4
#undef A2_EX3
#undef A2_NOP
#undef A2_STEP
}
__device__ __forceinline__ void attn_phase(const Params& p, LAS unsigned char* lds) {
    const int G = gridDim.x, c = blockIdx.x;
    const float smax = *WSP(const float, WS_SMAX);
    constexpr int NU = NB * NH * (SQ / 256);
    const QfArgs qa{WSP(const bf16_t, WS_LAT), WSP(const bf16_t, WS_WQT), WSP(const float, WS_SSQP), (const float*)p.in[12], WSP(const float, WS_COS), WSP(const float, WS_SIN)};
    bf16x8 lf[24];
    auto lrow_of = [&](int bh, int qb) -> const bf16_t* { const int tid = otid(), lane = tid & 63;
        return qa.lat + ((size_t)(bh >> 4) * SQ + qb * 256 + (tid >> 6) * 32 + (lane & 31)) * LATP + (lane >> 5) * 8; };
    int cur_h = -1;
    auto stage_wq = [&](int h_) {
        if (!QFUSE || h_ == cur_h) return; cur_h = h_;
        const int tid = otid(), lane = tid & 63, r32 = lane & 31, hi = lane >> 5; const int wid = __builtin_amdgcn_readfirstlane(tid >> 6);
#pragma unroll 1
        for (int i = 0; i < 9; ++i) { const int pc = wid + 8 * i, blk = pc / 24, cp = pc - blk * 24;
            const int wrow = h_ * 128 + (blk < 2 ? blk * 32 + r32 : 64 + rope_phys_a(r32));
            const bf16_t* gsrc = qa.wqt + (size_t)wrow * QL + (2 * cp + hi) * 8; unsigned keep_;
            asm volatile("s_mov_b32 %0, m0\n\ts_mov_b32 m0, %2\n\ts_nop 0\n\tglobal_load_lds_dwordx4 %1, off\n\ts_mov_b32 m0, %0" : "=&s"(keep_) : "v"(gsrc), "s"((unsigned)__builtin_amdgcn_readfirstlane((int)((unsigned)(uintptr_t)lds + LDS_WQ + pc * 1024))) : "memory"); }
        if (tid < 96) ((LAS float*)(lds + LDS_WQ + 73728))[tid] = qa.qnorm[tid];
        asm volatile("s_waitcnt vmcnt(0) lgkmcnt(0)" ::: "memory"); __builtin_amdgcn_s_barrier(); };
    if (G == 256) {
        const int x = c & 7, r = c >> 3, g = r >> 3;
        const int h_ = 2 * x + (g & 1), qb = r & 7;
        if constexpr (QFUSE) { const bf16_t* l0 = lrow_of((g >> 1) * 16 + h_, qb);
#pragma unroll
            for (int ks = 0; ks < 24; ++ks) lf[ks] = *(const bf16x8*)(l0 + ks * 16); }
        stage_wq(h_);
#pragma unroll 1
        for (int i = 0; i < 8; ++i) { const int b_ = 2 * i + (g >> 1), bh = b_ * 16 + h_;
            attn_unit2<QFUSE>(bh, qb, WSP(const bf16_t, WS_Q), WSP(const bf16_t, WS_K), WSP(const bf16_t, WS_V), WSP(bf16_t, WS_O), lds, smax, qa, lf, lrow_of(i + 1 < 8 ? bh + 32 : bh, qb)); }
    } else {
        if constexpr (QFUSE) { if (c < NU) { const bf16_t* l0 = lrow_of(c >> 3, c & 7);
#pragma unroll
            for (int ks = 0; ks < 24; ++ks) lf[ks] = *(const bf16x8*)(l0 + ks * 16); } }
#pragma unroll 1
        for (int L = c; L < NU; L += G) { stage_wq((L >> 3) & 15);
            attn_unit2<QFUSE>(L >> 3, L & 7, WSP(const bf16_t, WS_Q), WSP(const bf16_t, WS_K), WSP(const bf16_t, WS_V), WSP(bf16_t, WS_O), lds, smax, qa, lf, lrow_of((L + G < NU ? L + G : L) >> 3, (L + G < NU ? L + G : L) & 7)); }
    }
}
}

template <class RowMap>
__device__ __forceinline__ void xpose_item(const float* W, int ldw, const float* gain, bf16_t* Bt, int Kd, int k0, int n0, const RowMap& rm, LAS float* scr, int lane, const float wscale = 1.f) {
    float tv[32];
#pragma unroll
    for (int i = 0; i < 32; ++i) tv[i] = __builtin_nontemporal_load(W + (size_t)(k0 + 2 * i + (lane >> 5)) * ldw + n0 + (lane & 31));
    if (gain) {
#pragma unroll
        for (int i = 0; i < 32; ++i) tv[i] *= gain[k0 + 2 * i + (lane >> 5)]; }
#pragma unroll
    for (int i = 0; i < 32; ++i) scr[(2 * i + (lane >> 5)) * 33 + (lane & 31)] = tv[i] * wscale;
    asm volatile("s_waitcnt lgkmcnt(0)" ::: "memory");
    const int c = lane & 7;
#pragma unroll
    for (int j = 0; j < 4; ++j) { const int n = (lane >> 3) + 8 * j; const LAS float* sp = scr + (8 * c) * 33 + n;
        u32x4 o; o[0] = pk2(sp[0 * 33], sp[1 * 33]); o[1] = pk2(sp[2 * 33], sp[3 * 33]); o[2] = pk2(sp[4 * 33], sp[5 * 33]); o[3] = pk2(sp[6 * 33], sp[7 * 33]);
        *(u32x4*)(Bt + (size_t)rm(n0 + n) * Kd + k0 + 8 * c) = o; }
    asm volatile("s_waitcnt lgkmcnt(0)" ::: "memory");
}
template <class RowMap>
__device__ __forceinline__ void xpose_item8(const float* W, int ldw, float scale, unsigned char* Bt, int Kd, int k0, int n0, const RowMap& rm, LAS float* scr, int lane) {
    float tv[32];
#pragma unroll
    for (int i = 0; i < 32; ++i) tv[i] = __builtin_nontemporal_load(W + (size_t)(k0 + 2 * i + (lane >> 5)) * ldw + n0 + (lane & 31));
#pragma unroll
    for (int i = 0; i < 32; ++i) scr[(2 * i + (lane >> 5)) * 33 + (lane & 31)] = tv[i] * scale;
    asm volatile("s_waitcnt lgkmcnt(0)" ::: "memory");
    const int c = lane & 7;
#pragma unroll
    for (int j = 0; j < 4; ++j) { const int n = (lane >> 3) + 8 * j; const LAS float* sp = scr + (8 * c) * 33 + n;
        u32x2 o; o[0] = g8::pk4_fp8(sp[0 * 33], sp[1 * 33], sp[2 * 33], sp[3 * 33]); o[1] = g8::pk4_fp8(sp[4 * 33], sp[5 * 33], sp[6 * 33], sp[7 * 33]);
        *(u32x2*)(Bt + (size_t)rm(n0 + n) * Kd + k0 + 8 * c) = o; }
    asm volatile("s_waitcnt lgkmcnt(0)" ::: "memory");
}
struct RmId { __device__ __forceinline__ int operator()(int n) const { return n; } };
__device__ __forceinline__ int rope_phys(int d) { return 8 * ((d >> 2) & 3) + 4 * (d >> 4) + (d & 3); }
struct RmLat { __device__ __forceinline__ int operator()(int n) const { return n < 640 ? n : 640 + rope_phys(n - 640); } };
struct RmQ { __device__ __forceinline__ int operator()(int n) const { const int h = n / 96, d = n % 96; return h * 128 + (d < 64 ? d : 64 + rope_phys(d - 64)); } };
struct RmGate { int gate; __device__ __forceinline__ int operator()(int e) const { const int pn = e >> 6, ce = e & 63; return 256 * pn + 128 * (gate >> 1) + 32 * (ce >> 4) + 8 * ((ce >> 2) & 3) + 4 * (gate & 1) + (ce & 3); } };
struct RmGu { __device__ __forceinline__ int operator()(int n) const { const int a = n & 511; return 256 * (a >> 7) + 128 * (n >> 9) + (a & 127); } };

constexpr int CONV_IGU = 16 * 32, CONV_IDN = 8 * 32, CONV_NM = 64 * (CONV_IGU + CONV_IDN), CONV_LATE0 = 32 * CONV_IGU, CONV_LATE = 16 * CONV_IGU;
static_assert(!(MOE0_FP8 && MOE1_FP8) || DN1_FP8, "the late conversion ranges assume the all-e4m3 MoE path");
constexpr int CONV_LATEB = CONV_LATE0 + CONV_LATE, CONV_LATEBN = 8 * CONV_IGU, CONV_LATEC = CONV_LATEB + CONV_LATEBN, CONV_REST = CONV_LATEC + CONV_LATEBN;
__device__ __forceinline__ void conv_moe(const Params& p, LAS float* scr, int lane, int gw, int ngw, int r0, int nj) {
    constexpr int I_GU = CONV_IGU, I_DN = CONV_IDN;
    const bool paired = (nj % (2 * ngw)) == 0;
    auto item_of = [&](int j) -> int { int x = j; if (paired) { const int blk = j / (2 * ngw), w = j % ngw, h = (j / ngw) & 1; x = 2 * (blk * ngw + w) + h; }
        return r0 + x; };
    auto src_of = [&](int r) -> const float* {
        if (r < 64 * I_GU) { const int le = r / I_GU, q = r % I_GU; return IN_F(31) + (size_t)le * 1048576 + (size_t)((2 * (q / 64) + (q & 1)) * 64 + (lane >> 5)) * 1024 + ((q >> 1) & 31) * 32 + (lane & 31); }
        r -= 64 * I_GU; const int le = r / I_DN, q = r % I_DN; return IN_F(32) + (size_t)le * 524288 + (size_t)((2 * (q / 64) + (q & 1)) * 64 + (lane >> 5)) * 1024 + ((q >> 1) & 31) * 32 + (lane & 31); };
#define CV_LOAD(TV, j) do { const float* s_ = src_of(item_of(j)); _Pragma("unroll") for (int i = 0; i < 32; ++i) TV[i] = __builtin_nontemporal_load(s_ + (size_t)i * 2048); } while (0)
#define CV_PROC(TV, j) do { _Pragma("unroll") for (int i = 0; i < 32; ++i) scr[(2 * i + (lane >> 5)) * 33 + (lane & 31)] = TV[i] * F8_SW; \
        asm volatile("s_waitcnt lgkmcnt(0)" ::: "memory"); \
        const int r_ = item_of(j); const bool gu_ = r_ < 64 * I_GU; const int rr_ = gu_ ? r_ : r_ - 64 * I_GU, le_ = gu_ ? rr_ / I_GU : rr_ / I_DN, q_ = gu_ ? rr_ % I_GU : rr_ % I_DN, k0_ = (2 * (q_ / 64) + (q_ & 1)) * 64, n0_ = ((q_ >> 1) & 31) * 32, Kd_ = gu_ ? 1024 : 512; \
        unsigned char* Bt_ = gu_ ? WSP(unsigned char, WS_WGU8) + (size_t)(le_ >> 5) * 64 * MiB + (size_t)(le_ & 31) * 1048576 : WSP(unsigned char, WS_WDN8) + (size_t)(le_ >> 5) * 32 * MiB + (size_t)(le_ & 31) * 524288; \
        const int c_ = lane & 7; \
        _Pragma("unroll") for (int jj = 0; jj < 4; ++jj) { const int n_ = n0_ + (lane >> 3) + 8 * jj; const LAS float* sp = scr + (8 * c_) * 33 + (lane >> 3) + 8 * jj; \
            u32x2 o; o[0] = g8::pk4_fp8(sp[0 * 33], sp[1 * 33], sp[2 * 33], sp[3 * 33]); o[1] = g8::pk4_fp8(sp[4 * 33], sp[5 * 33], sp[6 * 33], sp[7 * 33]); \
            *(u32x2*)(Bt_ + (size_t)(gu_ ? RmGu{}(n_) : n_) * Kd_ + k0_ + 8 * c_) = o; } \
        asm volatile("s_waitcnt lgkmcnt(0)" ::: "memory"); } while (0)
    float ta[32], tb[32];
    int j = gw;
    if (j < nj) CV_LOAD(ta, j);
#pragma unroll 1
    while (j < nj) { const int j1 = j + ngw, j2 = j1 + ngw;
        if (j1 < nj) CV_LOAD(tb, j1);
        CV_PROC(ta, j);
        if (j2 < nj) CV_LOAD(ta, j2);
        if (j1 < nj) CV_PROC(tb, j1);
        j = j2; }
#undef CV_LOAD
#undef CV_PROC
}

__device__ __forceinline__ void conv_in_moe_tail(const Params& p, LAS unsigned char* ldsb, const LAS int* tab, int G, int vc, int r0, int n) {
    const int total = tab[32] * 4, rounds = (total + G - 1) / G, first_idle = total - (rounds - 1) * G, nidle = G - first_idle;
    __syncthreads();
    const int wave = otid() >> 6, lane = otid() & 63; LAS float* scr = (LAS float*)ldsb + wave * (64 * 33);
    if (nidle >= 32) { if (vc >= first_idle) conv_moe(p, scr, lane, (vc - first_idle) * 8 + wave, nidle * 8, r0, n); }
    else conv_moe(p, scr, lane, vc * 8 + wave, G * 8, r0, n);
}
__device__ __forceinline__ void ph_convert(const Params& p, LAS float* lds) {
    const int lane = otid() & 63, wave = otid() >> 6;
    LAS float* scr = lds + wave * (64 * 33);
    const int gw = blockIdx.x * 8 + wave, ngw = gridDim.x * 8;
    constexpr int I_W1 = 16 * 21, I_WQ = 6 * 48, I_WKV = 4 * 64, I_WO = 16 * 32, I_RIN = 16 * 64, I_G = 16 * 32, I_RO = 16 * 32, I_GU = 16 * 32, I_DN = 8 * 32;
    constexpr int NSMALL = I_W1 + I_WQ + I_WKV + I_WO + I_RIN + I_G + I_RO, NITEMS = NSMALL + 64 * (I_GU + I_DN);
    constexpr bool MOE_PIPE = MOE0_FP8 && MOE1_FP8;
    for (int it = gw; it < (MOE_PIPE ? NSMALL : NITEMS); it += ngw) { int r = it;
        if (r < I_W1) { xpose_item(IN_F(7), LATN, nullptr, WSP(bf16_t, WS_W1T), 1024, (r / 21) * 64, (r % 21) * 32, RmLat{}, scr, lane); continue; } r -= I_W1;
        if (r < I_WQ) { xpose_item(IN_F(10), 1536, IN_F(8), WSP(bf16_t, WS_WQT), QL, (r / 48) * 64, (r % 48) * 32, RmQ{}, scr, lane); continue; } r -= I_WQ;
        if (r < I_WKV) { xpose_item(IN_F(11), 2048, IN_F(9), WSP(bf16_t, WS_WKVT), KVL, (r / 64) * 64, (r % 64) * 32, RmId{}, scr, lane); continue; } r -= I_WKV;
        if (r < I_WO) { xpose_item(IN_F(14), 1024, nullptr, WSP(bf16_t, WS_WOT), 1024, (r / 32) * 64, (r % 32) * 32, RmId{}, scr, lane); continue; } r -= I_WO;
        if (r < I_RIN) { if (RNN_FP8) xpose_item8(IN_F(15), 2048, F8_SW, WSP(unsigned char, WS_WRINT), 1024, (r / 64) * 64, (r % 64) * 32, RmId{}, scr, lane);
            else xpose_item(IN_F(15), 2048, nullptr, WSP(bf16_t, WS_WRINT), 1024, (r / 64) * 64, (r % 64) * 32, RmId{}, scr, lane); continue; } r -= I_RIN;
        if (r < I_G) { const int nb = r >> 7, gate = (r >> 5) & 3, q = r & 31; const float* W = gate == 0 ? IN_F(19) : gate == 1 ? IN_F(21) : gate == 2 ? IN_F(24) : IN_F(26);
            xpose_item(W + (size_t)nb * 65536, 256, nullptr, WSP(bf16_t, WS_WGT) + (size_t)nb * 1024 * 256, 256, (q >> 3) * 64, (q & 7) * 32, RmGate{gate}, scr, lane, -1.4426950408889634f); continue; } r -= I_G;
        if (r < I_RO) { if (RNN_FP8) xpose_item8(IN_F(28), 1024, F8_SW, WSP(unsigned char, WS_WROT), 1024, (r / 32) * 64, (r % 32) * 32, RmId{}, scr, lane);
            else xpose_item(IN_F(28), 1024, nullptr, WSP(bf16_t, WS_WROT), 1024, (r / 32) * 64, (r % 32) * 32, RmId{}, scr, lane); continue; } r -= I_RO;
        if (r < 64 * I_GU) { const int le = r / I_GU, q = r % I_GU;
            if (le >= 32 ? MOE1_FP8 : MOE0_FP8) xpose_item8(IN_F(31) + (size_t)le * 1048576, 1024, F8_SW, WSP(unsigned char, WS_WGU8) + (size_t)(le >> 5) * 64 * MiB + (size_t)(le & 31) * 1048576, 1024, (q / 32) * 64, (q % 32) * 32, RmGu{}, scr, lane);
            else xpose_item(IN_F(31) + (size_t)le * 1048576, 1024, nullptr, WSP(bf16_t, WS_WGU) + (size_t)le * 1048576, 1024, (q / 32) * 64, (q % 32) * 32, RmGu{}, scr, lane);
            continue; } r -= 64 * I_GU;
        { const int le = r / I_DN, q = r % I_DN;
          if (le >= 32 ? MOE1_FP8 : MOE0_FP8) xpose_item8(IN_F(32) + (size_t)le * 524288, 1024, F8_SW, WSP(unsigned char, WS_WDN8) + (size_t)(le >> 5) * 32 * MiB + (size_t)(le & 31) * 524288, 512, (q / 32) * 64, (q % 32) * 32, RmId{}, scr, lane);
          else xpose_item(IN_F(32) + (size_t)le * 524288, 1024, nullptr, WSP(bf16_t, WS_WDN) + (size_t)le * 524288, 512, (q / 32) * 64, (q % 32) * 32, RmId{}, scr, lane); }
    }
    if constexpr (MOE_PIPE) { conv_moe(p, scr, lane, gw, ngw, 0, CONV_LATE0); conv_moe(p, scr, lane, gw, ngw, CONV_REST, CONV_NM - CONV_REST); }
    { u32x4 z = {0u, 0u, 0u, 0u}; const int gt = blockIdx.x * 512 + otid(), ngt = gridDim.x * 512;
      for (int i = gt; i < 96 * 1024 / 8; i += ngt) *(u32x4*)(WSP(bf16_t, WS_W1T) + (size_t)672 * 1024 + (size_t)i * 8) = z;
      for (int i = gt; i < 16 * 32 * QL / 8; i += ngt) { const int e = i * 8, hh = e / (32 * QL), rem = e % (32 * QL); *(u32x4*)(WSP(bf16_t, WS_WQT) + ((size_t)hh * 128 + 96) * QL + rem) = z; } }
}

__device__ __forceinline__ void ph_scan1(const Params& p) {
    const int lane = otid() & 63, gw = blockIdx.x * 8 + (otid() >> 6), ngw = gridDim.x * 8;
    const unsigned* sf = WSP(const unsigned, WS_SF); const unsigned* sb = WSP(const unsigned, WS_SB); float* sum = WSP(float, WS_SUM); float* gsum = sum + (size_t)2 * 1024 * 1024 * 2;
    for (int u = gw; u < 2 * 16 * 8 * 8; u += ngw) {
        const int dir = u >> 10, r = u & 1023, b = r >> 6, grp = (r >> 3) & 7, cg = r & 7, c = cg * 128 + lane * 2;
        float GA0 = 1.f, GA1 = 1.f, GH0 = 0.f, GH1 = 0.f;
        const unsigned* sdir = (dir ? sb : sf) + (size_t)b * SQ * D + c;
        u32x2 wa[16], wb2[16];
#define SC1_ROW(i) (dir ? (grp * 256 + 255 - (i)) : (grp * 256 + (i)))
#define SC1_SCAN(W) do { _Pragma("unroll") for (int t = 0; t < 16; ++t) { const u32x2 x = W[t]; \
            const float a0 = 1.f - __uint_as_float(x[0] << 16), x0 = __uint_as_float(x[0] & 0xffff0000u), a1 = 1.f - __uint_as_float(x[1] << 16), x1 = __uint_as_float(x[1] & 0xffff0000u); \
            H0 = a0 * H0 + x0; A0 *= a0; H1 = a1 * H1 + x1; A1 *= a1; } } while (0)
#pragma unroll
        for (int t = 0; t < 16; ++t) wa[t] = *(const u32x2*)(sdir + (size_t)SC1_ROW(t) * D);
#pragma unroll 1
        for (int k = 0; k < 8; ++k) {
            float A0 = 1.f, A1 = 1.f, H0 = 0.f, H1 = 0.f;
#pragma unroll
            for (int t = 0; t < 16; ++t) wb2[t] = *(const u32x2*)(sdir + (size_t)SC1_ROW(k * 32 + 16 + t) * D);
            SC1_SCAN(wa);
            if (k + 1 < 8) {
#pragma unroll
                for (int t = 0; t < 16; ++t) wa[t] = *(const u32x2*)(sdir + (size_t)SC1_ROW(k * 32 + 32 + t) * D); }
            SC1_SCAN(wb2);
            const int run = grp * 8 + (dir ? 7 - k : k);
            f32x4 o = {A0, H0, A1, H1};
            *(f32x4*)(sum + (((size_t)dir * 1024 + b * 64 + run) * 1024 + c) * 2) = o;
            GH0 = A0 * GH0 + H0; GA0 *= A0; GH1 = A1 * GH1 + H1; GA1 *= A1; }
#undef SC1_ROW
#undef SC1_SCAN
        f32x4 go = {GA0, GH0, GA1, GH1};
        *(f32x4*)(gsum + (((size_t)dir * 128 + b * 8 + grp) * 1024 + c) * 2) = go;
    }
}
__device__ __forceinline__ void ph_scan2(const Params& p) {
    const int lane = otid() & 63, gw = blockIdx.x * 8 + (otid() >> 6), ngw = gridDim.x * 8;
    const unsigned* sf = WSP(const unsigned, WS_SF); const unsigned* sb = WSP(const unsigned, WS_SB); const float* sum = WSP(const float, WS_SUM); const float* gsum = sum + (size_t)2 * 1024 * 1024 * 2;
    bf16_t* gy = WSP(bf16_t, WS_GG);
    for (int u = gw; u < 16 * 64 * 8; u += ngw) {
        const int b = u >> 9, run = (u >> 3) & 63, cg = u & 7, c = cg * 128 + lane * 2, grp = run >> 3, rin = run & 7;
        const size_t base = ((size_t)b * SQ + run * 32) * D + c;
        u32x2 wf[32];
#pragma unroll
        for (int t = 0; t < 32; ++t) wf[t] = __builtin_nontemporal_load((const u32x2*)(sf + base + (size_t)t * D));
        float hf0 = 0.f, hf1 = 0.f, hb0 = 0.f, hb1 = 0.f;
        { f32x4 gq[7], rq[7];
#pragma unroll
          for (int q = 0; q < 7; ++q) { gq[q] = *(const f32x4*)(gsum + (((size_t)b * 8 + q) * 1024 + c) * 2); rq[q] = *(const f32x4*)(sum + (((size_t)b * 64 + grp * 8 + q) * 1024 + c) * 2); }
#pragma unroll
          for (int q = 0; q < 7; ++q) if (q < grp) { hf0 = gq[q][0] * hf0 + gq[q][1]; hf1 = gq[q][2] * hf1 + gq[q][3]; }
#pragma unroll
          for (int q = 0; q < 7; ++q) if (q < rin) { hf0 = rq[q][0] * hf0 + rq[q][1]; hf1 = rq[q][2] * hf1 + rq[q][3]; } }
        { f32x4 gq[7], rq[7];
#pragma unroll
          for (int q = 0; q < 7; ++q) { gq[q] = *(const f32x4*)(gsum + (((size_t)128 + b * 8 + 7 - q) * 1024 + c) * 2); rq[q] = *(const f32x4*)(sum + (((size_t)1024 + b * 64 + grp * 8 + 7 - q) * 1024 + c) * 2); }
#pragma unroll
          for (int q = 0; q < 7; ++q) if (7 - q > grp) { hb0 = gq[q][0] * hb0 + gq[q][1]; hb1 = gq[q][2] * hb1 + gq[q][3]; }
#pragma unroll
          for (int q = 0; q < 7; ++q) if (7 - q > rin) { hb0 = rq[q][0] * hb0 + rq[q][1]; hb1 = rq[q][2] * hb1 + rq[q][3]; } }
        u32x2 wb[32];
#pragma unroll
        for (int t = 0; t < 32; ++t) wb[t] = __builtin_nontemporal_load((const u32x2*)(sb + base + (size_t)t * D));
        unsigned fp[32];
#pragma unroll
        for (int t = 0; t < 32; ++t) { hf0 = (1.f - __uint_as_float(wf[t][0] << 16)) * hf0 + __uint_as_float(wf[t][0] & 0xffff0000u); hf1 = (1.f - __uint_as_float(wf[t][1] << 16)) * hf1 + __uint_as_float(wf[t][1] & 0xffff0000u); fp[t] = pk2(hf0, hf1); }
        unsigned g[32];
#pragma unroll
        for (int t = 0; t < 32; ++t) g[t] = __builtin_nontemporal_load((const unsigned*)(gy + base + (size_t)t * D));
#pragma unroll
        for (int tt = 0; tt < 32; ++tt) { const int t = 31 - tt;
            hb0 = (1.f - __uint_as_float(wb[t][0] << 16)) * hb0 + __uint_as_float(wb[t][0] & 0xffff0000u); hb1 = (1.f - __uint_as_float(wb[t][1] << 16)) * hb1 + __uint_as_float(wb[t][1] & 0xffff0000u);
            const float y0 = __uint_as_float(g[t] << 16) * (__uint_as_float(fp[t] << 16) + hb0), y1 = __uint_as_float(g[t] & 0xffff0000u) * (__uint_as_float(fp[t] & 0xffff0000u) + hb1);
            if (RNN_FP8) *(unsigned short*)(WSP(unsigned char, WS_YF) + base + (size_t)t * D) = (unsigned short)pk4_fp8_(y0 * F8_SY, y1 * F8_SY, 0.f, 0.f);
            else *(unsigned*)(gy + base + (size_t)t * D) = pk2(y0, y1); }
    }
}

__device__ __forceinline__ void ph_router_opt(const Params& p, int layer, const bf16_t* xin, LAS unsigned char* ldsb) {
    const int tid = otid(), lane = tid & 63, wave = __builtin_amdgcn_readfirstlane(tid >> 6);
    constexpr int RT_STR = 1032, RT_LO = 16 * RT_STR * 2, RT_PART = 66560;
    LAS float* part = (LAS float*)(ldsb + RT_PART);
    LAS int* rinfo = (LAS int*)(ldsb + RT_PART + 16384);
    LAS int* lcnt = rinfo + 512;
    const float* g = IN_F(4) + layer * D; const float* mod = WSP(float, WS_MOD) + (size_t)layer * 16 * 6144;
    const float* wr = IN_F(29); const float* rb = IN_F(30);
    bf16_t* h2 = WSP(bf16_t, WS_H2);
    int* re = WSP(int, WS_RTE); int* rp = re + T * 2; float* rw = (float*)(rp + T * 2);
    int* tok = WSP(int, WS_TOK); int* dstp = WSP(int, WS_DST); float* wso = WSP(float, WS_WSO);
    unsigned* cnt = WSP(unsigned, WS_CTL) + CW_CNT + layer * 32;
    bf16x8 wq[4][2][3];
#pragma unroll
    for (int t = 0; t < 4; ++t)
#pragma unroll
        for (int cb = 0; cb < 2; ++cb) { float w8[8];
#pragma unroll
            for (int j = 0; j < 8; ++j) w8[j] = wr[(size_t)(wave * 128 + 32 * t + 8 * (lane >> 4) + j) * 32 + cb * 16 + (lane & 15)];
            u32x4 t0, t1, t2;
#pragma unroll
            for (int q = 0; q < 4; ++q) { const float x0 = w8[2 * q], x1 = w8[2 * q + 1];
                const unsigned a = g8::cvt_pk_bf16(x0, x1); const float r0 = x0 - __uint_as_float(a << 16), r1 = x1 - __uint_as_float(a & 0xffff0000u);
                const unsigned b = g8::cvt_pk_bf16(r0, r1); const float q0 = r0 - __uint_as_float(b << 16), q1 = r1 - __uint_as_float(b & 0xffff0000u);
                t0[q] = a; t1[q] = b; t2[q] = g8::cvt_pk_bf16(q0, q1); }
            wq[t][cb][0] = __builtin_bit_cast(bf16x8, t0); wq[t][cb][1] = __builtin_bit_cast(bf16x8, t1); wq[t][cb][2] = __builtin_bit_cast(bf16x8, t2); }
    const float bias_e = rb[tid & 31];
    for (int batch = vblock(); batch < T / 128; batch += gridDim.x) {
        if (tid < 64) lcnt[tid] = 0;
        u32x2 raw[2][4];
#pragma unroll
        for (int q = 0; q < 2; ++q)
#pragma unroll
            for (int j = 0; j < 4; ++j) raw[q][j] = *(const u32x2*)(xin + (size_t)(batch * 128 + wave * 2 + q) * D + j * 256 + lane * 4);
        float gm_[16], sh_[16];
        { const float* mb = mod + (size_t)((batch * 128) >> 11) * 6144;
#pragma unroll
          for (int j = 0; j < 4; ++j) { const int c0 = j * 256 + lane * 4; const f32x4 gg = *(const f32x4*)(g + c0), s1 = *(const f32x4*)(mb + 4096 + c0), s0 = *(const f32x4*)(mb + 3072 + c0);
#pragma unroll
              for (int i = 0; i < 4; ++i) { gm_[4 * j + i] = gg[i] * (1.f + s1[i]); sh_[4 * j + i] = s0[i]; } } }
        for (int gi = 0; gi < 8; ++gi) {
            const int row0 = batch * 128 + gi * 16;
#pragma unroll
            for (int q = 0; q < 2; ++q) { const int rl = wave * 2 + q, row = row0 + rl, b = row >> 11; float v[16];
#pragma unroll
                for (int j = 0; j < 4; ++j) { const u32x2 x = raw[q][j];
                    v[4 * j] = __uint_as_float(x[0] << 16); v[4 * j + 1] = __uint_as_float(x[0] & 0xffff0000u); v[4 * j + 2] = __uint_as_float(x[1] << 16); v[4 * j + 3] = __uint_as_float(x[1] & 0xffff0000u); }
                if (gi + 1 < 8) {
#pragma unroll
                    for (int j = 0; j < 4; ++j) raw[q][j] = *(const u32x2*)(xin + (size_t)(row + 16) * D + j * 256 + lane * 4); }
                { float s = 0.f;
#pragma unroll
                  for (int i = 0; i < 16; ++i) s += v[i] * v[i];
                  const float rstd = rsqrtf(wave_sum(s) * (1.f / 1024.f) + EPS);
#pragma unroll
                  for (int i = 0; i < 16; ++i) v[i] = v[i] * rstd * gm_[i] + sh_[i]; }
                if (layer == 1 ? MOE1_FP8 : MOE0_FP8) {
#pragma unroll
                    for (int j = 0; j < 4; ++j) *(unsigned*)(WSP(unsigned char, WS_H2F) + (size_t)row * D + j * 256 + lane * 4) = g8::pk4_fp8(v[4 * j] * F8_SH, v[4 * j + 1] * F8_SH, v[4 * j + 2] * F8_SH, v[4 * j + 3] * F8_SH); }
                else row_store_bf16(h2 + (size_t)row * D, lane, v);
#pragma unroll
                for (int j = 0; j < 4; ++j) { typedef float f32x2 __attribute__((ext_vector_type(2)));
                    const unsigned ha = g8::cvt_pk_bf16(v[4 * j], v[4 * j + 1]), hb2 = g8::cvt_pk_bf16(v[4 * j + 2], v[4 * j + 3]);
                    const unsigned la = g8::cvt_pk_bf16(v[4 * j] - __uint_as_float(ha << 16), v[4 * j + 1] - __uint_as_float(ha & 0xffff0000u)), lb2 = g8::cvt_pk_bf16(v[4 * j + 2] - __uint_as_float(hb2 << 16), v[4 * j + 3] - __uint_as_float(hb2 & 0xffff0000u));
                    *(LAS u32x2*)(ldsb + (rl * RT_STR + j * 256 + lane * 4) * 2) = (u32x2){ha, hb2}; *(LAS u32x2*)(ldsb + RT_LO + (rl * RT_STR + j * 256 + lane * 4) * 2) = (u32x2){la, lb2}; } }
            __syncthreads();
            { f32x4 a0 = {0.f, 0.f, 0.f, 0.f}, a1 = {0.f, 0.f, 0.f, 0.f}; const LAS unsigned char* hp = ldsb + ((lane & 15) * RT_STR + wave * 128 + (lane >> 4) * 8) * 2;
#pragma unroll
              for (int t = 0; t < 4; ++t) { const bf16x8 ah = *(const LAS bf16x8*)(hp + t * 64), al = *(const LAS bf16x8*)(hp + RT_LO + t * 64);
                  a0 = __builtin_amdgcn_mfma_f32_16x16x32_bf16(al, wq[t][0][1], a0, 0, 0, 0); a1 = __builtin_amdgcn_mfma_f32_16x16x32_bf16(al, wq[t][1][1], a1, 0, 0, 0);
                  a0 = __builtin_amdgcn_mfma_f32_16x16x32_bf16(ah, wq[t][0][2], a0, 0, 0, 0); a1 = __builtin_amdgcn_mfma_f32_16x16x32_bf16(ah, wq[t][1][2], a1, 0, 0, 0);
                  a0 = __builtin_amdgcn_mfma_f32_16x16x32_bf16(al, wq[t][0][0], a0, 0, 0, 0); a1 = __builtin_amdgcn_mfma_f32_16x16x32_bf16(al, wq[t][1][0], a1, 0, 0, 0);
                  a0 = __builtin_amdgcn_mfma_f32_16x16x32_bf16(ah, wq[t][0][1], a0, 0, 0, 0); a1 = __builtin_amdgcn_mfma_f32_16x16x32_bf16(ah, wq[t][1][1], a1, 0, 0, 0);
                  a0 = __builtin_amdgcn_mfma_f32_16x16x32_bf16(ah, wq[t][0][0], a0, 0, 0, 0); a1 = __builtin_amdgcn_mfma_f32_16x16x32_bf16(ah, wq[t][1][0], a1, 0, 0, 0); }
#pragma unroll
              for (int r = 0; r < 4; ++r) { part[(wave * 16 + 4 * (lane >> 4) + r) * 32 + (lane & 15)] = a0[r]; part[(wave * 16 + 4 * (lane >> 4) + r) * 32 + 16 + (lane & 15)] = a1[r]; } }
            __syncthreads();
            { const int rl = tid >> 5, e = tid & 31; float lg = 0.f;
#pragma unroll
              for (int w_ = 0; w_ < 8; ++w_) lg += part[(w_ * 16 + rl) * 32 + e];
              const float sc = 1.f / (1.f + expf(-lg)), bi = sc + bias_e;
              float bq[4], tq[4];
#pragma unroll
              for (int k = 0; k < 4; ++k) { bq[k] = __shfl(bi, (lane & ~3) + k); tq[k] = __shfl(sc, (lane & ~3) + k); }
              int i1 = 0; float v1 = bq[0], t1 = tq[0];
#pragma unroll
              for (int i = 1; i < 4; ++i) if (bq[i] > v1) { v1 = bq[i]; t1 = tq[i]; i1 = i; }
              int i2 = -1; float v2 = -INFINITY, t2 = 0.f;
#pragma unroll
              for (int i = 0; i < 4; ++i) if (i != i1 && bq[i] > v2) { v2 = bq[i]; t2 = tq[i]; i2 = i; }
              float gs = v1 + v2; int gq = e >> 2; int ee = ((4 * gq + i1) << 8) | (4 * gq + i2);
#pragma unroll
              for (int o = 4; o < 32; o <<= 1) { const float pgs = __shfl_xor(gs, o); const int pgq = __shfl_xor(gq, o), pee = __shfl_xor(ee, o); const float pt1 = __shfl_xor(t1, o), pt2 = __shfl_xor(t2, o);
                  if (pgs > gs || (pgs == gs && pgq < gq)) { gs = pgs; gq = pgq; ee = pee; t1 = pt1; t2 = pt2; } }
              if (e == 0) { const float inv = 1.f / (t1 + t2); LAS int* ri = rinfo + (gi * 16 + rl) * 4; ri[0] = ee >> 8; ri[1] = ee & 255; ri[2] = __float_as_int(t1 * inv); ri[3] = __float_as_int(t2 * inv); } }
        }
        __syncthreads();
        int e1 = 0, e2 = 0, r1 = 0, r2 = 0; float w1 = 0.f, w2 = 0.f;
        if (tid < 128) { e1 = rinfo[tid * 4]; e2 = rinfo[tid * 4 + 1]; w1 = __int_as_float(rinfo[tid * 4 + 2]); w2 = __int_as_float(rinfo[tid * 4 + 3]);
            r1 = __hip_atomic_fetch_add(lcnt + e1, 1, __ATOMIC_RELAXED, __HIP_MEMORY_SCOPE_WORKGROUP); r2 = __hip_atomic_fetch_add(lcnt + e2, 1, __ATOMIC_RELAXED, __HIP_MEMORY_SCOPE_WORKGROUP); }
        __syncthreads();
        if (tid < 32) lcnt[32 + tid] = (int)atomicAdd(cnt + tid, (unsigned)lcnt[tid]);
        __syncthreads();
        if (tid < 128) { const int row = batch * 128 + tid; const int p1 = lcnt[32 + e1] + r1, p2 = lcnt[32 + e2] + r2;
            re[row * 2] = e1; re[row * 2 + 1] = e2; rp[row * 2] = p1; rp[row * 2 + 1] = p2; rw[row * 2] = w1; rw[row * 2 + 1] = w2;
            tok[(size_t)e1 * T + p1] = row; tok[(size_t)e2 * T + p2] = row; dstp[(size_t)e1 * T + p1] = row * 2; dstp[(size_t)e2 * T + p2] = row * 2 + 1; wso[(size_t)e1 * T + p1] = w1; wso[(size_t)e2 * T + p2] = w2; }
        __syncthreads();
    }
}

#define XB_TMO      128
#define XB_XCNT(j)  (256  + 64 * (j))
#define XB_XSUB(j)  (1280 + 64 * (j))
#define XB_XGEN(j)  (2304 + 64 * (j))
#define XB_TOP      3328
#define XB_TOPGEN   3392
#define XCD_BAR_WORDS 3456
#define XB_SPIN_CAP (1u << 22)
__device__ __forceinline__ unsigned xb_ld(unsigned* p)              { return __hip_atomic_load(p, __ATOMIC_RELAXED, __HIP_MEMORY_SCOPE_AGENT); }
__device__ __forceinline__ unsigned xb_add(unsigned* p, unsigned v) { return __hip_atomic_fetch_add(p, v, __ATOMIC_RELAXED, __HIP_MEMORY_SCOPE_AGENT); }
__device__ __forceinline__ unsigned xb_xcc_id() { return (unsigned)__builtin_amdgcn_s_getreg((3 << 11) | 20) & 0xFu; }
#define XB_SPIN(cond, bar) do { unsigned _sp = 0; while (cond) { __builtin_amdgcn_s_sleep(1); \
    if ((++_sp & 255u) == 0u) { if (xb_ld(&(bar)[XB_TMO])) break; if (_sp > XB_SPIN_CAP) { atomicAdd(&(bar)[XB_TMO], 1u); break; } } } } while (0)
struct XcdBarrier { unsigned* bar; unsigned x; volatile LAS unsigned* st; };
__device__ __forceinline__ XcdBarrier xcd_barrier_post(unsigned* bar, volatile LAS unsigned* st) {
    XcdBarrier b; b.bar = bar; b.x = xb_xcc_id(); b.st = st;
    if (otid() == 0) (void)xb_add(&bar[XB_XCNT(b.x)], 1u);
    return b;
}
__device__ __forceinline__ void xcd_barrier_complete(unsigned* bar, unsigned x, unsigned& nloc, unsigned& nx) {
    const unsigned G = gridDim.x * gridDim.y * gridDim.z;
    unsigned sum, cnt, mine, sp = 0u;
    for (;;) {
        sum = 0u; cnt = 0u; mine = 0u;
#pragma unroll
        for (unsigned j = 0; j < 16; ++j) { const unsigned c = xb_ld(&bar[XB_XCNT(j)]); sum += c; cnt += (c > 0u) ? 1u : 0u; mine = (j == x) ? c : mine; }
        if (sum == G) break;
        __builtin_amdgcn_s_sleep(1);
        if ((++sp & 255u) == 0u) { if (xb_ld(&bar[XB_TMO])) break; if (sp > XB_SPIN_CAP) { atomicAdd(&bar[XB_TMO], 1u); break; } }
    }
    nloc = mine > 0u ? mine : 1u; nx = cnt > 0u ? cnt : 1u;
}
__device__ __forceinline__ void xcd_barrier(const XcdBarrier& b) {
    asm volatile("s_waitcnt vmcnt(0)" ::: "memory");
    __syncthreads();
    if (otid() == 0) {
        unsigned* bar = b.bar;
        __builtin_amdgcn_s_waitcnt(0);
        unsigned nloc = b.st[0], nx = b.st[1];
        if (nloc == 0u) { xcd_barrier_complete(bar, b.x, nloc, nx); b.st[0] = nloc; b.st[1] = nx; }
        const unsigned old = xb_add(&bar[XB_XSUB(b.x)], 1u);
        const unsigned gen = old / nloc;
        if (old + 1u == (gen + 1u) * nloc) {
            __builtin_amdgcn_fence(__ATOMIC_RELEASE, "agent");
            asm volatile("s_waitcnt vmcnt(0)" ::: "memory");
            const unsigned og = xb_add(&bar[XB_TOP], 1u);
            const unsigned tg = og / nx;
            if (og + 1u == (tg + 1u) * nx) xb_add(&bar[XB_TOPGEN], 1u);
            else XB_SPIN(xb_ld(&bar[XB_TOPGEN]) == tg, bar);
            __builtin_amdgcn_fence(__ATOMIC_ACQUIRE, "agent");
            xb_add(&bar[XB_XGEN(b.x)], 1u);
            asm volatile("s_waitcnt vmcnt(0)" ::: "memory");
        } else {
            XB_SPIN(xb_ld(&bar[XB_XGEN(b.x)]) == gen, bar);
            __builtin_amdgcn_fence(__ATOMIC_ACQUIRE, "agent");
            asm volatile("s_waitcnt vmcnt(0)" ::: "memory");
        }
    }
    __syncthreads();
}

enum { PH_PRO = 0, PH_NORM0, PH_LAT, PH_QKV, PH_ATTN, PH_WO, PH_ROUTE0, PH_GU0, PH_DN0, PH_COMB0, PH_RIN, PH_CONV, PH_GATE, PH_SCAN, PH_SCAN2, PH_RO, PH_ROUTE1, PH_GU1, PH_DN1, PH_COMB1, PH_COUNT };
constexpr int LDS_PHASE = 131072;
constexpr int LDS_XTRA = 131072;
constexpr int LDS_BYTES = 147456;
constexpr int CW_BAR = 4096;
constexpr bool OPT_RES = true, OPT_RIN = true, OPT_MOE = true, OPT_MLA = true, OPT_ATT = true, OPT_RNN = true, OPT_RTE = true;

template <int PH> __device__ __forceinline__ void run_phase(const Params& p, float* lds) {
    LAS unsigned char* ldsb = (LAS unsigned char*)lds;
    LAS int* tab = (LAS int*)(ldsb + LDS_XTRA);
    const int G = gridDim.x, c = blockIdx.x, vc = (G % 8 == 0) ? (c % 8) * (G / 8) + c / 8 : c;
    if constexpr (PH == PH_PRO) { ph_prologue(p, lds); __syncthreads(); ph_convert(p, (LAS float*)lds); }
    else if constexpr (PH == PH_NORM0) ph_norm0(p);
    else if constexpr (PH == PH_LAT) {
        if constexpr (OPT_MLA) { g8::DenseSched S; S.init(WSP(const bf16_t, WS_HB), 1024, WSP(const bf16_t, WS_W1T), 1024, T, 768);
            g8::EpiLat E{WSP(bf16_t, WS_LAT), WSP(float, WS_SSQP), WSP(float, WS_ROPEK), WSP(float, WS_PESSQ), WSP(const float, WS_COS), WSP(const float, WS_SIN), IN_F(13)};
            g8::gemm_phase<g8::EpiLat, g8::DenseSched, false>(ldsb, 1024 * 2, 1024 * 2, S, E); }
        else { FLat f{p}; rowgemm<1024, LATN>(f, lds); }
        if constexpr (MOE0_FP8 && MOE1_FP8) {
            const int idle0 = (G > 128 && G <= 384) ? 384 - G : 0, nb = G - idle0;
            __syncthreads();
            if (c >= idle0) conv_moe(p, (LAS float*)ldsb + (otid() >> 6) * (64 * 33), otid() & 63, (c - idle0) * 8 + (otid() >> 6), nb * 8, CONV_LATE0, CONV_LATE); } }
    else if constexpr (PH == PH_QKV) {
        if constexpr (OPT_MLA) {
            if constexpr (!QFUSE) { g8::DenseSched S; S.init(WSP(const bf16_t, WS_LAT), LATP, WSP(const bf16_t, WS_WQT), QL, T, 2048);
              g8::EpiQ E{ldsb, WSP(const float, WS_SSQP), IN_F(12), WSP(const float, WS_COS), WSP(const float, WS_SIN), WSP(bf16_t, WS_Q)};
              g8::gemm_phase<g8::EpiQ, g8::DenseSched, false>(ldsb, QL * 2, LATP * 2, S, E); }
            { g8::DenseSched S; S.init(WSP(const bf16_t, WS_LAT) + QL, LATP, WSP(const bf16_t, WS_WKVT), KVL, T, 2048);
              g8::EpiKV E{ldsb, WSP(const float, WS_SSQP), WSP(const float, WS_PESSQ), WSP(const float, WS_ROPEK), IN_F(13), WSP(bf16_t, WS_K), WSP(bf16_t, WS_V)};
              g8::gemm_phase<g8::EpiKV, g8::DenseSched, false>(ldsb, KVL * 2, LATP * 2, S, E); } }
        else { { FQ f{p}; rowgemm<QL, 1536>(f, lds); } __syncthreads(); { FKV f{p}; rowgemm<KVL, 2048>(f, lds); } } }
    else if constexpr (PH == PH_ATTN) { if constexpr (OPT_ATT) att::attn_phase(p, ldsb); else ph_attn(p, lds); }
    else if constexpr (PH == PH_WO) {
        if constexpr (OPT_RES) { g8::DenseSched S; S.init(WSP(const bf16_t, WS_O), 1024, WSP(const bf16_t, WS_WOT), 1024, T, 1024);
            g8::EpiRes<true> E{p.in[0], WSP(const float, WS_MOD) + 2048, WSP(bf16_t, WS_X1), 1.f}; g8::gemm_phase<g8::EpiRes<true>, g8::DenseSched, false>(ldsb, 1024 * 2, 1024 * 2, S, E); }
        else { FRes<true> f{p, WSP(const bf16_t, WS_O), IN_F(14), p.in[0], WSP(const float, WS_MOD) + 2048, WSP(bf16_t, WS_X1)}; rowgemm<1024, 1024>(f, lds); } }
    else if constexpr (PH == PH_ROUTE0) { if constexpr (OPT_RTE) ph_router_opt(p, 0, WSP(const bf16_t, WS_X1), ldsb); else ph_router(p, 0, WSP(const bf16_t, WS_X1)); }
    else if constexpr (PH == PH_GU0 || PH == PH_GU1) { constexpr int layer = (PH == PH_GU1);
        if constexpr (OPT_MOE) { g8::moe_tables(p, layer, tab);
            if constexpr (layer == 1 ? MOE1_FP8 : MOE0_FP8) {
                g8::MoeSched S{tab, (const char*)WSP(const unsigned char, WS_H2F), (const char*)WSP(const unsigned char, WS_WGU8) + (size_t)layer * 64 * MiB, WSP(const int, WS_TOK), 1024, 1024, G, vc, (size_t)1048576, true};
                if constexpr (DN1_FP8) { g8::EpiGu8 E{WSP(unsigned char, WS_ACT)}; g8::gemm_phase<g8::EpiGu8, g8::MoeSched, true, true>(ldsb, 1024, 1024, S, E);
                    if constexpr (layer == 0 && MOE0_FP8 && MOE1_FP8) conv_in_moe_tail(p, ldsb, tab, G, vc, CONV_LATEB, CONV_LATEBN); }
                else { g8::EpiGu E{WSP(bf16_t, WS_ACT), 1.f / (F8_SH * F8_SW)}; g8::gemm_phase<g8::EpiGu, g8::MoeSched, true, true>(ldsb, 1024, 1024, S, E); } }
            else { g8::MoeSched S{tab, (const char*)WSP(const bf16_t, WS_H2), (const char*)(WSP(const bf16_t, WS_WGU) + (size_t)layer * 32 * 1048576), WSP(const int, WS_TOK), 1024 * 2, 1024 * 2, G, vc, (size_t)1048576 * 2, true};
                g8::EpiGu E{WSP(bf16_t, WS_ACT), 1.f}; g8::gemm_phase<g8::EpiGu, g8::MoeSched, true>(ldsb, 1024 * 2, 1024 * 2, S, E); } }
        else { FGu f{p, layer}; rowgemm<1024, 1024>(f, lds); } }
    else if constexpr (PH == PH_DN0 || PH == PH_DN1) { constexpr int layer = (PH == PH_DN1);
        if constexpr (OPT_MOE) { g8::moe_tables(p, layer, tab);
            if constexpr (layer == 1 ? MOE1_FP8 : MOE0_FP8) {
                g8::MoeSched S{tab, (const char*)WSP(const unsigned char, WS_ACT), (const char*)WSP(const unsigned char, WS_WDN8) + (size_t)layer * 32 * MiB, WSP(const int, WS_TOK), 512, 512, G, vc, (size_t)524288, false};
                g8::EpiDnLite E{WSP(const int, WS_DST), WSP(const float, WS_WSO), WSP(bf16_t, WS_YS), 1.f / (F8_SA * F8_SW)};
                g8::gemm_phase<g8::EpiDnLite, g8::MoeSched, false, true>(ldsb, 512, 512, S, E);
                if constexpr (layer == 0 && MOE0_FP8 && MOE1_FP8 && DN1_FP8) conv_in_moe_tail(p, ldsb, tab, G, vc, CONV_LATEC, CONV_LATEBN); }
            else { g8::MoeSched S{tab, (const char*)WSP(const bf16_t, WS_ACT), (const char*)(WSP(const bf16_t, WS_WDN) + (size_t)layer * 32 * 524288), WSP(const int, WS_TOK), 512 * 2, 512 * 2, G, vc, (size_t)524288 * 2, false};
                g8::EpiDn E{WSP(const int, WS_DST), WSP(const float, WS_WSO), WSP(bf16_t, WS_YS), 1.f}; g8::gemm_phase<g8::EpiDn, g8::MoeSched, false>(ldsb, 512 * 2, 512 * 2, S, E); } }
        else { FDn f{p, layer}; rowgemm<512, 1024>(f, lds); } }
    else if constexpr (PH == PH_COMB0) ph_combine(p, 0, WSP(const bf16_t, WS_X1));
    else if constexpr (PH == PH_RIN) {
        if constexpr (OPT_RIN) {
            if constexpr (RNN_FP8) { g8::DenseSched S; S.init(WSP(const bf16_t, WS_HB), 512, WSP(const bf16_t, WS_WRINT), 512, T, 2048);
                g8::EpiRin E{WSP(bf16_t, WS_GG), WSP(bf16_t, WS_X1), 1.f / (F8_SH * F8_SW)}; g8::gemm_phase<g8::EpiRin, g8::DenseSched, false, true>(ldsb, 1024, 1024, S, E); }
            else { g8::DenseSched S; S.init(WSP(const bf16_t, WS_HB), 1024, WSP(const bf16_t, WS_WRINT), 1024, T, 2048);
                g8::EpiRin E{WSP(bf16_t, WS_GG), WSP(bf16_t, WS_X1), 1.f}; g8::gemm_phase<g8::EpiRin, g8::DenseSched, false>(ldsb, 1024 * 2, 1024 * 2, S, E); } }
        else { FRin f{p}; rowgemm<1024, 2048>(f, lds); } }
    else if constexpr (PH == PH_CONV) ph_conv(p);
    else if constexpr (PH == PH_GATE) {
        if constexpr (OPT_RNN) { g8::GateSched S{(const char*)WSP(const bf16_t, WS_H2), (const char*)WSP(const bf16_t, WS_WGT), G, vc};
            g8::EpiGate E{WSP(const bf16_t, WS_H2), IN_F(20), IN_F(22), IN_F(25), IN_F(27), WSP(const float, WS_SPL), WSP(unsigned, WS_SF), WSP(unsigned, WS_SB)};
            g8::gemm_phase<g8::EpiGate, g8::GateSched, false>(ldsb, 256 * 2, 1024 * 2, S, E); }
        else { FGate f{p}; rowgemm<256, 1024>(f, lds); } }
    else if constexpr (PH == PH_SCAN) { if constexpr (OPT_RNN) ph_scan1(p); else ph_scan(p); }
    else if constexpr (PH == PH_SCAN2) { if constexpr (OPT_RNN) ph_scan2(p); }
    else if constexpr (PH == PH_RO) {
        if constexpr (OPT_RES) {
            if constexpr (RNN_FP8) { g8::DenseSched S; S.init(WSP(const bf16_t, WS_YF), 512, WSP(const bf16_t, WS_WROT), 512, T, 1024);
                g8::EpiRes<false> E{WSP(const void, WS_X2), WSP(const float, WS_MOD) + 16 * 6144 + 2048, WSP(bf16_t, WS_X1), 1.f / (F8_SY * F8_SW)}; g8::gemm_phase<g8::EpiRes<false>, g8::DenseSched, false, true>(ldsb, 1024, 1024, S, E); }
            else { g8::DenseSched S; S.init(WSP(const bf16_t, WS_GG), 1024, WSP(const bf16_t, WS_WROT), 1024, T, 1024);
                g8::EpiRes<false> E{WSP(const void, WS_X2), WSP(const float, WS_MOD) + 16 * 6144 + 2048, WSP(bf16_t, WS_X1), 1.f}; g8::gemm_phase<g8::EpiRes<false>, g8::DenseSched, false>(ldsb, 1024 * 2, 1024 * 2, S, E); } }
        else { FRes<false> f{p, WSP(const bf16_t, WS_GG), IN_F(28), WSP(const void, WS_X2), WSP(const float, WS_MOD) + 16 * 6144 + 2048, WSP(bf16_t, WS_X1)}; rowgemm<1024, 1024>(f, lds); } }
    else if constexpr (PH == PH_ROUTE1) { if constexpr (OPT_RTE) ph_router_opt(p, 1, WSP(const bf16_t, WS_X1), ldsb); else ph_router(p, 1, WSP(const bf16_t, WS_X1)); }
    else if constexpr (PH == PH_COMB1) ph_combine(p, 1, WSP(const bf16_t, WS_X1));
}
#ifndef PROBE_MASK
#define PROBE_MASK 0u
#endif
template <int PH> __device__ __forceinline__ void run_from(const Params& p, float* lds, const XcdBarrier& bar) {
    run_phase<PH>(p, lds);
    if constexpr ((PROBE_MASK >> PH) & 1u) { xcd_barrier(bar); run_phase<PH>(p, lds); }
    if constexpr (PH + 1 < PH_COUNT) { xcd_barrier(bar); run_from<PH + 1>(p, lds, bar); }
}

__global__ void __launch_bounds__(512, 2) k_mega(Params p) {
    extern __shared__ __attribute__((aligned(16))) unsigned char lds_raw[];
    float* lds = (float*)lds_raw;
    volatile LAS unsigned* st = (volatile LAS unsigned*)((LAS unsigned char*)lds_raw + LDS_BYTES - 64);
    if (otid() == 0) { st[0] = 0u; st[1] = 0u; }
    __syncthreads();
    XcdBarrier bar = xcd_barrier_post(WSP(unsigned, WS_CTL) + CW_BAR, st);
    run_from<0>(p, lds, bar);
}

extern "C" void kernel_launch(void* const* d_in, const int* in_sizes, int n_in, void* d_out, int out_size, void* d_ws, size_t ws_size, hipStream_t stream) {
    if (n_in != 33 || ws_size < WS_END) { fprintf(stderr, "kernel_launch: unexpected n_in %d / ws_size %zu\n", n_in, ws_size); return; }
    static int grid = 0;
    if (grid == 0) {
        int dev = 0, cus = 0;
        if (hipGetDevice(&dev) != hipSuccess || hipDeviceGetAttribute(&cus, hipDeviceAttributeMultiprocessorCount, dev) != hipSuccess) { grid = -1; return; }
        if (hipFuncSetAttribute((const void*)k_mega, hipFuncAttributeMaxDynamicSharedMemorySize, LDS_BYTES) != hipSuccess) { grid = -1; return; }
        int nb = 0;
        if (hipOccupancyMaxActiveBlocksPerMultiprocessor(&nb, (const void*)k_mega, 512, LDS_BYTES) != hipSuccess || nb < 1) { grid = -1; return; }
        grid = cus;
    }
    if (grid < 0) return;
    Params p{};
    for (int i = 0; i < 33; ++i) p.in[i] = d_in[i];
    p.out = (float*)d_out; p.ws = (unsigned char*)d_ws;
    (void)hipMemsetAsync((char*)d_ws + WS_CTL, 0, 1 * MiB, stream);
    k_mega<<<dim3(grid), dim3(512), LDS_BYTES, stream>>>(p);
}
#ifdef PHASE_KERNELS
template <int PH> __global__ void __launch_bounds__(512, 2) k_one(Params p) {
    extern __shared__ __attribute__((aligned(16))) unsigned char lds_raw[];
    run_phase<PH>(p, (float*)lds_raw);
}
template __global__ void k_one<0>(Params); template __global__ void k_one<1>(Params); template __global__ void k_one<2>(Params); template __global__ void k_one<3>(Params);
template __global__ void k_one<4>(Params); template __global__ void k_one<5>(Params); template __global__ void k_one<6>(Params); template __global__ void k_one<7>(Params);
template __global__ void k_one<8>(Params); template __global__ void k_one<9>(Params); template __global__ void k_one<10>(Params); template __global__ void k_one<11>(Params);
template __global__ void k_one<12>(Params); template __global__ void k_one<13>(Params); template __global__ void k_one<14>(Params); template __global__ void k_one<15>(Params);
template __global__ void k_one<16>(Params); template __global__ void k_one<17>(Params); template __global__ void k_one<18>(Params); template __global__ void k_one<19>(Params);
#endif
```

```cpp
#include <hip/hip_runtime.h>
#include <stdint.h>
#include <stdio.h>

constexpr int T = 32768, D = 1024, NB = 16, SQ = 2048, NH = 16;
constexpr int QL = 384, KVL = 256, LATN = 672, LATP = 768;
constexpr int NE = 32, DE = 512;
constexpr float EPS = 1e-6f;
constexpr bool YS1_FP8 = true;
constexpr float F8_SYO = 32.f;
constexpr bool QFUSE = true;
constexpr bool MOE0_FP8 = true, MOE1_FP8 = true;
constexpr bool RNN_FP8 = false;
constexpr float F8_SY = 4.f;
constexpr bool DN1_FP8 = true;
constexpr float F8_SH = 16.f, F8_SW = 64.f, F8_SA = 8.f;
constexpr float QSCALE = 0.10206207261596577f * 1.4426950408889634f;

typedef unsigned short bf16_t;
typedef float f32x4 __attribute__((ext_vector_type(4)));
typedef unsigned u32x2 __attribute__((ext_vector_type(2)));
typedef unsigned u32x4 __attribute__((ext_vector_type(4)));

__device__ __forceinline__ int otid() { int t = (int)__builtin_amdgcn_workitem_id_x(); asm volatile("" : "+v"(t)); return t; }
__device__ __forceinline__ float bf2f(bf16_t v) { return __uint_as_float(((unsigned)v) << 16); }
__device__ __forceinline__ bf16_t f2bf(float f) { unsigned u = __float_as_uint(f); return (bf16_t)((u + 0x7fffu + ((u >> 16) & 1u)) >> 16); }
__device__ __forceinline__ unsigned pk2(float lo, float hi) { return (unsigned)f2bf(lo) | ((unsigned)f2bf(hi) << 16); }
__device__ __forceinline__ unsigned pk4_fp8_(float a, float b, float c, float d) {
    a = fminf(fmaxf(a, -448.f), 448.f); b = fminf(fmaxf(b, -448.f), 448.f); c = fminf(fmaxf(c, -448.f), 448.f); d = fminf(fmaxf(d, -448.f), 448.f);
    int r = 0; r = __builtin_amdgcn_cvt_pk_fp8_f32(a, b, r, false); r = __builtin_amdgcn_cvt_pk_fp8_f32(c, d, r, true); return (unsigned)r; }
__device__ __forceinline__ float wave_sum(float v) {
#pragma unroll
    for (int o = 1; o < 64; o <<= 1) v += __shfl_xor(v, o);
    return v;
}
__device__ __forceinline__ float sigmoidf_(float x) { return 1.f / (1.f + __expf(-x)); }
__device__ __forceinline__ float siluf_(float x) { return x * sigmoidf_(x); }
__device__ __forceinline__ float gelu_tanh(float x) { const float u = 0.7978845608028654f * (x + 0.044715f * x * x * x); return 0.5f * x * (1.f + tanhf(u)); }

constexpr size_t MiB = 1u << 20;
constexpr size_t WS_CTL = 0;
constexpr size_t WS_MOD = 1 * MiB;
constexpr size_t WS_COS = 2 * MiB;
constexpr size_t WS_SIN = 4 * MiB;
constexpr size_t WS_RTE = 6 * MiB;
constexpr size_t WS_TOK = 7 * MiB;
constexpr size_t WS_SSQ = 11 * MiB;
constexpr size_t WS_DST = 12 * MiB;
constexpr size_t WS_WSO = 16 * MiB;
constexpr size_t WS_W1T = 20 * MiB;
constexpr size_t WS_WQT = 22 * MiB;
constexpr size_t WS_WKVT = 24 * MiB;
constexpr size_t WS_WOT = 25 * MiB;
constexpr size_t WS_WRINT = 27 * MiB;
constexpr size_t WS_WGT = 31 * MiB;
constexpr size_t WS_WROT = 33 * MiB;
constexpr size_t WS_WGU = 36 * MiB;
constexpr size_t WS_WDN = 164 * MiB;
constexpr size_t WS_WGU8 = WS_WGU;
constexpr size_t WS_WDN8 = WS_WDN;
constexpr size_t WS_HB = 228 * MiB;
constexpr size_t WS_X1 = 292 * MiB;
constexpr size_t WS_H2 = 356 * MiB;
constexpr size_t WS_X2 = 420 * MiB;
constexpr size_t WS_U = 484 * MiB;
constexpr size_t WS_LAT = WS_U;
constexpr size_t WS_Q = WS_U + 48 * MiB;
constexpr size_t WS_K = WS_U + 144 * MiB;
constexpr size_t WS_V = WS_U + 240 * MiB;
constexpr size_t WS_O = WS_U + 304 * MiB;
constexpr size_t WS_SSQP = WS_U + 368 * MiB;
constexpr size_t WS_ROPEK = WS_U + 372 * MiB;
constexpr size_t WS_PESSQ = WS_U + 376 * MiB;
constexpr size_t WS_ACT = WS_U;
constexpr size_t WS_YS = WS_U + 72 * MiB;
constexpr size_t WS_YF = WS_U + 448 * MiB;
constexpr size_t WS_H2F = WS_U + 200 * MiB;
constexpr size_t WS_AF = WS_U;
constexpr size_t WS_AB = WS_U + 128 * MiB;
constexpr size_t WS_BXF = WS_U + 256 * MiB;
constexpr size_t WS_BXB = WS_U + 320 * MiB;
constexpr size_t WS_GG = WS_U + 384 * MiB;
constexpr size_t WS_SF = WS_U;
constexpr size_t WS_SB = WS_U + 128 * MiB;
constexpr size_t WS_SUM = WS_U + 256 * MiB;
constexpr size_t WS_SMAX = 11 * MiB + 768 * 1024;
constexpr size_t WS_SPL = 11 * MiB + 512 * 1024;
constexpr size_t WS_END = 1024 * MiB;
constexpr int CW_CNT = 1024;

struct Params { const void* in[33]; float* out; unsigned char* ws; };
__host__ __device__ __forceinline__ size_t kidx(int bh, int s, int d) { return ((size_t)(bh * 32 + (s >> 6)) * 12 + (d >> 3)) * 512 + (s & 63) * 8 + (d & 7); }
__host__ __device__ __forceinline__ size_t vidx(int bh, int s, int d) { return ((size_t)(bh * 32 + (s >> 6)) * 2 + (d >> 5)) * 2048 + (s & 63) * 32 + (d & 31); }

#define IN_F(i) ((const float*)p.in[i])
#define WSP(T_, off) ((T_*)(p.ws + (off)))

template <int K, int N, class F>
__device__ __forceinline__ void rowgemm(const F& f, float* lds) {
    constexpr int R = 8, NC = (N + 511) / 512;
    float* As = lds;
    float* Cs = lds + R * K;
    int* info = (int*)(Cs + R * N);
    const int tid = otid();
    const int nun = f.nunits();
    for (int u = blockIdx.x; u < nun; u += gridDim.x) {
        f.prep(u, info);
        __syncthreads();
        for (int i = tid; i < R * K; i += 512) { const int r = i / K, k = i % K; As[i] = f.a(u, info, r, k); }
        __syncthreads();
        float acc[NC][R];
#pragma unroll
        for (int c = 0; c < NC; ++c)
#pragma unroll
            for (int r = 0; r < R; ++r) acc[c][r] = 0.f;
        for (int k = 0; k < K; k += 4) {
            float bv[NC][4];
#pragma unroll
            for (int c = 0; c < NC; ++c) { const int n = tid + c * 512;
#pragma unroll
                for (int kk = 0; kk < 4; ++kk) bv[c][kk] = (n < N) ? f.b(u, info, k + kk, n) : 0.f; }
#pragma unroll
            for (int r = 0; r < R; ++r) { const f32x4 av = *(const f32x4*)(As + r * K + k);
#pragma unroll
                for (int c = 0; c < NC; ++c) { acc[c][r] += av[0] * bv[c][0]; acc[c][r] += av[1] * bv[c][1]; acc[c][r] += av[2] * bv[c][2]; acc[c][r] += av[3] * bv[c][3]; } }
        }
#pragma unroll
        for (int c = 0; c < NC; ++c) { const int n = tid + c * 512; if (n < N) {
#pragma unroll
            for (int r = 0; r < R; ++r) Cs[r * N + n] = acc[c][r]; } }
        __syncthreads();
        f.epi(u, info, Cs);
        __syncthreads();
    }
}

__device__ __forceinline__ void ph_prologue(const Params& p, float* lds) {
    const int tid = otid();
    float* cact = lds;
    float* red = lds + 16 * 1024;
    const float* c = IN_F(1);
    { float cv[32];
#pragma unroll
      for (int k = 0; k < 32; ++k) cv[k] = c[tid + 512 * k];
#pragma unroll
      for (int k = 0; k < 32; ++k) cact[tid + 512 * k] = siluf_(cv[k]); }
    __syncthreads();
    const float* wada = IN_F(5); const float* bada = IN_F(6);
    float* mod = WSP(float, WS_MOD);
    const int cl = tid & 31, ks = tid >> 5;
    for (int t = blockIdx.x; t < 384; t += gridDim.x) {
        const int l = t / 192, col0 = (t % 192) * 32;
        float acc[16];
#pragma unroll
        for (int b = 0; b < 16; ++b) acc[b] = 0.f;
        const float* w = wada + (size_t)l * 1024 * 6144 + col0 + cl;
#pragma unroll 1
        for (int k0 = ks * 64; k0 < ks * 64 + 64; k0 += 32) { float wv[32];
#pragma unroll
            for (int q = 0; q < 32; ++q) wv[q] = __builtin_nontemporal_load(w + (size_t)(k0 + q) * 6144);
#pragma unroll
            for (int q = 0; q < 32; ++q) {
#pragma unroll
                for (int b = 0; b < 16; ++b) acc[b] += cact[b * 1024 + k0 + q] * wv[q];
                asm volatile("" ::: "memory"); } }
#pragma unroll
        for (int b = 0; b < 16; ++b) red[(ks * 16 + b) * 32 + cl] = acc[b];
        __syncthreads();
        { const int b = tid >> 5; float s = 0.f;
#pragma unroll
          for (int q = 0; q < 16; ++q) s += red[(q * 16 + b) * 32 + cl];
          mod[((size_t)l * 16 + b) * 6144 + col0 + cl] = s + bada[l * 6144 + col0 + cl]; }
        __syncthreads();
    }
    { float* spl = WSP(float, WS_SPL); for (int i = blockIdx.x * 512 + tid; i < 2048; i += gridDim.x * 512) { const float lam = (i < 1024) ? IN_F(18)[i] : IN_F(23)[i - 1024]; spl[i] = -8.f * 1.4426950408889634f * log1pf(expf(-lam)); } }
    if (blockIdx.x == 0 && tid < 64) { float mq = 0.f, mk = 0.f; for (int i = tid; i < 96; i += 64) { mq = fmaxf(mq, fabsf(IN_F(12)[i])); mk = fmaxf(mk, fabsf(IN_F(13)[i])); }
#pragma unroll
        for (int o = 1; o < 64; o <<= 1) { mq = fmaxf(mq, __shfl_xor(mq, o)); mk = fmaxf(mk, __shfl_xor(mk, o)); }
        if (tid == 0) *WSP(float, WS_SMAX) = 1.02f * 96.f * mq * mk * QSCALE + 0.01f; }
    const int* pos = (const int*)p.in[2];
    float* ct = WSP(float, WS_COS); float* st = WSP(float, WS_SIN);
    for (int i = blockIdx.x * 512 + tid; i < T * 16; i += gridDim.x * 512) {
        const int tok = i >> 4, j = i & 15;
        const float inv = exp2f(-(float)j * (13.287712379549449f / 16.f));
        const float ang = (float)pos[tok] * inv;
        const double rev = (double)ang * 0.15915494309189535;
        const float fr = (float)(rev - floor(rev));
        ct[i] = __builtin_amdgcn_cosf(fr); st[i] = __builtin_amdgcn_sinf(fr);
    }
}

__device__ __forceinline__ void row_load_f32(const float* row, int lane, float (&v)[16]) {
#pragma unroll
    for (int j = 0; j < 4; ++j) { const f32x4 x = *(const f32x4*)(row + j * 256 + lane * 4); v[4 * j] = x[0]; v[4 * j + 1] = x[1]; v[4 * j + 2] = x[2]; v[4 * j + 3] = x[3]; }
}
__device__ __forceinline__ void row_load_bf16(const bf16_t* row, int lane, float (&v)[16]) {
#pragma unroll
    for (int j = 0; j < 4; ++j) { const u32x2 x = *(const u32x2*)(row + j * 256 + lane * 4);
        v[4 * j] = __uint_as_float(x[0] << 16); v[4 * j + 1] = __uint_as_float(x[0] & 0xffff0000u); v[4 * j + 2] = __uint_as_float(x[1] << 16); v[4 * j + 3] = __uint_as_float(x[1] & 0xffff0000u); }
}
__device__ __forceinline__ void row_store_bf16(bf16_t* row, int lane, const float (&v)[16]) {
#pragma unroll
    for (int j = 0; j < 4; ++j) { u32x2 x; x[0] = pk2(v[4 * j], v[4 * j + 1]); x[1] = pk2(v[4 * j + 2], v[4 * j + 3]); *(u32x2*)(row + j * 256 + lane * 4) = x; }
}
__device__ __forceinline__ void row_modulate(float (&v)[16], int lane, const float* g, const float* sh, const float* sc) {
    float s = 0.f;
#pragma unroll
    for (int i = 0; i < 16; ++i) s += v[i] * v[i];
    const float rstd = rsqrtf(wave_sum(s) * (1.f / 1024.f) + EPS);
#pragma unroll
    for (int j = 0; j < 4; ++j) { const int c0 = j * 256 + lane * 4;
        const f32x4 gg = *(const f32x4*)(g + c0), s1 = *(const f32x4*)(sc + c0), s0 = *(const f32x4*)(sh + c0);
#pragma unroll
        for (int i = 0; i < 4; ++i) v[4 * j + i] = v[4 * j + i] * rstd * gg[i] * (1.f + s1[i]) + s0[i]; }
}

__device__ __forceinline__ void ph_norm0(const Params& p) {
    const int lane = otid() & 63, gw = blockIdx.x * 8 + (otid() >> 6), ngw = gridDim.x * 8;
    const float* x = IN_F(0); const float* g = IN_F(3); const float* mod = WSP(float, WS_MOD); bf16_t* hb = WSP(bf16_t, WS_HB);
#pragma unroll 1
    for (int run = gw; run < T / 16; run += ngw) { const int row0 = run * 16, b = row0 >> 11; const float* mb = mod + (size_t)b * 6144;
        float gm[16], sh[16];
#pragma unroll
        for (int j = 0; j < 4; ++j) { const int c0 = j * 256 + lane * 4; const f32x4 gg = *(const f32x4*)(g + c0), s1 = *(const f32x4*)(mb + 1024 + c0), s0 = *(const f32x4*)(mb + c0);
#pragma unroll
            for (int i = 0; i < 4; ++i) { gm[4 * j + i] = gg[i] * (1.f + s1[i]); sh[4 * j + i] = s0[i]; } }
        f32x4 nx[4], ny[4];
#pragma unroll
        for (int j = 0; j < 4; ++j) { nx[j] = __builtin_nontemporal_load((const f32x4*)(x + (size_t)row0 * D + j * 256 + lane * 4)); ny[j] = __builtin_nontemporal_load((const f32x4*)(x + (size_t)(row0 + 1) * D + j * 256 + lane * 4)); }
#pragma unroll 1
        for (int k = 0; k < 16; ++k) { const int row = row0 + k, nrow = row0 + (k < 14 ? k + 2 : 15); float v[16];
#pragma unroll
            for (int j = 0; j < 4; ++j) { v[4 * j] = nx[j][0]; v[4 * j + 1] = nx[j][1]; v[4 * j + 2] = nx[j][2]; v[4 * j + 3] = nx[j][3]; nx[j] = ny[j]; }
#pragma unroll
            for (int j = 0; j < 4; ++j) ny[j] = __builtin_nontemporal_load((const f32x4*)(x + (size_t)nrow * D + j * 256 + lane * 4));
            float s_ = 0.f;
#pragma unroll
            for (int i = 0; i < 16; ++i) s_ += v[i] * v[i];
            const float rstd = rsqrtf(wave_sum(s_) * (1.f / 1024.f) + EPS);
#pragma unroll
            for (int i = 0; i < 16; ++i) v[i] = v[i] * rstd * gm[i] + sh[i];
            row_store_bf16(hb + (size_t)row * D, lane, v); } }
}

struct FLat { const Params& p;
    __device__ __forceinline__ int nunits() const { return T / 8; }
    __device__ __forceinline__ void prep(int, int*) const {}
    __device__ __forceinline__ float a(int u, const int*, int r, int k) const { return bf2f(WSP(const bf16_t, WS_HB)[(size_t)(u * 8 + r) * D + k]); }
    __device__ __forceinline__ float b(int, const int*, int k, int n) const { return IN_F(7)[(size_t)k * LATN + n]; }
    __device__ __forceinline__ void epi(int u, const int*, const float* Cs) const {
        bf16_t* lat = WSP(bf16_t, WS_LAT); float* ssq = WSP(float, WS_SSQ);
        const int tid = otid(), r = tid >> 6, lane = tid & 63; const int row = u * 8 + r;
        float s0 = 0.f, s1 = 0.f;
        for (int n = lane; n < LATN; n += 64) { const float v = Cs[r * LATN + n]; lat[(size_t)row * LATP + n] = f2bf(v); if (n < QL) s0 += v * v; else if (n < QL + KVL) s1 += v * v; }
        s0 = wave_sum(s0); s1 = wave_sum(s1);
        if (lane == 0) { ssq[row * 2] = s0; ssq[row * 2 + 1] = s1; }
    }
};
struct FQ { const Params& p;
    __device__ __forceinline__ int nunits() const { return T / 8; }
    __device__ __forceinline__ void prep(int, int*) const {}
    __device__ __forceinline__ float a(int u, const int*, int r, int k) const { const int row = u * 8 + r;
        const float rstd = rsqrtf(WSP(const float, WS_SSQ)[row * 2] * (1.f / QL) + EPS);
        return bf2f(WSP(const bf16_t, WS_LAT)[(size_t)row * LATP + k]) * rstd * IN_F(8)[k]; }
    __device__ __forceinline__ float b(int, const int*, int k, int n) const { return IN_F(10)[(size_t)k * 1536 + n]; }
    __device__ __forceinline__ void epi(int u, const int*, const float* Cs) const {
        const int tid = otid(); if (tid >= 128) return;
        const int r = tid >> 4, h = tid & 15, row = u * 8 + r, b = row >> 11, s = row & 2047;
        const float* c = Cs + r * 1536 + h * 96; const float* gn = IN_F(12);
        float ss = 0.f; for (int d = 0; d < 96; ++d) ss += c[d] * c[d];
        const float rstd = rsqrtf(ss * (1.f / 96.f) + EPS) ;
        bf16_t* q = WSP(bf16_t, WS_Q) + ((size_t)(b * NH + h) * SQ + s) * 96;
        for (int d = 0; d < 64; ++d) q[d] = f2bf(c[d] * rstd * gn[d] * QSCALE);
        const float* ct = WSP(const float, WS_COS) + (size_t)row * 16; const float* st = WSP(const float, WS_SIN) + (size_t)row * 16;
        for (int i = 0; i < 16; ++i) { const float x1 = c[64 + i] * rstd * gn[64 + i], x2 = c[80 + i] * rstd * gn[80 + i];
            q[64 + i] = f2bf((x1 * ct[i] - x2 * st[i]) * QSCALE); q[80 + i] = f2bf((x1 * st[i] + x2 * ct[i]) * QSCALE); }
    }
};
struct FKV { const Params& p;
    __device__ __forceinline__ int nunits() const { return T / 8; }
    __device__ __forceinline__ void prep(int, int*) const {}
    __device__ __forceinline__ float a(int u, const int*, int r, int k) const { const int row = u * 8 + r;
        const float rstd = rsqrtf(WSP(const float, WS_SSQ)[row * 2 + 1] * (1.f / KVL) + EPS);
        return bf2f(WSP(const bf16_t, WS_LAT)[(size_t)row * LATP + QL + k]) * rstd * IN_F(9)[k]; }
    __device__ __forceinline__ float b(int, const int*, int k, int n) const { return IN_F(11)[(size_t)k * 2048 + n]; }
    __device__ __forceinline__ void epi(int u, const int*, const float* Cs) const {
        const int tid = otid(); if (tid >= 128) return;
        const int r = tid >> 4, h = tid & 15, row = u * 8 + r, b = row >> 11, s = row & 2047;
        const float* c = Cs + r * 2048 + h * 128; const float* gn = IN_F(13);
        const bf16_t* pe = WSP(const bf16_t, WS_LAT) + (size_t)row * LATP + QL + KVL;
        float ss = 0.f; for (int d = 0; d < 64; ++d) ss += c[d] * c[d];
        for (int j = 0; j < 32; ++j) { const float v = bf2f(pe[j]); ss += v * v; }
        const float rstd = rsqrtf(ss * (1.f / 96.f) + EPS);
        bf16_t* kk = WSP(bf16_t, WS_K); bf16_t* vv = WSP(bf16_t, WS_V); const int bh = b * NH + h;
        for (int d = 0; d < 64; ++d) { kk[kidx(bh, s, d)] = f2bf(c[d] * rstd * gn[d]); vv[vidx(bh, s, d)] = f2bf(c[64 + d]); }
        const float* ct = WSP(const float, WS_COS) + (size_t)row * 16; const float* st = WSP(const float, WS_SIN) + (size_t)row * 16;
        for (int i = 0; i < 16; ++i) { const float x1 = bf2f(pe[i]) * rstd * gn[64 + i], x2 = bf2f(pe[16 + i]) * rstd * gn[80 + i];
            kk[kidx(bh, s, 64 + i)] = f2bf(x1 * ct[i] - x2 * st[i]); kk[kidx(bh, s, 80 + i)] = f2bf(x1 * st[i] + x2 * ct[i]); }
    }
};

__device__ __forceinline__ void ph_attn(const Params& p, float* lds) {
    constexpr int KT = 16;
    float* Ks = lds;
    float* Vs = lds + KT * 96;
    const int tid = otid();
    const bf16_t* Qg = WSP(const bf16_t, WS_Q); const bf16_t* Kg = WSP(const bf16_t, WS_K); const bf16_t* Vg = WSP(const bf16_t, WS_V);
    bf16_t* Og = WSP(bf16_t, WS_O);
    for (int u = blockIdx.x; u < 1024; u += gridDim.x) {
        const int bh = u >> 2, qc = u & 3, s = qc * 512 + tid;
        unsigned qp[48];
        { const bf16_t* qptr = Qg + ((size_t)bh * SQ + s) * 96;
#pragma unroll
          for (int d = 0; d < 48; d += 4) { const u32x4 x = *(const u32x4*)(qptr + 2 * d); qp[d] = x[0]; qp[d + 1] = x[1]; qp[d + 2] = x[2]; qp[d + 3] = x[3]; } }
        float o[64];
#pragma unroll
        for (int d = 0; d < 64; ++d) o[d] = 0.f;
        float m = -INFINITY, l = 0.f;
        for (int t0 = 0; t0 < SQ; t0 += KT) {
            __syncthreads();
            for (int i = tid; i < KT * 96; i += 512) Ks[i] = bf2f(Kg[kidx(bh, t0 + i / 96, i % 96)]);
            for (int i = tid; i < KT * 64; i += 512) Vs[i] = bf2f(Vg[vidx(bh, t0 + i / 64, i % 64)]);
            __syncthreads();
#pragma unroll 1
            for (int j = 0; j < KT; ++j) { float a = 0.f;
#pragma unroll
                for (int d = 0; d < 96; d += 4) { const f32x4 kv = *(const f32x4*)(Ks + j * 96 + d); const unsigned w0 = qp[d >> 1], w1 = qp[(d >> 1) + 1];
                    a += __uint_as_float(w0 << 16) * kv[0]; a += __uint_as_float(w0 & 0xffff0000u) * kv[1]; a += __uint_as_float(w1 << 16) * kv[2]; a += __uint_as_float(w1 & 0xffff0000u) * kv[3]; }
                const float mn = fmaxf(m, a), alpha = exp2f(m - mn), pj = exp2f(a - mn); m = mn;
                l = l * alpha + pj;
#pragma unroll
                for (int d = 0; d < 64; d += 4) { const f32x4 vv = *(const f32x4*)(Vs + j * 64 + d);
                    o[d] = o[d] * alpha + pj * vv[0]; o[d + 1] = o[d + 1] * alpha + pj * vv[1]; o[d + 2] = o[d + 2] * alpha + pj * vv[2]; o[d + 3] = o[d + 3] * alpha + pj * vv[3]; } }
        }
        const float rl = 1.f / l; const int b = bh >> 4, h = bh & 15;
        bf16_t* op = Og + ((size_t)(b * SQ + s)) * D + h * 64;
#pragma unroll
        for (int d = 0; d < 64; d += 8) { u32x4 x;
#pragma unroll
            for (int i = 0; i < 4; ++i) x[i] = pk2(o[d + 2 * i] * rl, o[d + 2 * i + 1] * rl);
            *(u32x4*)(op + d) = x; }
    }
}

template <bool RESID_F32>
struct FRes { const Params& p; const bf16_t* A; const float* W; const void* resid; const float* gate  ; bf16_t* out;
    __device__ __forceinline__ int nunits() const { return T / 8; }
    __device__ __forceinline__ void prep(int, int*) const {}
    __device__ __forceinline__ float a(int u, const int*, int r, int k) const { return bf2f(A[(size_t)(u * 8 + r) * D + k]); }
    __device__ __forceinline__ float b(int, const int*, int k, int n) const { return W[(size_t)k * D + n]; }
    __device__ __forceinline__ void epi(int u, const int*, const float* Cs) const {
        for (int i = otid(); i < 8 * D; i += 512) { const int r = i >> 10, n = i & 1023, row = u * 8 + r, b = row >> 11;
            const float rv = RESID_F32 ? ((const float*)resid)[(size_t)row * D + n] : bf2f(((const bf16_t*)resid)[(size_t)row * D + n]);
            out[(size_t)row * D + n] = f2bf(rv + gate[(size_t)b * 6144 + n] * Cs[i]); }
    }
};

__device__ __forceinline__ void ph_router(const Params& p, int layer, const bf16_t* xin) {
    const int lane = otid() & 63, gw = blockIdx.x * 8 + (otid() >> 6), ngw = gridDim.x * 8;
    const float* g = IN_F(4) + layer * D; const float* mod = WSP(float, WS_MOD) + (size_t)layer * 16 * 6144;
    const float* wr = IN_F(29); const float* rb = IN_F(30);
    bf16_t* h2 = WSP(bf16_t, WS_H2);
    int* re = WSP(int, WS_RTE); int* rp = re + T * 2; float* rw = (float*)(rp + T * 2);
    int* tok = WSP(int, WS_TOK); unsigned* cnt = WSP(unsigned, WS_CTL) + CW_CNT + layer * 32;
    for (int row = gw; row < T; row += ngw) { const int b = row >> 11; float v[16];
        row_load_bf16(xin + (size_t)row * D, lane, v);
        row_modulate(v, lane, g, mod + (size_t)b * 6144 + 3072, mod + (size_t)b * 6144 + 4096);
        row_store_bf16(h2 + (size_t)row * D, lane, v);
        float lg[32];
#pragma unroll
        for (int e = 0; e < 32; ++e) lg[e] = 0.f;
#pragma unroll
        for (int j = 0; j < 4; ++j)
#pragma unroll
            for (int i = 0; i < 4; ++i) { const float* w = wr + (size_t)(j * 256 + lane * 4 + i) * 32; const float hv = v[4 * j + i];
#pragma unroll
                for (int e = 0; e < 32; e += 4) { const f32x4 wv = *(const f32x4*)(w + e); lg[e] += hv * wv[0]; lg[e + 1] += hv * wv[1]; lg[e + 2] += hv * wv[2]; lg[e + 3] += hv * wv[3]; } }
#pragma unroll
        for (int e = 0; e < 32; ++e) lg[e] = wave_sum(lg[e]);
        float best = -INFINITY; int e1 = 0, e2 = 1; float s1 = 0.f, s2 = 0.f;
#pragma unroll
        for (int gq = 0; gq < 8; ++gq) {
            float sc[4], bi[4];
#pragma unroll
            for (int i = 0; i < 4; ++i) { sc[i] = 1.f / (1.f + expf(-lg[4 * gq + i])); bi[i] = sc[i] + rb[4 * gq + i]; }
            int i1 = 0; float v1 = bi[0], t1 = sc[0];
#pragma unroll
            for (int i = 1; i < 4; ++i) if (bi[i] > v1) { v1 = bi[i]; t1 = sc[i]; i1 = i; }
            int i2 = -1; float v2 = -INFINITY, t2 = 0.f;
#pragma unroll
            for (int i = 0; i < 4; ++i) if (i != i1 && bi[i] > v2) { v2 = bi[i]; t2 = sc[i]; i2 = i; }
            const float gs = v1 + v2;
            if (gs > best) { best = gs; e1 = 4 * gq + i1; e2 = 4 * gq + i2; s1 = t1; s2 = t2; }
        }
        if (lane == 0) {
            const float inv = 1.f / (s1 + s2);
            const int p1 = (int)atomicAdd(cnt + e1, 1u), p2 = (int)atomicAdd(cnt + e2, 1u);
            re[row * 2] = e1; re[row * 2 + 1] = e2; rp[row * 2] = p1; rp[row * 2 + 1] = p2; rw[row * 2] = s1 * inv; rw[row * 2 + 1] = s2 * inv;
            tok[(size_t)e1 * T + p1] = row; tok[(size_t)e2 * T + p2] = row;
            int* dstp = WSP(int, WS_DST); float* wso = WSP(float, WS_WSO);
            dstp[(size_t)e1 * T + p1] = row * 2; dstp[(size_t)e2 * T + p2] = row * 2 + 1; wso[(size_t)e1 * T + p1] = s1 * inv; wso[(size_t)e2 * T + p2] = s2 * inv;
        }
    }
}

struct MoeUnit {
    static __device__ __forceinline__ void prep(const Params& p, int layer, int u, int* info) {
        if (otid() == 0) {
            const unsigned* cnt = WSP(const unsigned, WS_CTL) + CW_CNT + layer * 32; const int* tok = WSP(const int, WS_TOK);
            int e = 0, g0 = 0, seg = 0;
            for (; e < 32; ++e) { const int c = (int)cnt[e], ng = (c + 7) >> 3; if (u < g0 + ng) break; g0 += ng; seg += ((c + 255) >> 8) << 8; }
            if (e >= 32) { info[0] = -1; }
            else { const int c = (int)cnt[e], pos0 = (u - g0) * 8; info[0] = e; info[1] = pos0; info[2] = c; info[3] = seg;
                for (int r = 0; r < 8; ++r) info[8 + r] = (pos0 + r < c) ? tok[(size_t)e * T + pos0 + r] : -1; }
        }
    }
};
struct FGu { const Params& p; int layer;
    __device__ __forceinline__ int nunits() const { return (2 * T) / 8 + 32; }
    __device__ __forceinline__ void prep(int u, int* info) const { MoeUnit::prep(p, layer, u, info); }
    __device__ __forceinline__ float a(int, const int* info, int r, int k) const { const int t = info[8 + r]; return (info[0] >= 0 && t >= 0) ? bf2f(WSP(const bf16_t, WS_H2)[(size_t)t * D + k]) : 0.f; }
    __device__ __forceinline__ float b(int, const int* info, int k, int n) const { const int e = info[0] < 0 ? 0 : info[0]; return IN_F(31)[((size_t)(layer * 32 + e) * 1024 + k) * 1024 + n]; }
    __device__ __forceinline__ void epi(int, const int* info, const float* Cs) const {
        if (info[0] < 0) return;
        bf16_t* act = WSP(bf16_t, WS_ACT);
        for (int i = otid(); i < 8 * DE; i += 512) { const int r = i >> 9, c = i & 511;
            if (info[8 + r] >= 0) act[(size_t)(info[3] + info[1] + r) * DE + c] = f2bf(siluf_(Cs[r * 1024 + c]) * Cs[r * 1024 + 512 + c]); }
    }
};
struct FDn { const Params& p; int layer;
    __device__ __forceinline__ int nunits() const { return (2 * T) / 8 + 32; }
    __device__ __forceinline__ void prep(int u, int* info) const { MoeUnit::prep(p, layer, u, info); }
    __device__ __forceinline__ float a(int, const int* info, int r, int k) const { return (info[0] >= 0 && info[8 + r] >= 0) ? bf2f(WSP(const bf16_t, WS_ACT)[(size_t)(info[3] + info[1] + r) * DE + k]) : 0.f; }
    __device__ __forceinline__ float b(int, const int* info, int k, int n) const { const int e = info[0] < 0 ? 0 : info[0]; return IN_F(32)[((size_t)(layer * 32 + e) * 512 + k) * 1024 + n]; }
    __device__ __forceinline__ void epi(int, const int* info, const float* Cs) const {
        if (info[0] < 0) return;
        const int* re = WSP(const int, WS_RTE); const float* rw = (const float*)(re + T * 4);
        bf16_t* ys = WSP(bf16_t, WS_YS);
        for (int i = otid(); i < 8 * D; i += 512) { const int r = i >> 10, n = i & 1023; const int t = info[8 + r];
            if (t >= 0) { const int slot = (re[t * 2] == info[0]) ? 0 : 1; ys[((size_t)t * 2 + slot) * D + n] = f2bf(rw[t * 2 + slot] * Cs[i]); } }
    }
};

__device__ __forceinline__ void ph_combine(const Params& p, int layer, const bf16_t* xmid) {
    const int lane = otid() & 63, gw = blockIdx.x * 8 + (otid() >> 6), ngw = gridDim.x * 8;
    const float* mod = WSP(float, WS_MOD); const bf16_t* ys = WSP(const bf16_t, WS_YS);
#pragma unroll 1
    for (int run = gw; run < T / 16; run += ngw) { const int row0 = run * 16, b = row0 >> 11;
        const float* g2 = mod + ((size_t)layer * 16 + b) * 6144 + 5120; const float* m1 = mod + ((size_t)16 + b) * 6144;
        float gt[16], gm[16], sh[16];
#pragma unroll
        for (int j = 0; j < 4; ++j) { const int c0 = j * 256 + lane * 4; const f32x4 gg = *(const f32x4*)(g2 + c0);
#pragma unroll
            for (int i = 0; i < 4; ++i) gt[4 * j + i] = gg[i];
            if (layer == 0) { const f32x4 gn = *(const f32x4*)(IN_F(3) + D + c0), s1 = *(const f32x4*)(m1 + 1024 + c0), s0 = *(const f32x4*)(m1 + c0);
#pragma unroll
                for (int i = 0; i < 4; ++i) { gm[4 * j + i] = gn[i] * (1.f + s1[i]); sh[4 * j + i] = s0[i]; } } }
        const bool y8 = YS1_FP8 && layer == 1; const unsigned char* ys8 = (const unsigned char*)ys;
        u32x2 nv[4], n0[4], n1[4];
#pragma unroll
        for (int j = 0; j < 4; ++j) { nv[j] = __builtin_nontemporal_load((const u32x2*)(xmid + (size_t)row0 * D + j * 256 + lane * 4));
            if (y8) { n0[j][0] = __builtin_nontemporal_load((const unsigned*)(ys8 + (size_t)row0 * 2 * D + j * 256 + lane * 4)); n1[j][0] = __builtin_nontemporal_load((const unsigned*)(ys8 + (size_t)row0 * 2 * D + D + j * 256 + lane * 4)); n0[j][1] = 0u; n1[j][1] = 0u; }
            else { n0[j] = __builtin_nontemporal_load((const u32x2*)(ys + (size_t)row0 * 2 * D + j * 256 + lane * 4)); n1[j] = __builtin_nontemporal_load((const u32x2*)(ys + (size_t)row0 * 2 * D + D + j * 256 + lane * 4)); } }
#pragma unroll 1
        for (int k = 0; k < 16; ++k) { const int row = row0 + k, nrow = row0 + (k < 15 ? k + 1 : k); float v[16];
#pragma unroll
            for (int j = 0; j < 4; ++j) {
                const float a0 = __uint_as_float(nv[j][0] << 16), a1 = __uint_as_float(nv[j][0] & 0xffff0000u), a2 = __uint_as_float(nv[j][1] << 16), a3 = __uint_as_float(nv[j][1] & 0xffff0000u);
                float p0, p1, p2, p3, q0, q1, q2, q3;
                if (y8) { constexpr float is = 1.f / F8_SYO; const int w0 = (int)n0[j][0], w1 = (int)n1[j][0];
                    p0 = __builtin_amdgcn_cvt_f32_fp8(w0, 0) * is; p1 = __builtin_amdgcn_cvt_f32_fp8(w0, 1) * is; p2 = __builtin_amdgcn_cvt_f32_fp8(w0, 2) * is; p3 = __builtin_amdgcn_cvt_f32_fp8(w0, 3) * is;
                    q0 = __builtin_amdgcn_cvt_f32_fp8(w1, 0) * is; q1 = __builtin_amdgcn_cvt_f32_fp8(w1, 1) * is; q2 = __builtin_amdgcn_cvt_f32_fp8(w1, 2) * is; q3 = __builtin_amdgcn_cvt_f32_fp8(w1, 3) * is; }
                else { p0 = __uint_as_float(n0[j][0] << 16); p1 = __uint_as_float(n0[j][0] & 0xffff0000u); p2 = __uint_as_float(n0[j][1] << 16); p3 = __uint_as_float(n0[j][1] & 0xffff0000u);
                    q0 = __uint_as_float(n1[j][0] << 16); q1 = __uint_as_float(n1[j][0] & 0xffff0000u); q2 = __uint_as_float(n1[j][1] << 16); q3 = __uint_as_float(n1[j][1] & 0xffff0000u); }
                v[4 * j] = a0 + gt[4 * j] * (p0 + q0); v[4 * j + 1] = a1 + gt[4 * j + 1] * (p1 + q1); v[4 * j + 2] = a2 + gt[4 * j + 2] * (p2 + q2); v[4 * j + 3] = a3 + gt[4 * j + 3] * (p3 + q3); }
#pragma unroll
            for (int j = 0; j < 4; ++j) { nv[j] = __builtin_nontemporal_load((const u32x2*)(xmid + (size_t)nrow * D + j * 256 + lane * 4));
                if (y8) { n0[j][0] = __builtin_nontemporal_load((const unsigned*)(ys8 + (size_t)nrow * 2 * D + j * 256 + lane * 4)); n1[j][0] = __builtin_nontemporal_load((const unsigned*)(ys8 + (size_t)nrow * 2 * D + D + j * 256 + lane * 4)); }
                else { n0[j] = __builtin_nontemporal_load((const u32x2*)(ys + (size_t)nrow * 2 * D + j * 256 + lane * 4)); n1[j] = __builtin_nontemporal_load((const u32x2*)(ys + (size_t)nrow * 2 * D + D + j * 256 + lane * 4)); } }
            if (layer == 0) {
                row_store_bf16(WSP(bf16_t, WS_X2) + (size_t)row * D, lane, v);
                float s_ = 0.f;
#pragma unroll
                for (int i = 0; i < 16; ++i) s_ += v[i] * v[i];
                const float rstd = rsqrtf(wave_sum(s_) * (1.f / 1024.f) + EPS);
#pragma unroll
                for (int i = 0; i < 16; ++i) v[i] = v[i] * rstd * gm[i] + sh[i];
                if (RNN_FP8) {
#pragma unroll
                    for (int j = 0; j < 4; ++j) *(unsigned*)(WSP(unsigned char, WS_HB) + (size_t)row * D + j * 256 + lane * 4) = pk4_fp8_(v[4 * j] * F8_SH, v[4 * j + 1] * F8_SH, v[4 * j + 2] * F8_SH, v[4 * j + 3] * F8_SH); }
                else row_store_bf16(WSP(bf16_t, WS_HB) + (size_t)row * D, lane, v);
            } else {
#pragma unroll
                for (int j = 0; j < 4; ++j) { f32x4 o = {v[4 * j], v[4 * j + 1], v[4 * j + 2], v[4 * j + 3]}; __builtin_nontemporal_store(o, (f32x4*)(p.out + (size_t)row * D + j * 256 + lane * 4)); }
            }
        } }
}

struct FRin { const Params& p;
    __device__ __forceinline__ int nunits() const { return T / 8; }
    __device__ __forceinline__ void prep(int, int*) const {}
    __device__ __forceinline__ float a(int u, const int*, int r, int k) const { return bf2f(WSP(const bf16_t, WS_HB)[(size_t)(u * 8 + r) * D + k]); }
    __device__ __forceinline__ float b(int, const int*, int k, int n) const { return IN_F(15)[(size_t)k * 2048 + n]; }
    __device__ __forceinline__ void epi(int u, const int*, const float* Cs) const {
        bf16_t* gg = WSP(bf16_t, WS_GG); bf16_t* xb = WSP(bf16_t, WS_X1);
        for (int i = otid(); i < 8 * 2048; i += 512) { const int r = i >> 11, n = i & 2047, row = u * 8 + r;
            if (n < 1024) gg[(size_t)row * D + n] = f2bf(gelu_tanh(Cs[i])); else xb[(size_t)row * D + n - 1024] = f2bf(Cs[i]); }
    }
};
__device__ __forceinline__ void ph_conv(const Params& p) {
    const bf16_t* xb = WSP(const bf16_t, WS_X1); bf16_t* xc = WSP(bf16_t, WS_H2);
    const float* cw = IN_F(16); const float* cb = IN_F(17);
    for (int it = blockIdx.x * 512 + otid(); it < (T / 16) * 128; it += gridDim.x * 512) {
        const int cg = it & 127, rb = it >> 7, c0 = cg * 8, row0 = rb * 16, s0 = row0 & 2047;
        float w[4][8], bias[8];
#pragma unroll
        for (int k = 0; k < 4; ++k) { const f32x4 a = *(const f32x4*)(cw + k * D + c0), b2 = *(const f32x4*)(cw + k * D + c0 + 4);
#pragma unroll
            for (int j = 0; j < 4; ++j) { w[k][j] = a[j]; w[k][4 + j] = b2[j]; } }
        { const f32x4 a = *(const f32x4*)(cb + c0), b2 = *(const f32x4*)(cb + c0 + 4);
#pragma unroll
          for (int j = 0; j < 4; ++j) { bias[j] = a[j]; bias[4 + j] = b2[j]; } }
        u32x4 win[19];
#pragma unroll
        for (int r = 0; r < 19; ++r) { const int ss = s0 + r - 2; win[r] = (ss >= 0 && ss < SQ) ? *(const u32x4*)(xb + (size_t)(row0 + r - 2) * D + c0) : (u32x4){0u, 0u, 0u, 0u}; }
#pragma unroll
        for (int r = 0; r < 16; ++r) { float a[8];
#pragma unroll
            for (int j = 0; j < 8; ++j) a[j] = bias[j];
#pragma unroll
            for (int k = 0; k < 4; ++k)
#pragma unroll
                for (int q = 0; q < 4; ++q) { const unsigned x = win[r + k][q]; a[2 * q] += __uint_as_float(x << 16) * w[k][2 * q]; a[2 * q + 1] += __uint_as_float(x & 0xffff0000u) * w[k][2 * q + 1]; }
            u32x4 o; o[0] = pk2(a[0], a[1]); o[1] = pk2(a[2], a[3]); o[2] = pk2(a[4], a[5]); o[3] = pk2(a[6], a[7]);
            *(u32x4*)(xc + (size_t)(row0 + r) * D + c0) = o; }
    }
}
struct FGate { const Params& p;
    __device__ __forceinline__ int nunits() const { return (T / 8) * 4; }
    __device__ __forceinline__ void prep(int, int*) const {}
    __device__ __forceinline__ float a(int u, const int*, int r, int k) const { const int n = u & 3, rg = u >> 2; return bf2f(WSP(const bf16_t, WS_H2)[(size_t)(rg * 8 + r) * D + n * 256 + k]); }
    __device__ __forceinline__ float b(int u, const int*, int k, int j) const { const int n = u & 3, gate = j >> 8, e = j & 255;
        const float* W = gate == 0 ? IN_F(19) : gate == 1 ? IN_F(21) : gate == 2 ? IN_F(24) : IN_F(26);
        return W[((size_t)n * 256 + k) * 256 + e]; }
    __device__ __forceinline__ void epi(int u, const int*, const float* Cs) const {
        const int n = u & 3, rg = u >> 2;
        float* af = WSP(float, WS_AF); bf16_t* bxf = WSP(bf16_t, WS_BXF); float* ab = WSP(float, WS_AB); bf16_t* bxb = WSP(bf16_t, WS_BXB);
        const bf16_t* xc = WSP(const bf16_t, WS_H2);
        for (int i = otid(); i < 8 * 256; i += 512) { const int r = i >> 8, e = i & 255, row = rg * 8 + r, c = n * 256 + e, s = row & 2047;
            const float x = bf2f(xc[(size_t)row * D + c]);
            const float rf = sigmoidf_(Cs[r * 1024 + e] + IN_F(20)[c]), jf = sigmoidf_(Cs[r * 1024 + 256 + e] + IN_F(22)[c]);
            const float rb = sigmoidf_(Cs[r * 1024 + 512 + e] + IN_F(25)[c]), jb = sigmoidf_(Cs[r * 1024 + 768 + e] + IN_F(27)[c]);
            const float laf = -8.f * rf * log1pf(expf(-IN_F(18)[c])), lab = -8.f * rb * log1pf(expf(-IN_F(23)[c]));
            const float mf = (s == 0) ? 1.f : sqrtf(-expm1f(2.f * laf)), mb = (s == SQ - 1) ? 1.f : sqrtf(-expm1f(2.f * lab));
            const size_t o = (size_t)row * D + c;
            af[o] = expf(laf); bxf[o] = f2bf(mf * jf * x); ab[o] = expf(lab); bxb[o] = f2bf(mb * jb * x); }
    }
};
__device__ __forceinline__ void ph_scan(const Params& p) {
    float* af = WSP(float, WS_AF); const bf16_t* bxf = WSP(const bf16_t, WS_BXF); const float* ab = WSP(const float, WS_AB); const bf16_t* bxb = WSP(const bf16_t, WS_BXB);
    bf16_t* gy = WSP(bf16_t, WS_GG);
    const int wave = otid() >> 6, lane = otid() & 63;
    if (wave == 0)
    for (int u = blockIdx.x; u < 256; u += gridDim.x) { const int b = u >> 4, c = (u & 15) * 64 + lane;
        const size_t base = (size_t)b * SQ * D + c; float h = 0.f;
#pragma unroll 8
        for (int t = 0; t < SQ; ++t) { const size_t o = base + (size_t)t * D; h = af[o] * h + bf2f(bxf[o]); af[o] = h; }
        h = 0.f;
#pragma unroll 8
        for (int t = SQ - 1; t >= 0; --t) { const size_t o = base + (size_t)t * D; h = ab[o] * h + bf2f(bxb[o]); gy[o] = f2bf(bf2f(gy[o]) * (af[o] + h)); }
    }
}

#define LAS __attribute__((address_space(3)))
typedef short bf16x8 __attribute__((ext_vector_type(8)));
namespace g8 {
constexpr int BM = 256, BK = 64, HALF = 128, HTB = HALF * BK * 2, STAGE_BYTES = 8 * HTB;
__host__ __device__ __forceinline__ int lds_byte(int r, int c) { const int st = (r >> 4) * 2 + (c >> 5), rr = r & 15, cc = c & 31, ob = rr * 64 + cc * 2; return st * 1024 + (ob ^ (((ob >> 9) & 1) << 5)); }
__host__ __device__ __forceinline__ void stage_rc(int b, int& R, int& C) { const int st = b / 1024, sb = b % 1024, swz = sb ^ (((sb >> 9) & 1) << 5); R = (st >> 1) * 16 + swz / 64; C = (st & 1) * 32 + (swz % 64) / 2; }
__host__ __device__ __forceinline__ int perm32(int rho) { const int n = rho >> 4, i = rho & 15; return 8 * (i >> 2) + 4 * n + (i & 3); }

struct Unit { const char* a; const char* b; const int* rows; int nvalid; int pm, pn, e, row0; };

__device__ __forceinline__ unsigned cvt_pk_bf16(float lo, float hi) { unsigned r; asm volatile("v_cvt_pk_bf16_f32 %0, %1, %2" : "=v"(r) : "v"(lo), "v"(hi)); return r; }

template <class Epi, class Sched, bool GATHER, bool FP8 = false>
__device__ __forceinline__ void gemm_phase(LAS unsigned char* lds, const int KB, const int ldaB, const Sched& S, const Epi& E) {
    int tid_ = otid();
    const int tid = tid_, wid = __builtin_amdgcn_readfirstlane(tid >> 6), lane = tid & 63, wr = wid >> 2, wc = wid & 3, fr = lane & 15, fq = lane >> 4;
    const int nt = KB / 128;
    int Rr[2], Cc[2]; unsigned voffB[2];
#pragma unroll
    for (int i = 0; i < 2; ++i) { int R, C; stage_rc(tid * 16 + i * 8192, R, C); const int Rb = (R & ~31) + perm32(R & 31); Rr[i] = R; Cc[i] = C; voffB[i] = (unsigned)(Rb * KB + C * 2); }
    const size_t kstep = (size_t)(BK * 2);
    const size_t hstep = (size_t)HALF * KB;
    const unsigned ldsw = (unsigned)wid * 1024u;
    const int aoff = lds_byte(wr * 64 + fr, fq * 8), boff = lds_byte(wc * 32 + fr, fq * 8);
#define G8_SA(b, h) (((b) * 2 + (h)) * HTB)
#define G8_SB(b, h) ((4 + (b) * 2 + (h)) * HTB)
#define G8_STAGE(bufoff, gbase, voff) do { _Pragma("unroll") for (int _i = 0; _i < 2; ++_i) \
        __builtin_amdgcn_global_load_lds((const unsigned*)((const char*)(gbase) + (voff)[_i]), (LAS unsigned*)(lds + (bufoff) + ldsw + _i * 8192), 16, 0, 0); } while (0)
#define G8_LD8(addr) __builtin_shufflevector(*(const LAS v4i_*)(addr), *(const LAS v4i_*)((addr) + 1024), 0, 1, 2, 3, 4, 5, 6, 7)
#define G8_LDA(dst, b, h) do { _Pragma("unroll") for (int m = 0; m < 4; ++m) dst[m] = G8_LD8(lds + G8_SA(b, h) + aoff + m * 2048); } while (0)
#define G8_LDB(dst, b, h) do { _Pragma("unroll") for (int n = 0; n < 2; ++n) dst[n] = G8_LD8(lds + G8_SB(b, h) + boff + n * 2048); } while (0)
#define G8_H0(x) __builtin_bit_cast(bf16x8, __builtin_shufflevector(x, x, 0, 1, 2, 3))
#define G8_H1(x) __builtin_bit_cast(bf16x8, __builtin_shufflevector(x, x, 4, 5, 6, 7))
#define G8_MMA(ai, bj, At, Bt) do { __builtin_amdgcn_s_setprio(1); _Pragma("unroll") for (int m = 0; m < 4; ++m) _Pragma("unroll") for (int n = 0; n < 2; ++n) { \
        if constexpr (FP8) acc[ai][bj][m][n] = __builtin_amdgcn_mfma_scale_f32_16x16x128_f8f6f4(Bt[n], At[m], acc[ai][bj][m][n], 0, 0, 0, 127, 0, 127); \
        else { acc[ai][bj][m][n] = __builtin_amdgcn_mfma_f32_16x16x32_bf16(G8_H0(Bt[n]), G8_H0(At[m]), acc[ai][bj][m][n], 0, 0, 0); \
               acc[ai][bj][m][n] = __builtin_amdgcn_mfma_f32_16x16x32_bf16(G8_H1(Bt[n]), G8_H1(At[m]), acc[ai][bj][m][n], 0, 0, 0); } } \
        __builtin_amdgcn_s_setprio(0); } while (0)
#define G8_WAIT_V(n) asm volatile("s_waitcnt vmcnt(" #n ")" ::: "memory")
#define G8_WAIT_L(n) asm volatile("s_waitcnt lgkmcnt(" #n ")" ::: "memory")
#define G8_BAR __builtin_amdgcn_s_barrier()
#define G8_SCHED __builtin_amdgcn_sched_barrier(0)
#define G8_AOFF(dst, u) do { _Pragma("unroll") for (int h = 0; h < 2; ++h) _Pragma("unroll") for (int i = 0; i < 2; ++i) { const int rl = h * HALF + Rr[i]; \
        if constexpr (GATHER) { const int rr = (rl < (u).nvalid) ? (u).rows[rl] : (u).rows[0]; dst[h][i] = (unsigned)(rr * ldaB + Cc[i] * 2); } \
        else dst[h][i] = (unsigned)(rl * ldaB + Cc[i] * 2); } } while (0)
    Unit cur, nxt; int ui = 0;
    if (!S.next(0, cur)) return;
    f32x4 acc[2][2][4][2];
#pragma unroll
    for (int a = 0; a < 2; ++a)
#pragma unroll
        for (int b = 0; b < 2; ++b)
#pragma unroll
            for (int m = 0; m < 4; ++m)
#pragma unroll
                for (int n = 0; n < 2; ++n) acc[a][b][m][n] = (f32x4){0.f, 0.f, 0.f, 0.f};
    typedef int v8i_ __attribute__((ext_vector_type(8))); typedef int v4i_ __attribute__((ext_vector_type(4)));
    v8i_ At[4], B0[2], B1[2];
    unsigned vA[2][2];
    LAS int* xr = (LAS int*)(lds + 131072 + 2048 + wid * 256);
    G8_AOFF(vA, cur);
    const char* cA = cur.a; const char* cB = cur.b;
    G8_STAGE(G8_SB(0, 0), cB, voffB); G8_STAGE(G8_SB(0, 1), cB + hstep, voffB); G8_STAGE(G8_SA(0, 0), cA, vA[0]); G8_STAGE(G8_SA(0, 1), cA, vA[1]);
    if (wr == 1) G8_BAR;
    G8_WAIT_V(2); G8_BAR;
    G8_STAGE(G8_SB(1, 0), cB + kstep, voffB); G8_STAGE(G8_SA(1, 0), cA + kstep, vA[0]); G8_STAGE(G8_SB(1, 1), cB + hstep + kstep, voffB);
    G8_WAIT_V(6); G8_BAR;
    for (;;) {
        const bool has_next = S.next(ui + 1, nxt);
        const char* nA = has_next ? nxt.a : cA; const char* nB = has_next ? nxt.b : cB;
#pragma unroll 1
        for (int t = 0; t < nt; t += 2) {
            const bool last = (t == nt - 2);
            const char* a1 = cA + (size_t)(t + 1) * kstep;
            const char* a2 = last ? nA : cA + (size_t)(t + 2) * kstep; const char* b2 = last ? nB : cB + (size_t)(t + 2) * kstep;
            const char* a3 = a2 + kstep; const char* b3 = b2 + kstep;
            G8_LDB(B0, 0, 0); G8_LDB(B1, 0, 1); G8_SCHED; G8_LDA(At, 0, 0); G8_STAGE(G8_SA(1, 1), a1, vA[1]);
            if constexpr (GATHER) {
                if (t == 0 && has_next) { const int hi_ = lane >> 4, h_ = hi_ >> 1, i_ = hi_ & 1; int rl = h_ * HALF + ((wid + 8 * i_) >> 1) * 16 + (lane & 15); rl = rl < nxt.nvalid ? rl : 0;
                    __builtin_amdgcn_global_load_lds((const unsigned*)(nxt.rows + rl), (LAS unsigned*)xr, 4, 0, 0); }
            }
            G8_WAIT_V(8); G8_WAIT_L(0); G8_BAR; G8_MMA(0, 0, At, B0); G8_MMA(0, 1, At, B1); G8_BAR; G8_SCHED;
            if constexpr (!GATHER && FP8) {
                if (last && has_next) { const int t2_ = otid();
#pragma unroll
                    for (int i = 0; i < 2; ++i) { int R_, C_; stage_rc(t2_ * 16 + i * 8192, R_, C_); const int Rb_ = (R_ & ~31) + perm32(R_ & 31);
                        vA[0][i] = (unsigned)(R_ * ldaB + C_ * 2); vA[1][i] = (unsigned)((HALF + R_) * ldaB + C_ * 2); voffB[i] = (unsigned)(Rb_ * KB + C_ * 2); } }
            }
            if constexpr (GATHER) {
                if (last && has_next) {
#pragma unroll
                    for (int h = 0; h < 2; ++h)
#pragma unroll
                        for (int i = 0; i < 2; ++i) vA[h][i] = (unsigned)(xr[(h * 2 + i) * 16 + (lane >> 2)] * ldaB + Cc[i] * 2); }
            }
            G8_LDA(At, 0, 1); G8_STAGE(G8_SB(0, 0), b2, voffB); G8_STAGE(G8_SB(0, 1), b2 + hstep, voffB); G8_STAGE(G8_SA(0, 0), a2, vA[0]);
            G8_WAIT_V(8); G8_WAIT_L(0); G8_BAR; G8_MMA(1, 0, At, B0); G8_MMA(1, 1, At, B1); G8_BAR; G8_SCHED;
            G8_LDB(B0, 1, 0); G8_LDB(B1, 1, 1); G8_SCHED; G8_LDA(At, 1, 0); G8_STAGE(G8_SA(0, 1), a2, vA[1]);
            G8_WAIT_V(8); G8_WAIT_L(0); G8_BAR; G8_MMA(0, 0, At, B0); G8_MMA(0, 1, At, B1); G8_BAR; G8_SCHED;
            G8_LDA(At, 1, 1); G8_STAGE(G8_SB(1, 0), b3, voffB); G8_STAGE(G8_SB(1, 1), b3 + hstep, voffB); G8_STAGE(G8_SA(1, 0), a3, vA[0]);
            G8_WAIT_V(8); G8_WAIT_L(0); G8_BAR; G8_MMA(1, 0, At, B0); G8_MMA(1, 1, At, B1); G8_BAR; G8_SCHED;
        }
        if (wr == 0) G8_BAR;
        E(acc, cur, wr, wc, fr, fq);
        if (!has_next) break;
#pragma unroll
        for (int a = 0; a < 2; ++a)
#pragma unroll
            for (int b = 0; b < 2; ++b)
#pragma unroll
                for (int m = 0; m < 4; ++m)
#pragma unroll
                    for (int n = 0; n < 2; ++n) acc[a][b][m][n] = (f32x4){0.f, 0.f, 0.f, 0.f};
        cur = nxt; cA = nA; cB = nB; ++ui;
        if (wr == 1) G8_BAR;
    }
    G8_WAIT_V(0);
    G8_BAR;
#undef G8_SA
#undef G8_SB
#undef G8_STAGE
#undef G8_LD8
#undef G8_H0
#undef G8_H1
#undef G8_LDA
#undef G8_LDB
#undef G8_MMA
#undef G8_AOFF
}

struct DenseSched { const char* A; const char* B; int nM, nN, nwg, G, c, lda, K;
    __device__ __forceinline__ void init(const void* A_, int lda_, const void* B_, int K_, int M, int N) { A = (const char*)A_; B = (const char*)B_; lda = lda_; K = K_; nM = M / 256; nN = N / 256; nwg = nM * nN; G = gridDim.x; c = blockIdx.x; }
    __device__ __forceinline__ bool next(int i, Unit& u) const {
        const long L = (long)i * G + c; if (L >= nwg) return false;
        int wgid = (int)L; { const int q = nwg / 8, r = nwg % 8, xcd = wgid % 8, off = wgid / 8; wgid = (xcd < r ? xcd * (q + 1) : r * (q + 1) + (xcd - r) * q) + off; }
        const int nig = 8 * nN, gid = wgid / nig, fm = gid * 8, gsz = (nM - fm) < 8 ? (nM - fm) : 8;
        u.pm = fm + ((wgid % nig) % gsz); u.pn = (wgid % nig) / gsz; u.e = 0; u.row0 = u.pm * 256; u.rows = nullptr; u.nvalid = 256;
        u.a = A + (size_t)u.pm * 256 * lda * 2; u.b = B + (size_t)u.pn * 256 * K * 2; return true; }
};
struct MoeSched { const LAS int* tab; const char* A; const char* B; const int* tok; int ldaB, KB  , G, vc; size_t bstride; bool gather;
    __device__ __forceinline__ bool next(int i, Unit& u) const {
        const int L = i * G + vc; const int ntile = tab[32]; if (L >= ntile * 4) return false;
        const int tl = L >> 2; u.pn = L & 3;
        const int e = __builtin_amdgcn_readfirstlane(tab[192 + tl]);
        const int t0 = __builtin_amdgcn_readfirstlane(tl - tab[e]), segr = __builtin_amdgcn_readfirstlane(tab[128 + e]), cn = __builtin_amdgcn_readfirstlane(tab[64 + e]);
        u.e = e; u.pm = t0; u.row0 = segr + t0 * 256; const int nv = cn - t0 * 256; u.nvalid = nv < 256 ? nv : 256;
        u.rows = tok + (size_t)e * T + t0 * 256;
        u.a = gather ? A : A + (size_t)u.row0 * ldaB; u.b = B + (size_t)e * bstride + (size_t)u.pn * 256 * KB; return true; }
};
__device__ __forceinline__ void moe_tables(const Params& p, int layer, LAS int* tab) {
    __syncthreads();
    if (otid() < 32) { const unsigned* cnt = WSP(const unsigned, WS_CTL) + CW_CNT + layer * 32; const int e = otid();
        const int c = (int)__hip_atomic_load(cnt + e, __ATOMIC_RELAXED, __HIP_MEMORY_SCOPE_AGENT), nt_ = (c + 255) >> 8; int incl = nt_;
#pragma unroll
        for (int o = 1; o < 32; o <<= 1) { const int v = __shfl_up(incl, o, 32); if (e >= o) incl += v; }
        const int tp = incl - nt_; tab[e] = tp; tab[64 + e] = c; tab[128 + e] = tp << 8; if (e == 31) tab[32] = incl; }
    __syncthreads();
    { const int t = otid(); if (t < 320) { int e = 0;
#pragma unroll 1
        for (int q = 1; q < 32; ++q) e += (tab[q] <= t) ? 1 : 0;
        tab[192 + t] = e; } }
    __syncthreads();
}

__device__ __forceinline__ float frcp(float x) { return __builtin_amdgcn_rcpf(x); }
__device__ __forceinline__ float fsig(float x) { return frcp(1.f + __builtin_amdgcn_exp2f(-1.4426950408889634f * x)); }
__device__ __forceinline__ float fast_tanh(float x) { const float e = __builtin_amdgcn_exp2f(2.885390081777927f * x); return 1.f - 2.f * frcp(e + 1.f); }
__device__ __forceinline__ float gelu_fast(float x) { const float u = 0.7978845608028654f * (x + 0.044715f * x * x * x); return 0.5f * x * (1.f + fast_tanh(u)); }
template <bool RF32> struct EpiRes { const void* resid; const float* gate; bf16_t* out; float inv;
    __device__ __forceinline__ void operator()(const f32x4 (&acc)[2][2][4][2], const Unit& u, int wr, int wc, int fr, int fq) const {
        const int b = u.row0 >> 11; f32x4 gv[2][2];
#pragma unroll
        for (int bj = 0; bj < 2; ++bj)
#pragma unroll
            for (int n = 0; n < 2; ++n) gv[bj][n] = *(const f32x4*)(gate + (size_t)b * 6144 + u.pn * 256 + bj * 128 + wc * 32 + 8 * fq + 4 * n) * inv;
        const size_t o0 = ((size_t)u.row0 + wr * 64 + fr) * D + u.pn * 256 + wc * 32 + 8 * fq;
#pragma unroll
        for (int ai = 0; ai < 2; ++ai) {
            f32x4 r0[4][2], r1[4][2];
#pragma unroll
            for (int m = 0; m < 4; ++m)
#pragma unroll
                for (int bj = 0; bj < 2; ++bj) { const size_t o = o0 + (size_t)(ai * 128 + m * 16) * D + bj * 128;
                    if constexpr (RF32) { r0[m][bj] = __builtin_nontemporal_load((const f32x4*)((const float*)resid + o)); r1[m][bj] = __builtin_nontemporal_load((const f32x4*)((const float*)resid + o + 4)); }
                    else { const u32x4 x = *(const u32x4*)((const bf16_t*)resid + o);
                        r0[m][bj] = (f32x4){__uint_as_float(x[0] << 16), __uint_as_float(x[0] & 0xffff0000u), __uint_as_float(x[1] << 16), __uint_as_float(x[1] & 0xffff0000u)};
                        r1[m][bj] = (f32x4){__uint_as_float(x[2] << 16), __uint_as_float(x[2] & 0xffff0000u), __uint_as_float(x[3] << 16), __uint_as_float(x[3] & 0xffff0000u)}; } }
#pragma unroll
            for (int m = 0; m < 4; ++m)
#pragma unroll
                for (int bj = 0; bj < 2; ++bj) { const size_t o = o0 + (size_t)(ai * 128 + m * 16) * D + bj * 128;
                    const f32x4 v0 = r0[m][bj] + gv[bj][0] * acc[ai][bj][m][0], v1 = r1[m][bj] + gv[bj][1] * acc[ai][bj][m][1];
                    u32x4 w; w[0] = cvt_pk_bf16(v0[0], v0[1]); w[1] = cvt_pk_bf16(v0[2], v0[3]); w[2] = cvt_pk_bf16(v1[0], v1[1]); w[3] = cvt_pk_bf16(v1[2], v1[3]);
                    *(u32x4*)(out + o) = w; }
            asm volatile("" ::: "memory"); }
    }
};
struct EpiRin { bf16_t* gg; bf16_t* xb; float inv;
    __device__ __forceinline__ void operator()(const f32x4 (&acc)[2][2][4][2], const Unit& u, int wr, int wc, int fr, int fq) const {
        const bool isg = u.pn < 4; bf16_t* dst = isg ? gg : xb; const int cbase = (u.pn & 3) * 256;
#pragma unroll
        for (int ai = 0; ai < 2; ++ai)
#pragma unroll
            for (int m = 0; m < 4; ++m) { const size_t row = (size_t)u.row0 + ai * 128 + wr * 64 + m * 16 + fr;
#pragma unroll
                for (int bj = 0; bj < 2; ++bj) { f32x4 v0 = acc[ai][bj][m][0] * inv, v1 = acc[ai][bj][m][1] * inv;
                    if (isg) {
#pragma unroll
                        for (int j = 0; j < 4; ++j) { v0[j] = gelu_fast(v0[j]); v1[j] = gelu_fast(v1[j]); } }
                    u32x4 w; w[0] = cvt_pk_bf16(v0[0], v0[1]); w[1] = cvt_pk_bf16(v0[2], v0[3]); w[2] = cvt_pk_bf16(v1[0], v1[1]); w[3] = cvt_pk_bf16(v1[2], v1[3]);
                    *(u32x4*)(dst + row * D + cbase + bj * 128 + wc * 32 + 8 * fq) = w; }
                asm volatile("" ::: "memory"); }
    }
};
struct EpiGu { bf16_t* act; float inv;
    __device__ __forceinline__ void operator()(const f32x4 (&acc)[2][2][4][2], const Unit& u, int wr, int wc, int fr, int fq) const {
#pragma unroll
        for (int ai = 0; ai < 2; ++ai)
#pragma unroll
            for (int m = 0; m < 4; ++m) { const size_t row = (size_t)u.row0 + ai * 128 + wr * 64 + m * 16 + fr; float v[8];
#pragma unroll
                for (int n = 0; n < 2; ++n)
#pragma unroll
                    for (int j = 0; j < 4; ++j) { const float g = acc[ai][0][m][n][j] * inv, uu = acc[ai][1][m][n][j] * inv; v[4 * n + j] = g * uu * fsig(g); }
                u32x4 w; w[0] = cvt_pk_bf16(v[0], v[1]); w[1] = cvt_pk_bf16(v[2], v[3]); w[2] = cvt_pk_bf16(v[4], v[5]); w[3] = cvt_pk_bf16(v[6], v[7]);
                *(u32x4*)(act + row * DE + u.pn * 128 + wc * 32 + 8 * fq) = w;
                asm volatile("" ::: "memory"); }
    }
};
struct EpiDnLite { const int* dst; const float* wso; bf16_t* ys; float oscale;
    __device__ __forceinline__ void operator()(const f32x4 (&acc)[2][2][4][2], const Unit& u, int wr, int wc, int fr, int fq) const {
        const int* dp = dst + (size_t)u.e * T + u.pm * 256; const float* wp = wso + (size_t)u.e * T + u.pm * 256;
        const int cofs = u.pn * 256 + wc * 32 + 8 * fq;
#pragma unroll
        for (int ai = 0; ai < 2; ++ai)
#pragma unroll
            for (int m = 0; m < 4; ++m) { const int rl = ai * 128 + wr * 64 + m * 16 + fr;
                if (rl < u.nvalid) { const int d = dp[rl]; const float w = wp[rl] * oscale; bf16_t* orow = ys + (size_t)d * D + cofs;
#pragma unroll
                    for (int bj = 0; bj < 2; ++bj) { const f32x4 v0 = acc[ai][bj][m][0] * w, v1 = acc[ai][bj][m][1] * w;
                        u32x4 x; x[0] = cvt_pk_bf16(v0[0], v0[1]); x[1] = cvt_pk_bf16(v0[2], v0[3]); x[2] = cvt_pk_bf16(v1[0], v1[1]); x[3] = cvt_pk_bf16(v1[2], v1[3]);
                        *(u32x4*)(orow + bj * 128) = x; } }
                asm volatile("" ::: "memory"); }
    }
};
struct EpiDnLite8 { const int* dst; const float* wso; unsigned char* ys; float oscale;
    __device__ __forceinline__ void operator()(const f32x4 (&acc)[2][2][4][2], const Unit& u, int wr, int wc, int fr, int fq) const;
};
__device__ __forceinline__ unsigned pk4_fp8(float a, float b, float c, float d) {
    a = fminf(fmaxf(a, -448.f), 448.f); b = fminf(fmaxf(b, -448.f), 448.f); c = fminf(fmaxf(c, -448.f), 448.f); d = fminf(fmaxf(d, -448.f), 448.f);
    int r = 0; r = __builtin_amdgcn_cvt_pk_fp8_f32(a, b, r, false); r = __builtin_amdgcn_cvt_pk_fp8_f32(c, d, r, true); return (unsigned)r; }
__device__ __forceinline__ void EpiDnLite8::operator()(const f32x4 (&acc)[2][2][4][2], const Unit& u, int wr, int wc, int fr, int fq) const {
    const int* dp = dst + (size_t)u.e * T + u.pm * 256; const float* wp = wso + (size_t)u.e * T + u.pm * 256;
    const int cofs = u.pn * 256 + wc * 32 + 8 * fq;
#pragma unroll
    for (int ai = 0; ai < 2; ++ai)
#pragma unroll
        for (int m = 0; m < 4; ++m) { const int rl = ai * 128 + wr * 64 + m * 16 + fr;
            if (rl < u.nvalid) { const int d = dp[rl]; const float w = wp[rl] * oscale; unsigned char* orow = ys + (size_t)d * D + cofs;
#pragma unroll
                for (int bj = 0; bj < 2; ++bj) { const f32x4 v0 = acc[ai][bj][m][0] * w, v1 = acc[ai][bj][m][1] * w;
                    u32x2 x; x[0] = pk4_fp8(v0[0], v0[1], v0[2], v0[3]); x[1] = pk4_fp8(v1[0], v1[1], v1[2], v1[3]);
                    *(u32x2*)(orow + bj * 128) = x; } }
            asm volatile("" ::: "memory"); }
}

struct EpiGu8 { unsigned char* act;
    __device__ __forceinline__ void operator()(const f32x4 (&acc)[2][2][4][2], const Unit& u, int wr, int wc, int fr, int fq) const {
        constexpr float inv = 1.f / (F8_SH * F8_SW);
#pragma unroll
        for (int ai = 0; ai < 2; ++ai)
#pragma unroll
            for (int m = 0; m < 4; ++m) { const size_t row = (size_t)u.row0 + ai * 128 + wr * 64 + m * 16 + fr; float v[8];
#pragma unroll
                for (int n = 0; n < 2; ++n)
#pragma unroll
                    for (int j = 0; j < 4; ++j) { const float g = acc[ai][0][m][n][j] * inv, uu = acc[ai][1][m][n][j] * inv; v[4 * n + j] = g * uu * fsig(g) * F8_SA; }
                u32x2 w; w[0] = pk4_fp8(v[0], v[1], v[2], v[3]); w[1] = pk4_fp8(v[4], v[5], v[6], v[7]);
                *(u32x2*)(act + row * DE + u.pn * 128 + wc * 32 + 8 * fq) = w;
                asm volatile("" ::: "memory"); }
    }
};
struct EpiDn { const int* dst; const float* wso; bf16_t* ys; float oscale;
    __device__ __forceinline__ void operator()(const f32x4 (&acc)[2][2][4][2], const Unit& u, int wr, int wc, int fr, int fq) const {
        const int* dp = dst + (size_t)u.e * T + u.pm * 256; const float* wp = wso + (size_t)u.e * T + u.pm * 256;
        const int cofs = u.pn * 256 + wc * 32 + 8 * fq;
        int dd[8]; float ww[8];
#pragma unroll
        for (int g = 0; g < 8; ++g) { const int rl = (g >> 2) * 128 + wr * 64 + (g & 3) * 16 + fr; const bool ok = rl < u.nvalid; dd[g] = ok ? dp[rl] : -1; ww[g] = ok ? wp[rl] * oscale : 0.f; }
#pragma unroll
        for (int g = 0; g < 8; ++g) { const int ai = g >> 2, m = g & 3;
            if (dd[g] >= 0) { bf16_t* orow = ys + (size_t)dd[g] * D + cofs; const float w = ww[g];
#pragma unroll
                for (int bj = 0; bj < 2; ++bj) { const f32x4 v0 = acc[ai][bj][m][0] * w, v1 = acc[ai][bj][m][1] * w;
                    u32x4 x; x[0] = cvt_pk_bf16(v0[0], v0[1]); x[1] = cvt_pk_bf16(v0[2], v0[3]); x[2] = cvt_pk_bf16(v1[0], v1[1]); x[3] = cvt_pk_bf16(v1[2], v1[3]);
                    *(u32x4*)(orow + bj * 128) = x; } } }
    }
};
__device__ __forceinline__ float quad_sum(float v) { v += __shfl_xor(v, 16); v += __shfl_xor(v, 32); return v; }
struct EpiLat { bf16_t* lat; float* ssqp; float* ropek; float* pessq; const float* cs; const float* sn; const float* knorm;
    __device__ __forceinline__ void operator()(const f32x4 (&acc)[2][2][4][2], const Unit& u, int wr, int wc, int fr, int fq) const {
        f32x4 cq[8], sq_[8];
        const bool pe_wave = (u.pn == 2 && wc == 0);
        if (pe_wave) {
#pragma unroll
            for (int g = 0; g < 8; ++g) { const size_t row = (size_t)u.row0 + (g >> 2) * 128 + wr * 64 + (g & 3) * 16 + fr; cq[g] = *(const f32x4*)(cs + row * 16 + 4 * fq); sq_[g] = *(const f32x4*)(sn + row * 16 + 4 * fq); } }
#pragma unroll
        for (int ai = 0; ai < 2; ++ai)
#pragma unroll
            for (int m = 0; m < 4; ++m) { const size_t row = (size_t)u.row0 + ai * 128 + wr * 64 + m * 16 + fr;
#pragma unroll
                for (int bj = 0; bj < 2; ++bj) { const f32x4 v0 = acc[ai][bj][m][0], v1 = acc[ai][bj][m][1]; const int col = u.pn * 256 + bj * 128 + wc * 32 + 8 * fq;
                    u32x4 w; w[0] = cvt_pk_bf16(v0[0], v0[1]); w[1] = cvt_pk_bf16(v0[2], v0[3]); w[2] = cvt_pk_bf16(v1[0], v1[1]); w[3] = cvt_pk_bf16(v1[2], v1[3]);
                    *(u32x4*)(lat + row * LATP + col) = w;
                    const int sl = u.pn * 2 + bj;
                    if (sl < 5) { float ss = 0.f;
#pragma unroll
                        for (int j = 0; j < 4; ++j) ss += v0[j] * v0[j] + v1[j] * v1[j];
                        ss = quad_sum(ss); if (fq == 0) ssqp[(size_t)(sl * 4 + wc) * T + row] = ss; }
                    else if (wc == 0) {
                        float ss = 0.f; f32x4 o1, o2; const f32x4 c4 = cq[ai * 4 + m], s4 = sq_[ai * 4 + m];
                        const f32x4 g1 = *(const f32x4*)(knorm + 64 + 4 * fq), g2 = *(const f32x4*)(knorm + 80 + 4 * fq);
#pragma unroll
                        for (int j = 0; j < 4; ++j) { ss += v0[j] * v0[j] + v1[j] * v1[j]; const float x1 = v0[j] * g1[j], x2 = v1[j] * g2[j]; o1[j] = x1 * c4[j] - x2 * s4[j]; o2[j] = x1 * s4[j] + x2 * c4[j]; }
                        ss = quad_sum(ss); if (fq == 0) pessq[row] = ss;
                        *(f32x4*)(ropek + row * 32 + 4 * fq) = o1; *(f32x4*)(ropek + row * 32 + 16 + 4 * fq) = o2; } }
                asm volatile("" ::: "memory"); }
    }
};
struct MlaXchg { LAS float* part; LAS float* rr; LAS float* pe; };
__device__ __forceinline__ MlaXchg mla_xchg(LAS unsigned char* lds) { MlaXchg x; x.part = (LAS float*)(lds + 131072 + 4096); x.rr = x.part + 2048; x.pe = x.rr + 256; return x; }
struct EpiQ { LAS unsigned char* lds; const float* ssqp; const float* qnorm; const float* cs; const float* sn; bf16_t* q;
    __device__ __forceinline__ void operator()(const f32x4 (&acc)[2][2][4][2], const Unit& u, int wr, int wc, int fr, int fq) const {
        const MlaXchg X = mla_xchg(lds); const int tid = otid();
        int lb = wr * 64 + fr; asm volatile("" : "+v"(lb));
        if (tid < 256) { float ss = 0.f;
#pragma unroll
            for (int sl = 0; sl < 12; ++sl) ss += ssqp[(size_t)sl * T + u.row0 + tid];
            X.rr[tid] = rsqrtf(ss * (1.f / QL) + EPS); }
        { LAS float* pw = X.part + wc * 512 + lb;
#pragma unroll
        for (int ai = 0; ai < 2; ++ai)
#pragma unroll
            for (int m = 0; m < 4; ++m)
#pragma unroll
                for (int bj = 0; bj < 2; ++bj) { const f32x4 v0 = acc[ai][bj][m][0], v1 = acc[ai][bj][m][1]; float ss = 0.f;
#pragma unroll
                    for (int j = 0; j < 4; ++j) ss += v0[j] * v0[j] + v1[j] * v1[j];
                    ss = quad_sum(ss); if (fq == 0) pw[bj * 256 + ai * 128 + m * 16] = ss; } }
        asm volatile("s_waitcnt lgkmcnt(0)" ::: "memory"); __builtin_amdgcn_s_barrier();
        if (wc == 3) return;
        const int b = u.row0 >> 11; const LAS float* pr = X.part + lb; const LAS float* prr = X.rr + lb;
#pragma unroll
        for (int ai = 0; ai < 2; ++ai) {
        f32x4 cq[4], sq_[4];
        if (wc == 2) {
#pragma unroll
            for (int g = 0; g < 4; ++g) { const size_t row = (size_t)u.row0 + ai * 128 + g * 16 + lb; cq[g] = *(const f32x4*)(cs + row * 16 + 4 * fq); sq_[g] = *(const f32x4*)(sn + row * 16 + 4 * fq); } }
#pragma unroll
            for (int m = 0; m < 4; ++m) { const int rl = ai * 128 + m * 16 + lb; const int row = u.row0 + rl, sq = row & 2047; const float r = prr[ai * 128 + m * 16];
#pragma unroll
                for (int bj = 0; bj < 2; ++bj) { const float tot = pr[(0 * 2 + bj) * 256 + ai * 128 + m * 16] + pr[(1 * 2 + bj) * 256 + ai * 128 + m * 16] + pr[(2 * 2 + bj) * 256 + ai * 128 + m * 16];
                    const float sc = r * rsqrtf(r * r * tot * (1.f / 96.f) + EPS) * QSCALE; const int h = u.pn * 2 + bj;
                    bf16_t* qp = q + ((size_t)(b * NH + h) * SQ + sq) * 96; const f32x4 v0 = acc[ai][bj][m][0], v1 = acc[ai][bj][m][1];
                    if (wc < 2) { const int d0 = wc * 32 + 8 * fq; const f32x4 g0 = *(const f32x4*)(qnorm + d0), g1 = *(const f32x4*)(qnorm + d0 + 4);
                        u32x4 w; w[0] = cvt_pk_bf16(v0[0] * sc * g0[0], v0[1] * sc * g0[1]); w[1] = cvt_pk_bf16(v0[2] * sc * g0[2], v0[3] * sc * g0[3]);
                        w[2] = cvt_pk_bf16(v1[0] * sc * g1[0], v1[1] * sc * g1[1]); w[3] = cvt_pk_bf16(v1[2] * sc * g1[2], v1[3] * sc * g1[3]);
                        *(u32x4*)(qp + d0) = w; }
                    else { const f32x4 c4 = cq[m], s4 = sq_[m];
                        const f32x4 g1 = *(const f32x4*)(qnorm + 64 + 4 * fq), g2 = *(const f32x4*)(qnorm + 80 + 4 * fq); float o1[4], o2[4];
#pragma unroll
                        for (int j = 0; j < 4; ++j) { const float x1 = v0[j] * sc * g1[j], x2 = v1[j] * sc * g2[j]; o1[j] = x1 * c4[j] - x2 * s4[j]; o2[j] = x1 * s4[j] + x2 * c4[j]; }
                        u32x2 w1, w2; w1[0] = cvt_pk_bf16(o1[0], o1[1]); w1[1] = cvt_pk_bf16(o1[2], o1[3]); w2[0] = cvt_pk_bf16(o2[0], o2[1]); w2[1] = cvt_pk_bf16(o2[2], o2[3]);
                        *(u32x2*)(qp + 64 + 4 * fq) = w1; *(u32x2*)(qp + 80 + 4 * fq) = w2; } }
                asm volatile("" ::: "memory"); } }
    }
};
struct EpiKV { LAS unsigned char* lds; const float* ssqp; const float* pessq; const float* ropek; const float* knorm; bf16_t* k; bf16_t* v;
    __device__ __forceinline__ void operator()(const f32x4 (&acc)[2][2][4][2], const Unit& u, int wr, int wc, int fr, int fq) const {
        const MlaXchg X = mla_xchg(lds); const int tid = otid();
        int lb = wr * 64 + fr; asm volatile("" : "+v"(lb));
        if (tid < 256) { float ss = 0.f;
#pragma unroll
            for (int sl = 12; sl < 20; ++sl) ss += ssqp[(size_t)sl * T + u.row0 + tid];
            X.rr[tid] = rsqrtf(ss * (1.f / KVL) + EPS); X.pe[tid] = pessq[u.row0 + tid]; }
        if (wc < 2) { LAS float* pw = X.part + wc * 512 + lb;
#pragma unroll
            for (int ai = 0; ai < 2; ++ai)
#pragma unroll
                for (int m = 0; m < 4; ++m)
#pragma unroll
                    for (int bj = 0; bj < 2; ++bj) { const f32x4 v0 = acc[ai][bj][m][0], v1 = acc[ai][bj][m][1]; float ss = 0.f;
#pragma unroll
                        for (int j = 0; j < 4; ++j) ss += v0[j] * v0[j] + v1[j] * v1[j];
                        ss = quad_sum(ss); if (fq == 0) pw[bj * 256 + ai * 128 + m * 16] = ss; } }
        asm volatile("s_waitcnt lgkmcnt(0)" ::: "memory"); __builtin_amdgcn_s_barrier();
        const int b = u.row0 >> 11; const LAS float* pr = X.part + lb; const LAS float* prr = X.rr + lb; const LAS float* ppe = X.pe + lb;
        f32x4 rks[8];
        if (wc >= 2) {
#pragma unroll
            for (int g = 0; g < 8; ++g) rks[g] = *(const f32x4*)(ropek + (size_t)(u.row0 + (g >> 2) * 128 + (g & 3) * 16 + lb) * 32 + (wc - 2) * 16 + 4 * fq); }
#pragma unroll
        for (int ai = 0; ai < 2; ++ai)
#pragma unroll
            for (int m = 0; m < 4; ++m) { const int rl = ai * 128 + m * 16 + lb; const int row = u.row0 + rl, sq = row & 2047; const float r = prr[ai * 128 + m * 16], pes = ppe[ai * 128 + m * 16];
#pragma unroll
                for (int bj = 0; bj < 2; ++bj) { const float tot = pr[(0 * 2 + bj) * 256 + ai * 128 + m * 16] + pr[(1 * 2 + bj) * 256 + ai * 128 + m * 16];
                    const float rh = rsqrtf((r * r * tot + pes) * (1.f / 96.f) + EPS); const int h = u.pn * 2 + bj; const size_t hs = (size_t)(b * NH + h) * SQ + sq;
                    const f32x4 v0 = acc[ai][bj][m][0], v1 = acc[ai][bj][m][1];
                    if (wc < 2) { const int d0 = wc * 32 + 8 * fq; const float sc = r * rh; const f32x4 g0 = *(const f32x4*)(knorm + d0), g1 = *(const f32x4*)(knorm + d0 + 4);
                        u32x4 w; w[0] = cvt_pk_bf16(v0[0] * sc * g0[0], v0[1] * sc * g0[1]); w[1] = cvt_pk_bf16(v0[2] * sc * g0[2], v0[3] * sc * g0[3]);
                        w[2] = cvt_pk_bf16(v1[0] * sc * g1[0], v1[1] * sc * g1[1]); w[3] = cvt_pk_bf16(v1[2] * sc * g1[2], v1[3] * sc * g1[3]);
                        *(u32x4*)(k + kidx(b * NH + h, sq, d0)) = w; }
                    else { const int d0 = (wc - 2) * 32 + 8 * fq;
                        u32x4 w; w[0] = cvt_pk_bf16(v0[0] * r, v0[1] * r); w[1] = cvt_pk_bf16(v0[2] * r, v0[3] * r); w[2] = cvt_pk_bf16(v1[0] * r, v1[1] * r); w[3] = cvt_pk_bf16(v1[2] * r, v1[3] * r);
                        *(u32x4*)(v + vidx(b * NH + h, sq, d0)) = w;
                        const int e0 = (wc - 2) * 16 + 4 * fq; const f32x4 rk = rks[ai * 4 + m];
                        u32x2 w2; w2[0] = cvt_pk_bf16(rk[0] * rh, rk[1] * rh); w2[1] = cvt_pk_bf16(rk[2] * rh, rk[3] * rh);
                        *(u32x2*)(k + kidx(b * NH + h, sq, 64 + e0)) = w2; } }
                asm volatile("" ::: "memory"); }
    }
};
struct GateSched { const char* A; const char* B; int G, c;
    __device__ __forceinline__ bool next(int i, Unit& u) const {
        const int L = i * G + c; if (L >= 2048) return false;
        const int nb = L >> 9, r = L & 511; u.pm = r >> 2; u.pn = r & 3; u.e = nb; u.row0 = u.pm * 256; u.rows = nullptr; u.nvalid = 256;
        u.a = A + ((size_t)u.pm * 256 * 1024 + nb * 256) * 2; u.b = B + ((size_t)nb * 1024 + u.pn * 256) * 256 * 2; return true; }
};
struct EpiGate { const bf16_t* xc; const float* brf; const float* bif; const float* brb; const float* bib; const float* spl; unsigned* sf; unsigned* sb;
    __device__ __forceinline__ void operator()(const f32x4 (&acc)[2][2][4][2], const Unit& u, int wr, int wc, int fr, int fq) const {
        int lb = wr * 64 + fr; asm volatile("" : "+v"(lb));
        const int c0 = u.e * 256 + u.pn * 64 + wc * 16 + 4 * fq;
        const f32x4 b0 = *(const f32x4*)(brf + c0) * -1.4426950408889634f, b1 = *(const f32x4*)(bif + c0) * -1.4426950408889634f, b2 = *(const f32x4*)(brb + c0) * -1.4426950408889634f, b3 = *(const f32x4*)(bib + c0) * -1.4426950408889634f;
        const f32x4 pf = *(const f32x4*)(spl + c0), pb = *(const f32x4*)(spl + 1024 + c0);
        u32x2 xws[8];
#pragma unroll
        for (int g = 0; g < 8; ++g) xws[g] = *(const u32x2*)(xc + (size_t)(u.row0 + (g >> 2) * 128 + (g & 3) * 16 + lb) * D + c0);
#pragma unroll
        for (int ai = 0; ai < 2; ++ai)
#pragma unroll
            for (int m = 0; m < 4; ++m) { const int row = u.row0 + ai * 128 + m * 16 + lb, sq = row & 2047; const size_t o = (size_t)row * D + c0;
                const u32x2 xw = xws[ai * 4 + m]; const float x[4] = {__uint_as_float(xw[0] << 16), __uint_as_float(xw[0] & 0xffff0000u), __uint_as_float(xw[1] << 16), __uint_as_float(xw[1] & 0xffff0000u)};
                u32x4 wf, wb;
#pragma unroll
                for (int j = 0; j < 4; ++j) {
                    const float rf = frcp(1.f + __builtin_amdgcn_exp2f(acc[ai][0][m][0][j] + b0[j])), jf = frcp(1.f + __builtin_amdgcn_exp2f(acc[ai][0][m][1][j] + b1[j]));
                    const float rb = frcp(1.f + __builtin_amdgcn_exp2f(acc[ai][1][m][0][j] + b2[j])), jb = frcp(1.f + __builtin_amdgcn_exp2f(acc[ai][1][m][1][j] + b3[j]));
                    const float af = __builtin_amdgcn_exp2f(pf[j] * rf), ab = __builtin_amdgcn_exp2f(pb[j] * rb);
                    const float omf = 1.f - af, omb = 1.f - ab;
                    const float mf = (sq == 0) ? 1.f : __builtin_amdgcn_sqrtf(omf * (1.f + af)), mb = (sq == SQ - 1) ? 1.f : __builtin_amdgcn_sqrtf(omb * (1.f + ab));
                    wf[j] = cvt_pk_bf16(omf, mf * jf * x[j]); wb[j] = cvt_pk_bf16(omb, mb * jb * x[j]); }
                *(u32x4*)(sf + o) = wf; *(u32x4*)(sb + o) = wb;
                asm volatile("" ::: "memory"); }
    }
};
}

namespace att {
typedef float f32x16 __attribute__((ext_vector_type(16)));
typedef short s16x4 __attribute__((ext_vector_type(4)));
typedef short v4i16_t __attribute__((ext_vector_type(4)));
constexpr int NSLOT = 3, KSLOT = 12288, VSLOT = 8192, LDS_K = 0, LDS_V = NSLOT * KSLOT, LDS_WS = LDS_V + NSLOT * VSLOT, LDS_OST = LDS_WS + 8 * 256;
constexpr float THR = 8.f;
__device__ __forceinline__ int crow(int r, int hi) { return (r & 3) + 8 * (r >> 2) + 4 * hi; }
typedef float f32x2_t __attribute__((ext_vector_type(2))); typedef __bf16 bf16x2_t __attribute__((ext_vector_type(2)));
__device__ __forceinline__ unsigned cvtpk(float lo, float hi) { f32x2_t v = {lo, hi}; bf16x2_t b = __builtin_convertvector(v, bf16x2_t); return __builtin_bit_cast(unsigned, b); }
__device__ __forceinline__ s16x4 vtr(const LAS unsigned char* p) { return __builtin_bit_cast(s16x4, __builtin_amdgcn_ds_read_tr16_b64_v4i16((LAS v4i16_t*)p)); }

__device__ __forceinline__ float max3f(float a, float b, float c) { return __builtin_fmaxf(__builtin_fmaxf(a, b), c); }
__device__ __forceinline__ float rowmax32(const f32x16& p0, const f32x16& p1) {
    float a = max3f(p0[0], p0[1], p1[0]), b = max3f(p0[2], p0[3], p1[1]); a = max3f(a, p1[2], p1[3]);
#pragma unroll
    for (int r = 4; r < 16; r += 4) { a = max3f(a, p0[r], p0[r + 1]); b = max3f(b, p0[r + 2], p0[r + 3]); a = max3f(a, p1[r], p1[r + 1]); b = max3f(b, p1[r + 2], p1[r + 3]); }
    float m = fmaxf(a, b);
    auto rr = __builtin_amdgcn_permlane32_swap(__float_as_uint(m), __float_as_uint(m), false, false);
    return fmaxf(__uint_as_float(rr[0]), __uint_as_float(rr[1]));
}
__device__ __forceinline__ void attn_unit(int bh, int qb, const bf16_t* Q, const bf16_t* K, const bf16_t* V, bf16_t* O, LAS unsigned char* lds) {
    const int tid = otid(), lane = tid & 63, r32 = lane & 31, hi = lane >> 5; const int wid = __builtin_amdgcn_readfirstlane(tid >> 6);
    const bf16_t* Kh = K + (size_t)bh * SQ * 96; const bf16_t* Vh = V + (size_t)bh * SQ * 64;
    const bf16_t* Qw = Q + ((size_t)bh * SQ + qb * 256 + wid * 32) * 96;
    LAS float* wsf = (LAS float*)(lds + LDS_WS) + wid * 64;
    const bf16_t* ksrc0 = Kh + (size_t)lane * 96 + wid * 8;
    const bf16_t* ksrc1 = Kh + (size_t)lane * 96 + (wid + 8) * 8;
    const bf16_t* vsrc = Vh + (size_t)(16 * (wid & 3) + (lane >> 2)) * 64 + (wid >> 2) * 32 + (lane & 3) * 8;
#define ATT_DMA_K(t, slot) do { \
        __builtin_amdgcn_global_load_lds((const unsigned*)(ksrc0 + (size_t)(t) * 64 * 96), (LAS unsigned*)(lds + LDS_K + (slot) * KSLOT + wid * 1024), 16, 0, 0); \
        if (wid < 4) __builtin_amdgcn_global_load_lds((const unsigned*)(ksrc1 + (size_t)(t) * 64 * 96), (LAS unsigned*)(lds + LDS_K + (slot) * KSLOT + (wid + 8) * 1024), 16, 0, 0); } while (0)
#define ATT_DMA_V(t, slot) __builtin_amdgcn_global_load_lds((const unsigned*)(vsrc + (size_t)(t) * 64 * 64), (LAS unsigned*)(lds + LDS_V + (slot) * VSLOT + wid * 1024), 16, 0, 0)
    ATT_DMA_K(0, 0); ATT_DMA_V(0, 0); ATT_DMA_K(1, 1);
    bf16x8 qr[6];
#pragma unroll
    for (int d0 = 0; d0 < 6; ++d0) qr[d0] = *(const bf16x8*)(Qw + (size_t)r32 * 96 + d0 * 16 + hi * 8);
    f32x16 o[2], negm;
#pragma unroll
    for (int r = 0; r < 16; ++r) { o[0][r] = 0.f; o[1][r] = 0.f; negm[r] = 0.f; }
    float mhat = 0.f, l = 0.f;
    const int kfo = hi * 1024 + r32 * 16;
    const int vfo = ((lane >> 4) & 1) * 32 + (lane & 3) * 8 + (4 * hi + ((lane & 15) >> 2)) * 64;
    asm volatile("s_waitcnt vmcnt(0)" ::: "memory"); __builtin_amdgcn_s_barrier();
    constexpr int NT = SQ / 64;
    f32x16 pA0, pA1, pB0, pB1;
    bool resc = false;
#define ATT_QK(C0, C1, slot) do { const LAS unsigned char* kb_ = lds + LDS_K + (slot) * KSLOT + kfo; C0 = negm; C1 = negm; \
        _Pragma("unroll") for (int d0 = 0; d0 < 6; ++d0) { const bf16x8 b0_ = *(const LAS bf16x8*)(kb_ + d0 * 2048), b1_ = *(const LAS bf16x8*)(kb_ + d0 * 2048 + 512); \
            C0 = __builtin_amdgcn_mfma_f32_32x32x16_bf16(b0_, qr[d0], C0, 0, 0, 0); C1 = __builtin_amdgcn_mfma_f32_32x32x16_bf16(b1_, qr[d0], C1, 0, 0, 0); } } while (0)
#define ATT_DECIDE(C0, C1) do { const float rm_ = rowmax32(C0, C1); resc = false; \
        if (__builtin_expect(__any(rm_ > THR), 0)) { const float dl_ = fmaxf(rm_, 0.f); mhat += dl_; \
            _Pragma("unroll") for (int r = 0; r < 16; ++r) { C0[r] -= dl_; C1[r] -= dl_; negm[r] = -mhat; } \
            const float f_ = __builtin_amdgcn_exp2f(-dl_); l *= f_; if (hi == 0) wsf[r32] = f_; resc = true; } } while (0)
#define ATT_EXP(C0, C1) do { _Pragma("unroll") for (int r = 0; r < 16; ++r) { C0[r] = __builtin_amdgcn_exp2f(C0[r]); C1[r] = __builtin_amdgcn_exp2f(C1[r]); } } while (0)
#define ATT_PACK(P0, P1) do { float s_ = 0.f; _Pragma("unroll") for (int r = 0; r < 16; ++r) s_ += P0[r] + P1[r]; l += s_; \
        _Pragma("unroll") for (int i = 0; i < 4; ++i) { pw0[i] = cvtpk(P0[2 * i], P0[2 * i + 1]); pw1[i] = cvtpk(P0[8 + 2 * i], P0[8 + 2 * i + 1]); pw2[i] = cvtpk(P1[2 * i], P1[2 * i + 1]); pw3[i] = cvtpk(P1[8 + 2 * i], P1[8 + 2 * i + 1]); } } while (0)
#define ATT_VLOAD(slot) do { const LAS unsigned char* vb_ = lds + LDS_V + (slot) * VSLOT + vfo; \
        _Pragma("unroll") for (int i = 0; i < 8; ++i) { vlo[i] = vtr(vb_ + (i >> 2) * 4096 + (i & 3) * 1024); vhi[i] = vtr(vb_ + (i >> 2) * 4096 + (i & 3) * 1024 + 512); } } while (0)
#define ATT_VF(i) (bf16x8){vlo[i][0], vlo[i][1], vlo[i][2], vlo[i][3], vhi[i][0], vhi[i][1], vhi[i][2], vhi[i][3]}
#define ATT_PVEXP(C0, C1) do { \
        o[0] = __builtin_amdgcn_mfma_f32_32x32x16_bf16(__builtin_bit_cast(bf16x8, pw0), ATT_VF(0), o[0], 0, 0, 0); C0[0] = __builtin_amdgcn_exp2f(C0[0]); C0[1] = __builtin_amdgcn_exp2f(C0[1]); C0[2] = __builtin_amdgcn_exp2f(C0[2]); C0[3] = __builtin_amdgcn_exp2f(C0[3]); \
        o[1] = __builtin_amdgcn_mfma_f32_32x32x16_bf16(__builtin_bit_cast(bf16x8, pw0), ATT_VF(4), o[1], 0, 0, 0); C0[4] = __builtin_amdgcn_exp2f(C0[4]); C0[5] = __builtin_amdgcn_exp2f(C0[5]); C0[6] = __builtin_amdgcn_exp2f(C0[6]); C0[7] = __builtin_amdgcn_exp2f(C0[7]); \
        o[0] = __builtin_amdgcn_mfma_f32_32x32x16_bf16(__builtin_bit_cast(bf16x8, pw1), ATT_VF(1), o[0], 0, 0, 0); C0[8] = __builtin_amdgcn_exp2f(C0[8]); C0[9] = __builtin_amdgcn_exp2f(C0[9]); C0[10] = __builtin_amdgcn_exp2f(C0[10]); C0[11] = __builtin_amdgcn_exp2f(C0[11]); \
        o[1] = __builtin_amdgcn_mfma_f32_32x32x16_bf16(__builtin_bit_cast(bf16x8, pw1), ATT_VF(5), o[1], 0, 0, 0); C0[12] = __builtin_amdgcn_exp2f(C0[12]); C0[13] = __builtin_amdgcn_exp2f(C0[13]); C0[14] = __builtin_amdgcn_exp2f(C0[14]); C0[15] = __builtin_amdgcn_exp2f(C0[15]); \
        o[0] = __builtin_amdgcn_mfma_f32_32x32x16_bf16(__builtin_bit_cast(bf16x8, pw2), ATT_VF(2), o[0], 0, 0, 0); C1[0] = __builtin_amdgcn_exp2f(C1[0]); C1[1] = __builtin_amdgcn_exp2f(C1[1]); C1[2] = __builtin_amdgcn_exp2f(C1[2]); C1[3] = __builtin_amdgcn_exp2f(C1[3]); \
        o[1] = __builtin_amdgcn_mfma_f32_32x32x16_bf16(__builtin_bit_cast(bf16x8, pw2), ATT_VF(6), o[1], 0, 0, 0); C1[4] = __builtin_amdgcn_exp2f(C1[4]); C1[5] = __builtin_amdgcn_exp2f(C1[5]); C1[6] = __builtin_amdgcn_exp2f(C1[6]); C1[7] = __builtin_amdgcn_exp2f(C1[7]); \
        o[0] = __builtin_amdgcn_mfma_f32_32x32x16_bf16(__builtin_bit_cast(bf16x8, pw3), ATT_VF(3), o[0], 0, 0, 0); C1[8] = __builtin_amdgcn_exp2f(C1[8]); C1[9] = __builtin_amdgcn_exp2f(C1[9]); C1[10] = __builtin_amdgcn_exp2f(C1[10]); C1[11] = __builtin_amdgcn_exp2f(C1[11]); \
        o[1] = __builtin_amdgcn_mfma_f32_32x32x16_bf16(__builtin_bit_cast(bf16x8, pw3), ATT_VF(7), o[1], 0, 0, 0); C1[12] = __builtin_amdgcn_exp2f(C1[12]); C1[13] = __builtin_amdgcn_exp2f(C1[13]); C1[14] = __builtin_amdgcn_exp2f(C1[14]); C1[15] = __builtin_amdgcn_exp2f(C1[15]); \
        _Pragma("unroll") for (int g_ = 0; g_ < 8; ++g_) { __builtin_amdgcn_sched_group_barrier(0x8, 1, 0); __builtin_amdgcn_sched_group_barrier(0x2, 4, 0); } } while (0)
#define ATT_PV() do { \
        _Pragma("unroll") for (int i = 0; i < 8; ++i) { const int d0_ = i >> 2, ks_ = i & 3; const u32x4 pw_ = ks_ == 0 ? pw0 : ks_ == 1 ? pw1 : ks_ == 2 ? pw2 : pw3; \
            o[d0_] = __builtin_amdgcn_mfma_f32_32x32x16_bf16(__builtin_bit_cast(bf16x8, pw_), ATT_VF(i), o[d0_], 0, 0, 0); } } while (0)
#define ATT_RESC() do { if (resc) { asm volatile("s_waitcnt lgkmcnt(0)" ::: "memory"); \
        _Pragma("unroll") for (int r = 0; r < 16; ++r) { const float f_ = wsf[crow(r, hi)]; o[0][r] *= f_; o[1][r] *= f_; } } } while (0)
#define ATT_WAITBAR(full) do { if (full) asm volatile("s_waitcnt vmcnt(0) lgkmcnt(0)" ::: "memory"); \
        else if (wid < 4) asm volatile("s_waitcnt vmcnt(3) lgkmcnt(0)" ::: "memory"); else asm volatile("s_waitcnt vmcnt(2) lgkmcnt(0)" ::: "memory"); \
        __builtin_amdgcn_s_barrier(); } while (0)
#define ATT_STEP(C0, C1, P0, P1, t, ks, vs, kn) do { u32x4 pw0, pw1, pw2, pw3; s16x4 vlo[8], vhi[8]; \
        if ((t) + 2 < NT) ATT_DMA_K((t) + 2, vs); if ((t) + 1 < NT) ATT_DMA_V((t) + 1, kn); \
        ATT_QK(C0, C1, ks); ATT_VLOAD(vs); ATT_PACK(P0, P1); ATT_DECIDE(C0, C1); ATT_PVEXP(C0, C1); \
        ATT_WAITBAR((t) + 2 >= NT); ATT_RESC(); } while (0)
    ATT_DMA_K(2, 2); ATT_DMA_V(1, 1);
    ATT_QK(pA0, pA1, 0); ATT_DECIDE(pA0, pA1); ATT_EXP(pA0, pA1);
    ATT_WAITBAR(false);
    int ks = 1, vs = 0, kn = 2;
#pragma unroll 1
    for (int t = 1; t + 1 < NT; t += 2) {
        ATT_STEP(pB0, pB1, pA0, pA1, t, ks, vs, kn);
        vs = ks; ks = kn; kn = kn == 2 ? 0 : kn + 1;
        ATT_STEP(pA0, pA1, pB0, pB1, t + 1, ks, vs, kn);
        vs = ks; ks = kn; kn = kn == 2 ? 0 : kn + 1;
    }
    ATT_STEP(pB0, pB1, pA0, pA1, NT - 1, ks, vs, kn);
    { u32x4 pw0, pw1, pw2, pw3; s16x4 vlo[8], vhi[8]; ATT_VLOAD(ks); ATT_PACK(pB0, pB1); ATT_PV(); }
    { auto rr = __builtin_amdgcn_permlane32_swap(__float_as_uint(l), __float_as_uint(l), false, false); l = __uint_as_float(rr[0]) + __uint_as_float(rr[1]); }
    if (hi == 0) wsf[32 + r32] = l;
    asm volatile("s_waitcnt lgkmcnt(0)" ::: "memory");
    LAS bf16_t* stg = (LAS bf16_t*)(lds + LDS_OST) + wid * 2048;
#pragma unroll
    for (int r = 0; r < 16; ++r) { const int orow = crow(r, hi); const float rl = __builtin_amdgcn_rcpf(wsf[32 + orow]);
        stg[orow * 64 + r32] = f2bf(o[0][r] * rl); stg[orow * 64 + 32 + r32] = f2bf(o[1][r] * rl); }
    asm volatile("s_waitcnt lgkmcnt(0)" ::: "memory");
    const int b = bh >> 4, h = bh & 15;
    bf16_t* Ow = O + ((size_t)b * SQ + qb * 256 + wid * 32) * D + h * 64;
#pragma unroll
    for (int i = 0; i < 4; ++i) { const int row = i * 8 + (lane >> 3), ch = lane & 7; const u32x4 v = *(const LAS u32x4*)(stg + row * 64 + ch * 8); *(u32x4*)(Ow + (size_t)row * D + ch * 8) = v; }
    asm volatile("s_waitcnt lgkmcnt(0)" ::: "memory"); __builtin_amdgcn_s_barrier();
#undef ATT_DMA_K
#undef ATT_DMA_V
#undef ATT_QK
#undef ATT_DECIDE
#undef ATT_EXP
#undef ATT_PACK
#undef ATT_PV
#undef ATT_PVEXP
#undef ATT_VLOAD
#undef ATT_VF
#undef ATT_RESC
#undef ATT_WAITBAR
#undef ATT_STEP
}
#define SBAR() __builtin_amdgcn_sched_barrier(0)
#define PINV(x) asm volatile("" : "+v"(x))
struct QfArgs { const bf16_t* lat; const bf16_t* wqt; const float* ssqp; const float* qnorm; const float* cs; const float* sn; };
constexpr int LDS_WQ = LDS_OST;
__device__ __forceinline__ int rope_phys_a(int d) { return 8 * ((d >> 2) & 3) + 4 * (d >> 4) + (d & 3); }
template <bool QF>
__device__ __forceinline__ void attn_unit2(int bh, int qb, const bf16_t* Q, const bf16_t* K, const bf16_t* V, bf16_t* O, LAS unsigned char* lds, const float smax, const QfArgs& qa, bf16x8 (&lf)[24], const bf16_t* lat_next) {
    const int tid = otid(), lane = tid & 63, r32 = lane & 31, hi = lane >> 5; const int wid = __builtin_amdgcn_readfirstlane(tid >> 6);
    const bf16_t* Kh = K + (size_t)bh * SQ * 96; const bf16_t* Vh = V + (size_t)bh * SQ * 64;
    const bf16_t* Qw = Q + ((size_t)bh * SQ + qb * 256 + wid * 32) * 96;
    LAS float* wsf = (LAS float*)(lds + LDS_WS) + wid * 64;
    const bf16_t* ksrc0 = Kh + (size_t)wid * 512 + lane * 8;
    const bf16_t* ksrc1 = Kh + (size_t)(wid + 8) * 512 + lane * 8;
    const bf16_t* vsrc = Vh + (size_t)(wid >> 2) * 2048 + (16 * (wid & 3) + (lane >> 2)) * 32 + (lane & 3) * 8;
#define A2_GLDS(gsrc, ldsaddr) do { unsigned keep_; asm volatile("s_mov_b32 %0, m0\n\ts_mov_b32 m0, %2\n\ts_nop 0\n\tglobal_load_lds_dwordx4 %1, off\n\ts_mov_b32 m0, %0" : "=&s"(keep_) : "v"(gsrc), "s"((unsigned)__builtin_amdgcn_readfirstlane((int)(ldsaddr))) : "memory"); } while (0)
    const unsigned lds0 = (unsigned)(uintptr_t)lds;
#define A2_DMA_K(t, slot) do { \
        A2_GLDS(ksrc0 + (size_t)(t) * 64 * 96, lds0 + LDS_K + (slot) * KSLOT + wid * 1024); \
        if (wid < 4) A2_GLDS(ksrc1 + (size_t)(t) * 64 * 96, lds0 + LDS_K + (slot) * KSLOT + (wid + 8) * 1024); } while (0)
#define A2_DMA_V(t, slot) A2_GLDS(vsrc + (size_t)(t) * 64 * 64, lds0 + LDS_V + (slot) * VSLOT + wid * 1024)
#define A2_WAITBAR(NL, NH) do { if (wid < 4) asm volatile("s_waitcnt vmcnt(" #NL ") lgkmcnt(0)\n\ts_barrier" ::: "memory"); else asm volatile("s_waitcnt vmcnt(" #NH ") lgkmcnt(0)\n\ts_barrier" ::: "memory"); } while (0)
    bf16x8 qr[6];
    if constexpr (!QF) {
#pragma unroll
        for (int d0 = 0; d0 < 6; ++d0) qr[d0] = *(const bf16x8*)(Qw + (size_t)r32 * 96 + d0 * 16 + hi * 8);
        A2_DMA_K(0, 0); A2_DMA_V(0, 0); A2_DMA_K(1, 1); A2_DMA_K(2, 2);
    } else {
        const size_t trow = (size_t)(bh >> 4) * SQ + qb * 256 + wid * 32 + r32;
        float ssq_ = 0.f;
#pragma unroll
        for (int sl = 0; sl < 12; ++sl) ssq_ += qa.ssqp[(size_t)sl * T + trow];
        const f32x4 c0 = *(const f32x4*)(qa.cs + trow * 16 + 4 * hi), c1 = *(const f32x4*)(qa.cs + trow * 16 + 8 + 4 * hi);
        const f32x4 s0 = *(const f32x4*)(qa.sn + trow * 16 + 4 * hi), s1 = *(const f32x4*)(qa.sn + trow * 16 + 8 + 4 * hi);
        A2_DMA_K(0, 0); A2_DMA_V(0, 0); A2_DMA_K(1, 1); A2_DMA_K(2, 2);
        f32x16 dq[3];
#pragma unroll
        for (int r = 0; r < 16; ++r) { dq[0][r] = 0.f; dq[1][r] = 0.f; dq[2][r] = 0.f; }
        const LAS unsigned char* wq0 = lds + LDS_WQ + lane * 16;
        bf16x8 wa[3], wb[3];
#define A2_WQLD(W, ks) do { W[0] = *(const LAS bf16x8*)(wq0 + (ks) * 1024); W[1] = *(const LAS bf16x8*)(wq0 + 24576 + (ks) * 1024); W[2] = *(const LAS bf16x8*)(wq0 + 49152 + (ks) * 1024); } while (0)
#define A2_WQMM(W, ks) do { dq[0] = __builtin_amdgcn_mfma_f32_32x32x16_bf16(W[0], lf[ks], dq[0], 0, 0, 0); dq[1] = __builtin_amdgcn_mfma_f32_32x32x16_bf16(W[1], lf[ks], dq[1], 0, 0, 0); dq[2] = __builtin_amdgcn_mfma_f32_32x32x16_bf16(W[2], lf[ks], dq[2], 0, 0, 0); } while (0)
        A2_WQLD(wa, 0); SBAR();
#pragma unroll
        for (int ks = 0; ks < 24; ks += 2) {
            A2_WQLD(wb, ks + 1); SBAR(); A2_WQMM(wa, ks); SBAR();
            if (ks + 2 < 24) { A2_WQLD(wa, ks + 2); SBAR(); } A2_WQMM(wb, ks + 1); SBAR(); }
#undef A2_WQLD
#undef A2_WQMM
        const float rq = rsqrtf(ssq_ * (1.f / QL) + EPS);
        float tot = 0.f;
#pragma unroll
        for (int blk = 0; blk < 3; ++blk)
#pragma unroll
            for (int r = 0; r < 16; ++r) tot += dq[blk][r] * dq[blk][r];
        { auto rr = __builtin_amdgcn_permlane32_swap(__float_as_uint(tot), __float_as_uint(tot), false, false); tot = __uint_as_float(rr[0]) + __uint_as_float(rr[1]); }
        const float scq = rq * rsqrtf(rq * rq * tot * (1.f / 96.f) + EPS) * QSCALE;
#pragma unroll
        for (int blk = 0; blk < 3; ++blk)
#pragma unroll
            for (int k = 0; k < 4; ++k) { const f32x4 g = *(const LAS f32x4*)(lds + LDS_WQ + 73728 + (32 * blk + 8 * k + 4 * hi) * 4);
#pragma unroll
                for (int j = 0; j < 4; ++j) dq[blk][4 * k + j] *= scq * g[j]; }
#pragma unroll
        for (int r = 0; r < 8; ++r) { const float c = r < 4 ? c0[r & 3] : c1[r & 3], sv = r < 4 ? s0[r & 3] : s1[r & 3];
            const float x1 = dq[2][r], x2 = dq[2][r + 8]; dq[2][r] = x1 * c - x2 * sv; dq[2][r + 8] = x1 * sv + x2 * c; }
#pragma unroll
        for (int blk = 0; blk < 3; ++blk)
#pragma unroll
            for (int s2 = 0; s2 < 2; ++s2) {
                const unsigned a0 = cvtpk(dq[blk][8 * s2 + 0], dq[blk][8 * s2 + 1]), a1 = cvtpk(dq[blk][8 * s2 + 2], dq[blk][8 * s2 + 3]);
                const unsigned b0 = cvtpk(dq[blk][8 * s2 + 4], dq[blk][8 * s2 + 5]), b1 = cvtpk(dq[blk][8 * s2 + 6], dq[blk][8 * s2 + 7]);
                const unsigned x0 = hi ? a0 : b0, x1 = hi ? a1 : b1;
                const unsigned y0 = (unsigned)__shfl_xor((int)x0, 32), y1 = (unsigned)__shfl_xor((int)x1, 32);
                u32x4 w; w[0] = hi ? y0 : a0; w[1] = hi ? y1 : a1; w[2] = hi ? b0 : y0; w[3] = hi ? b1 : y1;
                qr[2 * blk + s2] = __builtin_bit_cast(bf16x8, w); }
    }
    f32x16 o[2], negm;
#pragma unroll
    for (int r = 0; r < 16; ++r) { o[0][r] = 0.f; o[1][r] = 0.f; negm[r] = -smax; }
    PINV(negm);
    float l_reg = 0.f;
    const LAS unsigned char* kp0 = lds + LDS_K + hi * 1024 + r32 * 16;
    const LAS unsigned char* vp0 = lds + LDS_V + ((lane >> 4) & 1) * 32 + (lane & 3) * 8 + (4 * hi + ((lane & 15) >> 2)) * 64;
    constexpr int NT = SQ / 64;
    bf16x8 kf[12];
#define A2_KLOAD2(slot, j) do { kf[2 * (j)] = *(const LAS bf16x8*)(kp0 + (slot) * KSLOT + (j) * 2048); kf[2 * (j) + 1] = *(const LAS bf16x8*)(kp0 + (slot) * KSLOT + (j) * 2048 + 512); } while (0)
    f32x16 pA0, pA1, pB0, pB1;
    A2_WAITBAR(5, 3);
#pragma unroll
    for (int j = 0; j < 6; ++j) A2_KLOAD2(0, j);
    pA0 = negm; pA1 = negm;
#pragma unroll
    for (int d0 = 0; d0 < 6; ++d0) { pA0 = __builtin_amdgcn_mfma_f32_32x32x16_bf16(kf[2 * d0], qr[d0], pA0, 0, 0, 0); pA1 = __builtin_amdgcn_mfma_f32_32x32x16_bf16(kf[2 * d0 + 1], qr[d0], pA1, 0, 0, 0); }
#pragma unroll
    for (int r = 0; r < 16; ++r) { pA0[r] = __builtin_amdgcn_exp2f(pA0[r]); if (r < 8) pA1[r] = __builtin_amdgcn_exp2f(pA1[r]); }
    A2_WAITBAR(0, 0);
    A2_DMA_K(3, 0); A2_DMA_V(1, 1);
    int sp = 0, sc = 1, sn = 2;
#pragma unroll
    for (int j = 0; j < 6; ++j) A2_KLOAD2(sc, j);
    A2_WAITBAR(3, 2);
#define A2_VRD(i) do { vlo[i] = vtr(vp_ + ((i) >> 2) * 4096 + ((i) & 3) * 1024); vhi[i] = vtr(vp_ + ((i) >> 2) * 4096 + ((i) & 3) * 1024 + 512); } while (0)
#define A2_VF(i) (bf16x8){vlo[i][0], vlo[i][1], vlo[i][2], vlo[i][3], vhi[i][0], vhi[i][1], vhi[i][2], vhi[i][3]}
#define A2_PAF(k) __builtin_bit_cast(bf16x8, pw##k)
#define A2_GAPA(MF, A0, A1, A2_, W0, W1) do { MF; sacc += A0; sacc += A1; sacc += A2_; PINV(sacc); W0; W1; SBAR(); } while (0)
#define A2_EX4(X, B) do { X[B] = __builtin_amdgcn_exp2f(X[B]); X[B + 1] = __builtin_amdgcn_exp2f(X[B + 1]); X[B + 2] = __builtin_amdgcn_exp2f(X[B + 2]); X[B + 3] = __builtin_amdgcn_exp2f(X[B + 3]); PINV(X); } while (0)
#define A2_EX3(a, b, c) do { a = __builtin_amdgcn_exp2f(a); b = __builtin_amdgcn_exp2f(b); c = __builtin_amdgcn_exp2f(c); } while (0)
#define A2_NOP do { } while (0)
#define A2_STEP(C0, C1, P0, P1, t) do { SBAR(); \
        const LAS unsigned char* vp_ = vp0 + sp * VSLOT; s16x4 vlo[8], vhi[8]; u32x4 pw0, pw1, pw2, pw3; \
        const bool gk_ = (t) + 3 < NT, gv_ = (t) + 1 < NT; \
        A2_VRD(0); SBAR(); float sacc = P0[0] + P0[1]; \
        P1[8] = __builtin_amdgcn_exp2f(P1[8]); P1[9] = __builtin_amdgcn_exp2f(P1[9]); PINV(P1); A2_GAPA(C0 = __builtin_amdgcn_mfma_f32_32x32x16_bf16(kf[0], qr[0], negm, 0, 0, 0), P0[2], P0[3], P0[4], pw0[0] = cvtpk(P0[0], P0[1]), pw0[1] = cvtpk(P0[2], P0[3])); \
        A2_VRD(4); SBAR(); P1[10] = __builtin_amdgcn_exp2f(P1[10]); P1[11] = __builtin_amdgcn_exp2f(P1[11]); PINV(P1); A2_GAPA(C1 = __builtin_amdgcn_mfma_f32_32x32x16_bf16(kf[1], qr[0], negm, 0, 0, 0), P0[5], P0[6], P0[7], pw0[2] = cvtpk(P0[4], P0[5]), pw0[3] = cvtpk(P0[6], P0[7])); \
        A2_VRD(1); SBAR(); P1[12] = __builtin_amdgcn_exp2f(P1[12]); P1[13] = __builtin_amdgcn_exp2f(P1[13]); PINV(P1); A2_GAPA(C0 = __builtin_amdgcn_mfma_f32_32x32x16_bf16(kf[2], qr[1], C0, 0, 0, 0), P0[8], P0[9], P0[10], pw1[0] = cvtpk(P0[8], P0[9]), pw1[1] = cvtpk(P0[10], P0[11])); \
        A2_VRD(5); SBAR(); P1[14] = __builtin_amdgcn_exp2f(P1[14]); P1[15] = __builtin_amdgcn_exp2f(P1[15]); PINV(P1); A2_GAPA(C1 = __builtin_amdgcn_mfma_f32_32x32x16_bf16(kf[3], qr[1], C1, 0, 0, 0), P0[11], P0[12], P0[13], pw1[2] = cvtpk(P0[12], P0[13]), pw1[3] = cvtpk(P0[14], P0[15])); \
        A2_VRD(2); SBAR(); A2_GAPA(C0 = __builtin_amdgcn_mfma_f32_32x32x16_bf16(kf[4], qr[2], C0, 0, 0, 0), P0[14], P0[15], P1[0], pw2[0] = cvtpk(P1[0], P1[1]), pw2[1] = cvtpk(P1[2], P1[3])); \
        A2_VRD(6); SBAR(); A2_GAPA(C1 = __builtin_amdgcn_mfma_f32_32x32x16_bf16(kf[5], qr[2], C1, 0, 0, 0), P1[1], P1[2], P1[3], pw2[2] = cvtpk(P1[4], P1[5]), pw2[3] = cvtpk(P1[6], P1[7])); \
        A2_VRD(3); SBAR(); A2_GAPA(C0 = __builtin_amdgcn_mfma_f32_32x32x16_bf16(kf[6], qr[3], C0, 0, 0, 0), P1[4], P1[5], P1[6], pw3[0] = cvtpk(P1[8], P1[9]), pw3[1] = cvtpk(P1[10], P1[11])); \
        A2_VRD(7); SBAR(); A2_GAPA(C1 = __builtin_amdgcn_mfma_f32_32x32x16_bf16(kf[7], qr[3], C1, 0, 0, 0), P1[7], P1[8], P1[9], pw3[2] = cvtpk(P1[12], P1[13]), pw3[3] = cvtpk(P1[14], P1[15])); \
        A2_GAPA(C0 = __builtin_amdgcn_mfma_f32_32x32x16_bf16(kf[8], qr[4], C0, 0, 0, 0), P1[10], P1[11], P1[12], A2_NOP, A2_NOP); \
        A2_GAPA(C1 = __builtin_amdgcn_mfma_f32_32x32x16_bf16(kf[9], qr[4], C1, 0, 0, 0), P1[13], P1[14], P1[15], A2_NOP, A2_NOP); \
        if (gk_) { A2_DMA_K((t) + 3, sc); } if (gv_) { A2_DMA_V((t) + 1, sn); } SBAR(); \
        C0 = __builtin_amdgcn_mfma_f32_32x32x16_bf16(kf[10], qr[5], C0, 0, 0, 0); C1 = __builtin_amdgcn_mfma_f32_32x32x16_bf16(kf[11], qr[5], C1, 0, 0, 0); SBAR(); \
        l_reg += sacc; SBAR(); \
        o[0] = __builtin_amdgcn_mfma_f32_32x32x16_bf16(A2_PAF(0), A2_VF(0), o[0], 0, 0, 0); A2_EX3(C0[0], C0[1], C0[2]); PINV(C0); SBAR(); \
        o[1] = __builtin_amdgcn_mfma_f32_32x32x16_bf16(A2_PAF(0), A2_VF(4), o[1], 0, 0, 0); A2_EX3(C0[3], C0[4], C0[5]); PINV(C0); SBAR(); \
        if (gv_) { A2_KLOAD2(sn, 0); SBAR(); } o[0] = __builtin_amdgcn_mfma_f32_32x32x16_bf16(A2_PAF(1), A2_VF(1), o[0], 0, 0, 0); A2_EX3(C0[6], C0[7], C0[8]); PINV(C0); SBAR(); \
        if (gv_) { A2_KLOAD2(sn, 1); SBAR(); } o[1] = __builtin_amdgcn_mfma_f32_32x32x16_bf16(A2_PAF(1), A2_VF(5), o[1], 0, 0, 0); A2_EX3(C0[9], C0[10], C0[11]); PINV(C0); SBAR(); \
        if (gv_) { A2_KLOAD2(sn, 2); SBAR(); } o[0] = __builtin_amdgcn_mfma_f32_32x32x16_bf16(A2_PAF(2), A2_VF(2), o[0], 0, 0, 0); A2_EX3(C0[12], C0[13], C0[14]); PINV(C0); SBAR(); \
        if (gv_) { A2_KLOAD2(sn, 3); SBAR(); } o[1] = __builtin_amdgcn_mfma_f32_32x32x16_bf16(A2_PAF(2), A2_VF(6), o[1], 0, 0, 0); A2_EX3(C0[15], C1[0], C1[1]); PINV(C0); PINV(C1); SBAR(); \
        if (gv_) { A2_KLOAD2(sn, 4); SBAR(); } o[0] = __builtin_amdgcn_mfma_f32_32x32x16_bf16(A2_PAF(3), A2_VF(3), o[0], 0, 0, 0); A2_EX3(C1[2], C1[3], C1[4]); PINV(C1); SBAR(); \
        if (gv_) { A2_KLOAD2(sn, 5); SBAR(); } o[1] = __builtin_amdgcn_mfma_f32_32x32x16_bf16(A2_PAF(3), A2_VF(7), o[1], 0, 0, 0); A2_EX3(C1[5], C1[6], C1[7]); PINV(C1); SBAR(); \
        if (gk_) A2_WAITBAR(3, 2); else A2_WAITBAR(0, 0); \
        { const int t_ = sp; sp = sc; sc = sn; sn = t_; } } while (0)
    if (wid < 4) __builtin_amdgcn_s_setprio(1);
#pragma unroll 1
    for (int t = 1; t + 1 < NT; t += 2) { A2_STEP(pB0, pB1, pA0, pA1, t); A2_STEP(pA0, pA1, pB0, pB1, t + 1); }
    __builtin_amdgcn_s_setprio(0);
    A2_STEP(pB0, pB1, pA0, pA1, NT - 1);
    if constexpr (QF) {
#pragma unroll
        for (int ks = 0; ks < 24; ++ks) lf[ks] = *(const bf16x8*)(lat_next + ks * 16); }
    { float sacc = 0.f;
#pragma unroll
      for (int r = 8; r < 16; ++r) pB1[r] = __builtin_amdgcn_exp2f(pB1[r]);
#pragma unroll
      for (int r = 0; r < 16; ++r) sacc += pB0[r] + pB1[r];
      l_reg += sacc;
      u32x4 pw0, pw1, pw2, pw3;
#pragma unroll
      for (int i = 0; i < 4; ++i) { pw0[i] = cvtpk(pB0[2 * i], pB0[2 * i + 1]); pw1[i] = cvtpk(pB0[8 + 2 * i], pB0[8 + 2 * i + 1]); pw2[i] = cvtpk(pB1[2 * i], pB1[2 * i + 1]); pw3[i] = cvtpk(pB1[8 + 2 * i], pB1[8 + 2 * i + 1]); }
      const LAS unsigned char* vp_ = vp0 + sp * VSLOT; s16x4 vlo[8], vhi[8];
#pragma unroll
      for (int i = 0; i < 8; ++i) A2_VRD(i);
#pragma unroll
      for (int i = 0; i < 8; ++i) { const int d0_ = i >> 2, ks_ = i & 3; const u32x4 pw_ = ks_ == 0 ? pw0 : ks_ == 1 ? pw1 : ks_ == 2 ? pw2 : pw3;
          o[d0_] = __builtin_amdgcn_mfma_f32_32x32x16_bf16(__builtin_bit_cast(bf16x8, pw_), A2_VF(i), o[d0_], 0, 0, 0); } }
    float l = l_reg;
    { auto rr = __builtin_amdgcn_permlane32_swap(__float_as_uint(l), __float_as_uint(l), false, false); l = __uint_as_float(rr[0]) + __uint_as_float(rr[1]); }
    if (hi == 0) wsf[32 + r32] = l;
    asm volatile("s_waitcnt lgkmcnt(0)" ::: "memory");
    LAS bf16_t* stg = (LAS bf16_t*)(lds + (QF ? LDS_K : LDS_OST)) + wid * 2048;
#pragma unroll
    for (int r = 0; r < 16; ++r) { const int orow = crow(r, hi); const float rl = __builtin_amdgcn_rcpf(wsf[32 + orow]);
        stg[orow * 64 + r32] = f2bf(o[0][r] * rl); stg[orow * 64 + 32 + r32] = f2bf(o[1][r] * rl); }
    asm volatile("s_waitcnt lgkmcnt(0)" ::: "memory");
    const int b = bh >> 4, h = bh & 15;
    bf16_t* Ow = O + ((size_t)b * SQ + qb * 256 + wid * 32) * D + h * 64;
#pragma unroll
    for (int i = 0; i < 4; ++i) { const int row = i * 8 + (lane >> 3), ch = lane & 7; const u32x4 v = *(const LAS u32x4*)(stg + row * 64 + ch * 8); *(u32x4*)(Ow + (size_t)row * D + ch * 8) = v; }
    if constexpr (QF) { asm volatile("s_waitcnt lgkmcnt(0)" ::: "memory"); __builtin_amdgcn_s_barrier(); }
    else { asm volatile("s_waitcnt vmcnt(0) lgkmcnt(0)" ::: "memory"); __builtin_amdgcn_s_barrier(); }
#undef A2_GLDS
#undef A2_DMA_K
#undef A2_DMA_V
#undef A2_WAITBAR
#undef A2_KLOAD2
#undef A2_VRD
#undef A2_VF
#undef A2_PAF
#undef A2_GAPA
#undef A2_EX4
#undef A2_EX3
#undef A2_NOP
#undef A2_STEP
}
__device__ __forceinline__ void attn_phase(const Params& p, LAS unsigned char* lds) {
    const int G = gridDim.x, c = blockIdx.x;
    const float smax = *WSP(const float, WS_SMAX);
    constexpr int NU = NB * NH * (SQ / 256);
    const QfArgs qa{WSP(const bf16_t, WS_LAT), WSP(const bf16_t, WS_WQT), WSP(const float, WS_SSQP), (const float*)p.in[12], WSP(const float, WS_COS), WSP(const float, WS_SIN)};
    bf16x8 lf[24];
    auto lrow_of = [&](int bh, int qb) -> const bf16_t* { const int tid = otid(), lane = tid & 63;
        return qa.lat + ((size_t)(bh >> 4) * SQ + qb * 256 + (tid >> 6) * 32 + (lane & 31)) * LATP + (lane >> 5) * 8; };
    int cur_h = -1;
    auto stage_wq = [&](int h_) {
        if (!QFUSE || h_ == cur_h) return; cur_h = h_;
        const int tid = otid(), lane = tid & 63, r32 = lane & 31, hi = lane >> 5; const int wid = __builtin_amdgcn_readfirstlane(tid >> 6);
#pragma unroll 1
        for (int i = 0; i < 9; ++i) { const int pc = wid + 8 * i, blk = pc / 24, cp = pc - blk * 24;
            const int wrow = h_ * 128 + (blk < 2 ? blk * 32 + r32 : 64 + rope_phys_a(r32));
            const bf16_t* gsrc = qa.wqt + (size_t)wrow * QL + (2 * cp + hi) * 8; unsigned keep_;
            asm volatile("s_mov_b32 %0, m0\n\ts_mov_b32 m0, %2\n\ts_nop 0\n\tglobal_load_lds_dwordx4 %1, off\n\ts_mov_b32 m0, %0" : "=&s"(keep_) : "v"(gsrc), "s"((unsigned)__builtin_amdgcn_readfirstlane((int)((unsigned)(uintptr_t)lds + LDS_WQ + pc * 1024))) : "memory"); }
        if (tid < 96) ((LAS float*)(lds + LDS_WQ + 73728))[tid] = qa.qnorm[tid];
        asm volatile("s_waitcnt vmcnt(0) lgkmcnt(0)" ::: "memory"); __builtin_amdgcn_s_barrier(); };
    if (G == 256) {
        const int x = c & 7, r = c >> 3, g = r >> 3;
        const int h_ = 2 * x + (g & 1), qb = r & 7;
        if constexpr (QFUSE) { const bf16_t* l0 = lrow_of((g >> 1) * 16 + h_, qb);
#pragma unroll
            for (int ks = 0; ks < 24; ++ks) lf[ks] = *(const bf16x8*)(l0 + ks * 16); }
        stage_wq(h_);
#pragma unroll 1
        for (int i = 0; i < 8; ++i) { const int b_ = 2 * i + (g >> 1), bh = b_ * 16 + h_;
            attn_unit2<QFUSE>(bh, qb, WSP(const bf16_t, WS_Q), WSP(const bf16_t, WS_K), WSP(const bf16_t, WS_V), WSP(bf16_t, WS_O), lds, smax, qa, lf, lrow_of(i + 1 < 8 ? bh + 32 : bh, qb)); }
    } else {
        if constexpr (QFUSE) { if (c < NU) { const bf16_t* l0 = lrow_of(c >> 3, c & 7);
#pragma unroll
            for (int ks = 0; ks < 24; ++ks) lf[ks] = *(const bf16x8*)(l0 + ks * 16); } }
#pragma unroll 1
        for (int L = c; L < NU; L += G) { stage_wq((L >> 3) & 15);
            attn_unit2<QFUSE>(L >> 3, L & 7, WSP(const bf16_t, WS_Q), WSP(const bf16_t, WS_K), WSP(const bf16_t, WS_V), WSP(bf16_t, WS_O), lds, smax, qa, lf, lrow_of((L + G < NU ? L + G : L) >> 3, (L + G < NU ? L + G : L) & 7)); }
    }
}
}

template <class RowMap>
__device__ __forceinline__ void xpose_item(const float* W, int ldw, const float* gain, bf16_t* Bt, int Kd, int k0, int n0, const RowMap& rm, LAS float* scr, int lane, const float wscale = 1.f) {
    float tv[32];
#pragma unroll
    for (int i = 0; i < 32; ++i) tv[i] = __builtin_nontemporal_load(W + (size_t)(k0 + 2 * i + (lane >> 5)) * ldw + n0 + (lane & 31));
    if (gain) {
#pragma unroll
        for (int i = 0; i < 32; ++i) tv[i] *= gain[k0 + 2 * i + (lane >> 5)]; }
#pragma unroll
    for (int i = 0; i < 32; ++i) scr[(2 * i + (lane >> 5)) * 33 + (lane & 31)] = tv[i] * wscale;
    asm volatile("s_waitcnt lgkmcnt(0)" ::: "memory");
    const int c = lane & 7;
#pragma unroll
    for (int j = 0; j < 4; ++j) { const int n = (lane >> 3) + 8 * j; const LAS float* sp = scr + (8 * c) * 33 + n;
        u32x4 o; o[0] = pk2(sp[0 * 33], sp[1 * 33]); o[1] = pk2(sp[2 * 33], sp[3 * 33]); o[2] = pk2(sp[4 * 33], sp[5 * 33]); o[3] = pk2(sp[6 * 33], sp[7 * 33]);
        *(u32x4*)(Bt + (size_t)rm(n0 + n) * Kd + k0 + 8 * c) = o; }
    asm volatile("s_waitcnt lgkmcnt(0)" ::: "memory");
}
template <class RowMap>
__device__ __forceinline__ void xpose_item8(const float* W, int ldw, float scale, unsigned char* Bt, int Kd, int k0, int n0, const RowMap& rm, LAS float* scr, int lane) {
    float tv[32];
#pragma unroll
    for (int i = 0; i < 32; ++i) tv[i] = __builtin_nontemporal_load(W + (size_t)(k0 + 2 * i + (lane >> 5)) * ldw + n0 + (lane & 31));
#pragma unroll
    for (int i = 0; i < 32; ++i) scr[(2 * i + (lane >> 5)) * 33 + (lane & 31)] = tv[i] * scale;
    asm volatile("s_waitcnt lgkmcnt(0)" ::: "memory");
    const int c = lane & 7;
#pragma unroll
    for (int j = 0; j < 4; ++j) { const int n = (lane >> 3) + 8 * j; const LAS float* sp = scr + (8 * c) * 33 + n;
        u32x2 o; o[0] = g8::pk4_fp8(sp[0 * 33], sp[1 * 33], sp[2 * 33], sp[3 * 33]); o[1] = g8::pk4_fp8(sp[4 * 33], sp[5 * 33], sp[6 * 33], sp[7 * 33]);
        *(u32x2*)(Bt + (size_t)rm(n0 + n) * Kd + k0 + 8 * c) = o; }
    asm volatile("s_waitcnt lgkmcnt(0)" ::: "memory");
}
struct RmId { __device__ __forceinline__ int operator()(int n) const { return n; } };
__device__ __forceinline__ int rope_phys(int d) { return 8 * ((d >> 2) & 3) + 4 * (d >> 4) + (d & 3); }
struct RmLat { __device__ __forceinline__ int operator()(int n) const { return n < 640 ? n : 640 + rope_phys(n - 640); } };
struct RmQ { __device__ __forceinline__ int operator()(int n) const { const int h = n / 96, d = n % 96; return h * 128 + (d < 64 ? d : 64 + rope_phys(d - 64)); } };
struct RmGate { int gate; __device__ __forceinline__ int operator()(int e) const { const int pn = e >> 6, ce = e & 63; return 256 * pn + 128 * (gate >> 1) + 32 * (ce >> 4) + 8 * ((ce >> 2) & 3) + 4 * (gate & 1) + (ce & 3); } };
struct RmGu { __device__ __forceinline__ int operator()(int n) const { const int a = n & 511; return 256 * (a >> 7) + 128 * (n >> 9) + (a & 127); } };

constexpr int CONV_IGU = 16 * 32, CONV_IDN = 8 * 32, CONV_NM = 64 * (CONV_IGU + CONV_IDN), CONV_LATE0 = 32 * CONV_IGU, CONV_LATE = 16 * CONV_IGU;
static_assert(!(MOE0_FP8 && MOE1_FP8) || DN1_FP8, "the late conversion ranges assume the all-e4m3 MoE path");
constexpr int CONV_LATEB = CONV_LATE0 + CONV_LATE, CONV_LATEBN = 8 * CONV_IGU, CONV_LATEC = CONV_LATEB + CONV_LATEBN, CONV_REST = CONV_LATEC + CONV_LATEBN;
__device__ __forceinline__ void conv_moe(const Params& p, LAS float* scr, int lane, int gw, int ngw, int r0, int nj) {
    constexpr int I_GU = CONV_IGU, I_DN = CONV_IDN;
    const bool paired = (nj % (2 * ngw)) == 0;
    auto item_of = [&](int j) -> int { int x = j; if (paired) { const int blk = j / (2 * ngw), w = j % ngw, h = (j / ngw) & 1; x = 2 * (blk * ngw + w) + h; }
        return r0 + x; };
    auto src_of = [&](int r) -> const float* {
        if (r < 64 * I_GU) { const int le = r / I_GU, q = r % I_GU; return IN_F(31) + (size_t)le * 1048576 + (size_t)((2 * (q / 64) + (q & 1)) * 64 + (lane >> 5)) * 1024 + ((q >> 1) & 31) * 32 + (lane & 31); }
        r -= 64 * I_GU; const int le = r / I_DN, q = r % I_DN; return IN_F(32) + (size_t)le * 524288 + (size_t)((2 * (q / 64) + (q & 1)) * 64 + (lane >> 5)) * 1024 + ((q >> 1) & 31) * 32 + (lane & 31); };
#define CV_LOAD(TV, j) do { const float* s_ = src_of(item_of(j)); _Pragma("unroll") for (int i = 0; i < 32; ++i) TV[i] = __builtin_nontemporal_load(s_ + (size_t)i * 2048); } while (0)
#define CV_PROC(TV, j) do { _Pragma("unroll") for (int i = 0; i < 32; ++i) scr[(2 * i + (lane >> 5)) * 33 + (lane & 31)] = TV[i] * F8_SW; \
        asm volatile("s_waitcnt lgkmcnt(0)" ::: "memory"); \
        const int r_ = item_of(j); const bool gu_ = r_ < 64 * I_GU; const int rr_ = gu_ ? r_ : r_ - 64 * I_GU, le_ = gu_ ? rr_ / I_GU : rr_ / I_DN, q_ = gu_ ? rr_ % I_GU : rr_ % I_DN, k0_ = (2 * (q_ / 64) + (q_ & 1)) * 64, n0_ = ((q_ >> 1) & 31) * 32, Kd_ = gu_ ? 1024 : 512; \
        unsigned char* Bt_ = gu_ ? WSP(unsigned char, WS_WGU8) + (size_t)(le_ >> 5) * 64 * MiB + (size_t)(le_ & 31) * 1048576 : WSP(unsigned char, WS_WDN8) + (size_t)(le_ >> 5) * 32 * MiB + (size_t)(le_ & 31) * 524288; \
        const int c_ = lane & 7; \
        _Pragma("unroll") for (int jj = 0; jj < 4; ++jj) { const int n_ = n0_ + (lane >> 3) + 8 * jj; const LAS float* sp = scr + (8 * c_) * 33 + (lane >> 3) + 8 * jj; \
            u32x2 o; o[0] = g8::pk4_fp8(sp[0 * 33], sp[1 * 33], sp[2 * 33], sp[3 * 33]); o[1] = g8::pk4_fp8(sp[4 * 33], sp[5 * 33], sp[6 * 33], sp[7 * 33]); \
            *(u32x2*)(Bt_ + (size_t)(gu_ ? RmGu{}(n_) : n_) * Kd_ + k0_ + 8 * c_) = o; } \
        asm volatile("s_waitcnt lgkmcnt(0)" ::: "memory"); } while (0)
    float ta[32], tb[32];
    int j = gw;
    if (j < nj) CV_LOAD(ta, j);
#pragma unroll 1
    while (j < nj) { const int j1 = j + ngw, j2 = j1 + ngw;
        if (j1 < nj) CV_LOAD(tb, j1);
        CV_PROC(ta, j);
        if (j2 < nj) CV_LOAD(ta, j2);
        if (j1 < nj) CV_PROC(tb, j1);
        j = j2; }
#undef CV_LOAD
#undef CV_PROC
}

__device__ __forceinline__ void conv_in_moe_tail(const Params& p, LAS unsigned char* ldsb, const LAS int* tab, int G, int vc, int r0, int n) {
    const int total = tab[32] * 4, rounds = (total + G - 1) / G, first_idle = total - (rounds - 1) * G, nidle = G - first_idle;
    __syncthreads();
    const int wave = otid() >> 6, lane = otid() & 63; LAS float* scr = (LAS float*)ldsb + wave * (64 * 33);
    if (nidle >= 32) { if (vc >= first_idle) conv_moe(p, scr, lane, (vc - first_idle) * 8 + wave, nidle * 8, r0, n); }
    else conv_moe(p, scr, lane, vc * 8 + wave, G * 8, r0, n);
}
__device__ __forceinline__ void ph_convert(const Params& p, LAS float* lds) {
    const int lane = otid() & 63, wave = otid() >> 6;
    LAS float* scr = lds + wave * (64 * 33);
    const int gw = blockIdx.x * 8 + wave, ngw = gridDim.x * 8;
    constexpr int I_W1 = 16 * 21, I_WQ = 6 * 48, I_WKV = 4 * 64, I_WO = 16 * 32, I_RIN = 16 * 64, I_G = 16 * 32, I_RO = 16 * 32, I_GU = 16 * 32, I_DN = 8 * 32;
    constexpr int NSMALL = I_W1 + I_WQ + I_WKV + I_WO + I_RIN + I_G + I_RO, NITEMS = NSMALL + 64 * (I_GU + I_DN);
    constexpr bool MOE_PIPE = MOE0_FP8 && MOE1_FP8;
    for (int it = gw; it < (MOE_PIPE ? NSMALL : NITEMS); it += ngw) { int r = it;
        if (r < I_W1) { xpose_item(IN_F(7), LATN, nullptr, WSP(bf16_t, WS_W1T), 1024, (r / 21) * 64, (r % 21) * 32, RmLat{}, scr, lane); continue; } r -= I_W1;
        if (r < I_WQ) { xpose_item(IN_F(10), 1536, IN_F(8), WSP(bf16_t, WS_WQT), QL, (r / 48) * 64, (r % 48) * 32, RmQ{}, scr, lane); continue; } r -= I_WQ;
        if (r < I_WKV) { xpose_item(IN_F(11), 2048, IN_F(9), WSP(bf16_t, WS_WKVT), KVL, (r / 64) * 64, (r % 64) * 32, RmId{}, scr, lane); continue; } r -= I_WKV;
        if (r < I_WO) { xpose_item(IN_F(14), 1024, nullptr, WSP(bf16_t, WS_WOT), 1024, (r / 32) * 64, (r % 32) * 32, RmId{}, scr, lane); continue; } r -= I_WO;
        if (r < I_RIN) { if (RNN_FP8) xpose_item8(IN_F(15), 2048, F8_SW, WSP(unsigned char, WS_WRINT), 1024, (r / 64) * 64, (r % 64) * 32, RmId{}, scr, lane);
            else xpose_item(IN_F(15), 2048, nullptr, WSP(bf16_t, WS_WRINT), 1024, (r / 64) * 64, (r % 64) * 32, RmId{}, scr, lane); continue; } r -= I_RIN;
        if (r < I_G) { const int nb = r >> 7, gate = (r >> 5) & 3, q = r & 31; const float* W = gate == 0 ? IN_F(19) : gate == 1 ? IN_F(21) : gate == 2 ? IN_F(24) : IN_F(26);
            xpose_item(W + (size_t)nb * 65536, 256, nullptr, WSP(bf16_t, WS_WGT) + (size_t)nb * 1024 * 256, 256, (q >> 3) * 64, (q & 7) * 32, RmGate{gate}, scr, lane, -1.4426950408889634f); continue; } r -= I_G;
        if (r < I_RO) { if (RNN_FP8) xpose_item8(IN_F(28), 1024, F8_SW, WSP(unsigned char, WS_WROT), 1024, (r / 32) * 64, (r % 32) * 32, RmId{}, scr, lane);
            else xpose_item(IN_F(28), 1024, nullptr, WSP(bf16_t, WS_WROT), 1024, (r / 32) * 64, (r % 32) * 32, RmId{}, scr, lane); continue; } r -= I_RO;
        if (r < 64 * I_GU) { const int le = r / I_GU, q = r % I_GU;
            if (le >= 32 ? MOE1_FP8 : MOE0_FP8) xpose_item8(IN_F(31) + (size_t)le * 1048576, 1024, F8_SW, WSP(unsigned char, WS_WGU8) + (size_t)(le >> 5) * 64 * MiB + (size_t)(le & 31) * 1048576, 1024, (q / 32) * 64, (q % 32) * 32, RmGu{}, scr, lane);
            else xpose_item(IN_F(31) + (size_t)le * 1048576, 1024, nullptr, WSP(bf16_t, WS_WGU) + (size_t)le * 1048576, 1024, (q / 32) * 64, (q % 32) * 32, RmGu{}, scr, lane);
            continue; } r -= 64 * I_GU;
        { const int le = r / I_DN, q = r % I_DN;
          if (le >= 32 ? MOE1_FP8 : MOE0_FP8) xpose_item8(IN_F(32) + (size_t)le * 524288, 1024, F8_SW, WSP(unsigned char, WS_WDN8) + (size_t)(le >> 5) * 32 * MiB + (size_t)(le & 31) * 524288, 512, (q / 32) * 64, (q % 32) * 32, RmId{}, scr, lane);
          else xpose_item(IN_F(32) + (size_t)le * 524288, 1024, nullptr, WSP(bf16_t, WS_WDN) + (size_t)le * 524288, 512, (q / 32) * 64, (q % 32) * 32, RmId{}, scr, lane); }
    }
    if constexpr (MOE_PIPE) { conv_moe(p, scr, lane, gw, ngw, 0, CONV_LATE0); conv_moe(p, scr, lane, gw, ngw, CONV_REST, CONV_NM - CONV_REST); }
    { u32x4 z = {0u, 0u, 0u, 0u}; const int gt = blockIdx.x * 512 + otid(), ngt = gridDim.x * 512;
      for (int i = gt; i < 96 * 1024 / 8; i += ngt) *(u32x4*)(WSP(bf16_t, WS_W1T) + (size_t)672 * 1024 + (size_t)i * 8) = z;
      for (int i = gt; i < 16 * 32 * QL / 8; i += ngt) { const int e = i * 8, hh = e / (32 * QL), rem = e % (32 * QL); *(u32x4*)(WSP(bf16_t, WS_WQT) + ((size_t)hh * 128 + 96) * QL + rem) = z; } }
}

__device__ __forceinline__ void ph_scan1(const Params& p) {
    const int lane = otid() & 63, gw = blockIdx.x * 8 + (otid() >> 6), ngw = gridDim.x * 8;
    const unsigned* sf = WSP(const unsigned, WS_SF); const unsigned* sb = WSP(const unsigned, WS_SB); float* sum = WSP(float, WS_SUM); float* gsum = sum + (size_t)2 * 1024 * 1024 * 2;
    for (int u = gw; u < 2 * 16 * 8 * 8; u += ngw) {
        const int dir = u >> 10, r = u & 1023, b = r >> 6, grp = (r >> 3) & 7, cg = r & 7, c = cg * 128 + lane * 2;
        float GA0 = 1.f, GA1 = 1.f, GH0 = 0.f, GH1 = 0.f;
        const unsigned* sdir = (dir ? sb : sf) + (size_t)b * SQ * D + c;
        u32x2 wa[16], wb2[16];
#define SC1_ROW(i) (dir ? (grp * 256 + 255 - (i)) : (grp * 256 + (i)))
#define SC1_SCAN(W) do { _Pragma("unroll") for (int t = 0; t < 16; ++t) { const u32x2 x = W[t]; \
            const float a0 = 1.f - __uint_as_float(x[0] << 16), x0 = __uint_as_float(x[0] & 0xffff0000u), a1 = 1.f - __uint_as_float(x[1] << 16), x1 = __uint_as_float(x[1] & 0xffff0000u); \
            H0 = a0 * H0 + x0; A0 *= a0; H1 = a1 * H1 + x1; A1 *= a1; } } while (0)
#pragma unroll
        for (int t = 0; t < 16; ++t) wa[t] = *(const u32x2*)(sdir + (size_t)SC1_ROW(t) * D);
#pragma unroll 1
        for (int k = 0; k < 8; ++k) {
            float A0 = 1.f, A1 = 1.f, H0 = 0.f, H1 = 0.f;
#pragma unroll
            for (int t = 0; t < 16; ++t) wb2[t] = *(const u32x2*)(sdir + (size_t)SC1_ROW(k * 32 + 16 + t) * D);
            SC1_SCAN(wa);
            if (k + 1 < 8) {
#pragma unroll
                for (int t = 0; t < 16; ++t) wa[t] = *(const u32x2*)(sdir + (size_t)SC1_ROW(k * 32 + 32 + t) * D); }
            SC1_SCAN(wb2);
            const int run = grp * 8 + (dir ? 7 - k : k);
            f32x4 o = {A0, H0, A1, H1};
            *(f32x4*)(sum + (((size_t)dir * 1024 + b * 64 + run) * 1024 + c) * 2) = o;
            GH0 = A0 * GH0 + H0; GA0 *= A0; GH1 = A1 * GH1 + H1; GA1 *= A1; }
#undef SC1_ROW
#undef SC1_SCAN
        f32x4 go = {GA0, GH0, GA1, GH1};
        *(f32x4*)(gsum + (((size_t)dir * 128 + b * 8 + grp) * 1024 + c) * 2) = go;
    }
}
__device__ __forceinline__ void ph_scan2(const Params& p) {
    const int lane = otid() & 63, gw = blockIdx.x * 8 + (otid() >> 6), ngw = gridDim.x * 8;
    const unsigned* sf = WSP(const unsigned, WS_SF); const unsigned* sb = WSP(const unsigned, WS_SB); const float* sum = WSP(const float, WS_SUM); const float* gsum = sum + (size_t)2 * 1024 * 1024 * 2;
    bf16_t* gy = WSP(bf16_t, WS_GG);
    for (int u = gw; u < 16 * 64 * 8; u += ngw) {
        const int b = u >> 9, run = (u >> 3) & 63, cg = u & 7, c = cg * 128 + lane * 2, grp = run >> 3, rin = run & 7;
        const size_t base = ((size_t)b * SQ + run * 32) * D + c;
        u32x2 wf[32];
#pragma unroll
        for (int t = 0; t < 32; ++t) wf[t] = __builtin_nontemporal_load((const u32x2*)(sf + base + (size_t)t * D));
        float hf0 = 0.f, hf1 = 0.f, hb0 = 0.f, hb1 = 0.f;
        { f32x4 gq[7], rq[7];
#pragma unroll
          for (int q = 0; q < 7; ++q) { gq[q] = *(const f32x4*)(gsum + (((size_t)b * 8 + q) * 1024 + c) * 2); rq[q] = *(const f32x4*)(sum + (((size_t)b * 64 + grp * 8 + q) * 1024 + c) * 2); }
#pragma unroll
          for (int q = 0; q < 7; ++q) if (q < grp) { hf0 = gq[q][0] * hf0 + gq[q][1]; hf1 = gq[q][2] * hf1 + gq[q][3]; }
#pragma unroll
          for (int q = 0; q < 7; ++q) if (q < rin) { hf0 = rq[q][0] * hf0 + rq[q][1]; hf1 = rq[q][2] * hf1 + rq[q][3]; } }
        { f32x4 gq[7], rq[7];
#pragma unroll
          for (int q = 0; q < 7; ++q) { gq[q] = *(const f32x4*)(gsum + (((size_t)128 + b * 8 + 7 - q) * 1024 + c) * 2); rq[q] = *(const f32x4*)(sum + (((size_t)1024 + b * 64 + grp * 8 + 7 - q) * 1024 + c) * 2); }
#pragma unroll
          for (int q = 0; q < 7; ++q) if (7 - q > grp) { hb0 = gq[q][0] * hb0 + gq[q][1]; hb1 = gq[q][2] * hb1 + gq[q][3]; }
#pragma unroll
          for (int q = 0; q < 7; ++q) if (7 - q > rin) { hb0 = rq[q][0] * hb0 + rq[q][1]; hb1 = rq[q][2] * hb1 + rq[q][3]; } }
        u32x2 wb[32];
#pragma unroll
        for (int t = 0; t < 32; ++t) wb[t] = __builtin_nontemporal_load((const u32x2*)(sb + base + (size_t)t * D));
        unsigned fp[32];
#pragma unroll
        for (int t = 0; t < 32; ++t) { hf0 = (1.f - __uint_as_float(wf[t][0] << 16)) * hf0 + __uint_as_float(wf[t][0] & 0xffff0000u); hf1 = (1.f - __uint_as_float(wf[t][1] << 16)) * hf1 + __uint_as_float(wf[t][1] & 0xffff0000u); fp[t] = pk2(hf0, hf1); }
        unsigned g[32];
#pragma unroll
        for (int t = 0; t < 32; ++t) g[t] = __builtin_nontemporal_load((const unsigned*)(gy + base + (size_t)t * D));
#pragma unroll
        for (int tt = 0; tt < 32; ++tt) { const int t = 31 - tt;
            hb0 = (1.f - __uint_as_float(wb[t][0] << 16)) * hb0 + __uint_as_float(wb[t][0] & 0xffff0000u); hb1 = (1.f - __uint_as_float(wb[t][1] << 16)) * hb1 + __uint_as_float(wb[t][1] & 0xffff0000u);
            const float y0 = __uint_as_float(g[t] << 16) * (__uint_as_float(fp[t] << 16) + hb0), y1 = __uint_as_float(g[t] & 0xffff0000u) * (__uint_as_float(fp[t] & 0xffff0000u) + hb1);
            if (RNN_FP8) *(unsigned short*)(WSP(unsigned char, WS_YF) + base + (size_t)t * D) = (unsigned short)pk4_fp8_(y0 * F8_SY, y1 * F8_SY, 0.f, 0.f);
            else *(unsigned*)(gy + base + (size_t)t * D) = pk2(y0, y1); }
    }
}

__device__ __forceinline__ void ph_router_opt(const Params& p, int layer, const bf16_t* xin, LAS unsigned char* ldsb) {
    const int tid = otid(), lane = tid & 63, wave = __builtin_amdgcn_readfirstlane(tid >> 6);
    constexpr int RT_STR = 1032, RT_LO = 16 * RT_STR * 2, RT_PART = 66560;
    LAS float* part = (LAS float*)(ldsb + RT_PART);
    LAS int* rinfo = (LAS int*)(ldsb + RT_PART + 16384);
    LAS int* lcnt = rinfo + 512;
    const float* g = IN_F(4) + layer * D; const float* mod = WSP(float, WS_MOD) + (size_t)layer * 16 * 6144;
    const float* wr = IN_F(29); const float* rb = IN_F(30);
    bf16_t* h2 = WSP(bf16_t, WS_H2);
    int* re = WSP(int, WS_RTE); int* rp = re + T * 2; float* rw = (float*)(rp + T * 2);
    int* tok = WSP(int, WS_TOK); int* dstp = WSP(int, WS_DST); float* wso = WSP(float, WS_WSO);
    unsigned* cnt = WSP(unsigned, WS_CTL) + CW_CNT + layer * 32;
    bf16x8 wq[4][2][3];
#pragma unroll
    for (int t = 0; t < 4; ++t)
#pragma unroll
        for (int cb = 0; cb < 2; ++cb) { float w8[8];
#pragma unroll
            for (int j = 0; j < 8; ++j) w8[j] = wr[(size_t)(wave * 128 + 32 * t + 8 * (lane >> 4) + j) * 32 + cb * 16 + (lane & 15)];
            u32x4 t0, t1, t2;
#pragma unroll
            for (int q = 0; q < 4; ++q) { const float x0 = w8[2 * q], x1 = w8[2 * q + 1];
                const unsigned a = g8::cvt_pk_bf16(x0, x1); const float r0 = x0 - __uint_as_float(a << 16), r1 = x1 - __uint_as_float(a & 0xffff0000u);
                const unsigned b = g8::cvt_pk_bf16(r0, r1); const float q0 = r0 - __uint_as_float(b << 16), q1 = r1 - __uint_as_float(b & 0xffff0000u);
                t0[q] = a; t1[q] = b; t2[q] = g8::cvt_pk_bf16(q0, q1); }
            wq[t][cb][0] = __builtin_bit_cast(bf16x8, t0); wq[t][cb][1] = __builtin_bit_cast(bf16x8, t1); wq[t][cb][2] = __builtin_bit_cast(bf16x8, t2); }
    const float bias_e = rb[tid & 31];
    for (int batch = blockIdx.x; batch < T / 128; batch += gridDim.x) {
        if (tid < 64) lcnt[tid] = 0;
        u32x2 raw[2][4];
#pragma unroll
        for (int q = 0; q < 2; ++q)
#pragma unroll
            for (int j = 0; j < 4; ++j) raw[q][j] = *(const u32x2*)(xin + (size_t)(batch * 128 + wave * 2 + q) * D + j * 256 + lane * 4);
        float gm_[16], sh_[16];
        { const float* mb = mod + (size_t)((batch * 128) >> 11) * 6144;
#pragma unroll
          for (int j = 0; j < 4; ++j) { const int c0 = j * 256 + lane * 4; const f32x4 gg = *(const f32x4*)(g + c0), s1 = *(const f32x4*)(mb + 4096 + c0), s0 = *(const f32x4*)(mb + 3072 + c0);
#pragma unroll
              for (int i = 0; i < 4; ++i) { gm_[4 * j + i] = gg[i] * (1.f + s1[i]); sh_[4 * j + i] = s0[i]; } } }
        for (int gi = 0; gi < 8; ++gi) {
            const int row0 = batch * 128 + gi * 16;
#pragma unroll
            for (int q = 0; q < 2; ++q) { const int rl = wave * 2 + q, row = row0 + rl, b = row >> 11; float v[16];
#pragma unroll
                for (int j = 0; j < 4; ++j) { const u32x2 x = raw[q][j];
                    v[4 * j] = __uint_as_float(x[0] << 16); v[4 * j + 1] = __uint_as_float(x[0] & 0xffff0000u); v[4 * j + 2] = __uint_as_float(x[1] << 16); v[4 * j + 3] = __uint_as_float(x[1] & 0xffff0000u); }
                if (gi + 1 < 8) {
#pragma unroll
                    for (int j = 0; j < 4; ++j) raw[q][j] = *(const u32x2*)(xin + (size_t)(row + 16) * D + j * 256 + lane * 4); }
                { float s = 0.f;
#pragma unroll
                  for (int i = 0; i < 16; ++i) s += v[i] * v[i];
                  const float rstd = rsqrtf(wave_sum(s) * (1.f / 1024.f) + EPS);
#pragma unroll
                  for (int i = 0; i < 16; ++i) v[i] = v[i] * rstd * gm_[i] + sh_[i]; }
                if (layer == 1 ? MOE1_FP8 : MOE0_FP8) {
#pragma unroll
                    for (int j = 0; j < 4; ++j) *(unsigned*)(WSP(unsigned char, WS_H2F) + (size_t)row * D + j * 256 + lane * 4) = g8::pk4_fp8(v[4 * j] * F8_SH, v[4 * j + 1] * F8_SH, v[4 * j + 2] * F8_SH, v[4 * j + 3] * F8_SH); }
                else row_store_bf16(h2 + (size_t)row * D, lane, v);
#pragma unroll
                for (int j = 0; j < 4; ++j) { typedef float f32x2 __attribute__((ext_vector_type(2)));
                    const unsigned ha = g8::cvt_pk_bf16(v[4 * j], v[4 * j + 1]), hb2 = g8::cvt_pk_bf16(v[4 * j + 2], v[4 * j + 3]);
                    const unsigned la = g8::cvt_pk_bf16(v[4 * j] - __uint_as_float(ha << 16), v[4 * j + 1] - __uint_as_float(ha & 0xffff0000u)), lb2 = g8::cvt_pk_bf16(v[4 * j + 2] - __uint_as_float(hb2 << 16), v[4 * j + 3] - __uint_as_float(hb2 & 0xffff0000u));
                    *(LAS u32x2*)(ldsb + (rl * RT_STR + j * 256 + lane * 4) * 2) = (u32x2){ha, hb2}; *(LAS u32x2*)(ldsb + RT_LO + (rl * RT_STR + j * 256 + lane * 4) * 2) = (u32x2){la, lb2}; } }
            __syncthreads();
            { f32x4 a0 = {0.f, 0.f, 0.f, 0.f}, a1 = {0.f, 0.f, 0.f, 0.f}; const LAS unsigned char* hp = ldsb + ((lane & 15) * RT_STR + wave * 128 + (lane >> 4) * 8) * 2;
#pragma unroll
              for (int t = 0; t < 4; ++t) { const bf16x8 ah = *(const LAS bf16x8*)(hp + t * 64), al = *(const LAS bf16x8*)(hp + RT_LO + t * 64);
                  a0 = __builtin_amdgcn_mfma_f32_16x16x32_bf16(al, wq[t][0][1], a0, 0, 0, 0); a1 = __builtin_amdgcn_mfma_f32_16x16x32_bf16(al, wq[t][1][1], a1, 0, 0, 0);
                  a0 = __builtin_amdgcn_mfma_f32_16x16x32_bf16(ah, wq[t][0][2], a0, 0, 0, 0); a1 = __builtin_amdgcn_mfma_f32_16x16x32_bf16(ah, wq[t][1][2], a1, 0, 0, 0);
                  a0 = __builtin_amdgcn_mfma_f32_16x16x32_bf16(al, wq[t][0][0], a0, 0, 0, 0); a1 = __builtin_amdgcn_mfma_f32_16x16x32_bf16(al, wq[t][1][0], a1, 0, 0, 0);
                  a0 = __builtin_amdgcn_mfma_f32_16x16x32_bf16(ah, wq[t][0][1], a0, 0, 0, 0); a1 = __builtin_amdgcn_mfma_f32_16x16x32_bf16(ah, wq[t][1][1], a1, 0, 0, 0);
                  a0 = __builtin_amdgcn_mfma_f32_16x16x32_bf16(ah, wq[t][0][0], a0, 0, 0, 0); a1 = __builtin_amdgcn_mfma_f32_16x16x32_bf16(ah, wq[t][1][0], a1, 0, 0, 0); }
#pragma unroll
              for (int r = 0; r < 4; ++r) { part[(wave * 16 + 4 * (lane >> 4) + r) * 32 + (lane & 15)] = a0[r]; part[(wave * 16 + 4 * (lane >> 4) + r) * 32 + 16 + (lane & 15)] = a1[r]; } }
            __syncthreads();
            { const int rl = tid >> 5, e = tid & 31; float lg = 0.f;
#pragma unroll
              for (int w_ = 0; w_ < 8; ++w_) lg += part[(w_ * 16 + rl) * 32 + e];
              const float sc = 1.f / (1.f + expf(-lg)), bi = sc + bias_e;
              float bq[4], tq[4];
#pragma unroll
              for (int k = 0; k < 4; ++k) { bq[k] = __shfl(bi, (lane & ~3) + k); tq[k] = __shfl(sc, (lane & ~3) + k); }
              int i1 = 0; float v1 = bq[0], t1 = tq[0];
#pragma unroll
              for (int i = 1; i < 4; ++i) if (bq[i] > v1) { v1 = bq[i]; t1 = tq[i]; i1 = i; }
              int i2 = -1; float v2 = -INFINITY, t2 = 0.f;
#pragma unroll
              for (int i = 0; i < 4; ++i) if (i != i1 && bq[i] > v2) { v2 = bq[i]; t2 = tq[i]; i2 = i; }
              float gs = v1 + v2; int gq = e >> 2; int ee = ((4 * gq + i1) << 8) | (4 * gq + i2);
#pragma unroll
              for (int o = 4; o < 32; o <<= 1) { const float pgs = __shfl_xor(gs, o); const int pgq = __shfl_xor(gq, o), pee = __shfl_xor(ee, o); const float pt1 = __shfl_xor(t1, o), pt2 = __shfl_xor(t2, o);
                  if (pgs > gs || (pgs == gs && pgq < gq)) { gs = pgs; gq = pgq; ee = pee; t1 = pt1; t2 = pt2; } }
              if (e == 0) { const float inv = 1.f / (t1 + t2); LAS int* ri = rinfo + (gi * 16 + rl) * 4; ri[0] = ee >> 8; ri[1] = ee & 255; ri[2] = __float_as_int(t1 * inv); ri[3] = __float_as_int(t2 * inv); } }
        }
        __syncthreads();
        int e1 = 0, e2 = 0, r1 = 0, r2 = 0; float w1 = 0.f, w2 = 0.f;
        if (tid < 128) { e1 = rinfo[tid * 4]; e2 = rinfo[tid * 4 + 1]; w1 = __int_as_float(rinfo[tid * 4 + 2]); w2 = __int_as_float(rinfo[tid * 4 + 3]);
            r1 = __hip_atomic_fetch_add(lcnt + e1, 1, __ATOMIC_RELAXED, __HIP_MEMORY_SCOPE_WORKGROUP); r2 = __hip_atomic_fetch_add(lcnt + e2, 1, __ATOMIC_RELAXED, __HIP_MEMORY_SCOPE_WORKGROUP); }
        __syncthreads();
        if (tid < 32) lcnt[32 + tid] = (int)atomicAdd(cnt + tid, (unsigned)lcnt[tid]);
        __syncthreads();
        if (tid < 128) { const int row = batch * 128 + tid; const int p1 = lcnt[32 + e1] + r1, p2 = lcnt[32 + e2] + r2;
            re[row * 2] = e1; re[row * 2 + 1] = e2; rp[row * 2] = p1; rp[row * 2 + 1] = p2; rw[row * 2] = w1; rw[row * 2 + 1] = w2;
            tok[(size_t)e1 * T + p1] = row; tok[(size_t)e2 * T + p2] = row; dstp[(size_t)e1 * T + p1] = row * 2; dstp[(size_t)e2 * T + p2] = row * 2 + 1; wso[(size_t)e1 * T + p1] = w1; wso[(size_t)e2 * T + p2] = w2; }
        __syncthreads();
    }
}

#define XB_TMO      128
#define XB_XCNT(j)  (256  + 64 * (j))
#define XB_XSUB(j)  (1280 + 64 * (j))
#define XB_XGEN(j)  (2304 + 64 * (j))
#define XB_TOP      3328
#define XB_TOPGEN   3392
#define XCD_BAR_WORDS 3456
#define XB_SPIN_CAP (1u << 22)
__device__ __forceinline__ unsigned xb_ld(unsigned* p)              { return __hip_atomic_load(p, __ATOMIC_RELAXED, __HIP_MEMORY_SCOPE_AGENT); }
__device__ __forceinline__ unsigned xb_add(unsigned* p, unsigned v) { return __hip_atomic_fetch_add(p, v, __ATOMIC_RELAXED, __HIP_MEMORY_SCOPE_AGENT); }
__device__ __forceinline__ unsigned xb_xcc_id() { return (unsigned)__builtin_amdgcn_s_getreg((3 << 11) | 20) & 0xFu; }
#define XB_SPIN(cond, bar) do { unsigned _sp = 0; while (cond) { __builtin_amdgcn_s_sleep(1); \
    if ((++_sp & 255u) == 0u) { if (xb_ld(&(bar)[XB_TMO])) break; if (_sp > XB_SPIN_CAP) { atomicAdd(&(bar)[XB_TMO], 1u); break; } } } } while (0)
struct XcdBarrier { unsigned* bar; unsigned x; volatile LAS unsigned* st; };
__device__ __forceinline__ XcdBarrier xcd_barrier_post(unsigned* bar, volatile LAS unsigned* st) {
    XcdBarrier b; b.bar = bar; b.x = xb_xcc_id(); b.st = st;
    if (otid() == 0) (void)xb_add(&bar[XB_XCNT(b.x)], 1u);
    return b;
}
__device__ __forceinline__ void xcd_barrier_complete(unsigned* bar, unsigned x, unsigned& nloc, unsigned& nx) {
    const unsigned G = gridDim.x * gridDim.y * gridDim.z;
    unsigned sum, cnt, mine, sp = 0u;
    for (;;) {
        sum = 0u; cnt = 0u; mine = 0u;
#pragma unroll
        for (unsigned j = 0; j < 16; ++j) { const unsigned c = xb_ld(&bar[XB_XCNT(j)]); sum += c; cnt += (c > 0u) ? 1u : 0u; mine = (j == x) ? c : mine; }
        if (sum == G) break;
        __builtin_amdgcn_s_sleep(1);
        if ((++sp & 255u) == 0u) { if (xb_ld(&bar[XB_TMO])) break; if (sp > XB_SPIN_CAP) { atomicAdd(&bar[XB_TMO], 1u); break; } }
    }
    nloc = mine > 0u ? mine : 1u; nx = cnt > 0u ? cnt : 1u;
}
__device__ __forceinline__ void xcd_barrier(const XcdBarrier& b) {
    asm volatile("s_waitcnt vmcnt(0)" ::: "memory");
    __syncthreads();
    if (otid() == 0) {
        unsigned* bar = b.bar;
        __builtin_amdgcn_s_waitcnt(0);
        unsigned nloc = b.st[0], nx = b.st[1];
        if (nloc == 0u) { xcd_barrier_complete(bar, b.x, nloc, nx); b.st[0] = nloc; b.st[1] = nx; }
        const unsigned old = xb_add(&bar[XB_XSUB(b.x)], 1u);
        const unsigned gen = old / nloc;
        if (old + 1u == (gen + 1u) * nloc) {
            __builtin_amdgcn_fence(__ATOMIC_RELEASE, "agent");
            asm volatile("s_waitcnt vmcnt(0)" ::: "memory");
            const unsigned og = xb_add(&bar[XB_TOP], 1u);
            const unsigned tg = og / nx;
            if (og + 1u == (tg + 1u) * nx) xb_add(&bar[XB_TOPGEN], 1u);
            else XB_SPIN(xb_ld(&bar[XB_TOPGEN]) == tg, bar);
            __builtin_amdgcn_fence(__ATOMIC_ACQUIRE, "agent");
            xb_add(&bar[XB_XGEN(b.x)], 1u);
            asm volatile("s_waitcnt vmcnt(0)" ::: "memory");
        } else {
            XB_SPIN(xb_ld(&bar[XB_XGEN(b.x)]) == gen, bar);
            __builtin_amdgcn_fence(__ATOMIC_ACQUIRE, "agent");
            asm volatile("s_waitcnt vmcnt(0)" ::: "memory");
        }
    }
    __syncthreads();
}

enum { PH_PRO = 0, PH_NORM0, PH_LAT, PH_QKV, PH_ATTN, PH_WO, PH_ROUTE0, PH_GU0, PH_DN0, PH_COMB0, PH_RIN, PH_CONV, PH_GATE, PH_SCAN, PH_SCAN2, PH_RO, PH_ROUTE1, PH_GU1, PH_DN1, PH_COMB1, PH_COUNT };
constexpr int LDS_PHASE = 131072;
constexpr int LDS_XTRA = 131072;
constexpr int LDS_BYTES = 147456;
constexpr int CW_BAR = 4096;
constexpr bool OPT_RES = true, OPT_RIN = true, OPT_MOE = true, OPT_MLA = true, OPT_ATT = true, OPT_RNN = true, OPT_RTE = true;

template <int PH> __device__ __forceinline__ void run_phase(const Params& p, float* lds) {
    LAS unsigned char* ldsb = (LAS unsigned char*)lds;
    LAS int* tab = (LAS int*)(ldsb + LDS_XTRA);
    const int G = gridDim.x, c = blockIdx.x, vc = (G % 8 == 0) ? (c % 8) * (G / 8) + c / 8 : c;
    if constexpr (PH == PH_PRO) { ph_prologue(p, lds); __syncthreads(); ph_convert(p, (LAS float*)lds); }
    else if constexpr (PH == PH_NORM0) ph_norm0(p);
    else if constexpr (PH == PH_LAT) {
        if constexpr (OPT_MLA) { g8::DenseSched S; S.init(WSP(const bf16_t, WS_HB), 1024, WSP(const bf16_t, WS_W1T), 1024, T, 768);
            g8::EpiLat E{WSP(bf16_t, WS_LAT), WSP(float, WS_SSQP), WSP(float, WS_ROPEK), WSP(float, WS_PESSQ), WSP(const float, WS_COS), WSP(const float, WS_SIN), IN_F(13)};
            g8::gemm_phase<g8::EpiLat, g8::DenseSched, false>(ldsb, 1024 * 2, 1024 * 2, S, E); }
        else { FLat f{p}; rowgemm<1024, LATN>(f, lds); }
        if constexpr (MOE0_FP8 && MOE1_FP8) {
            const int idle0 = (G > 128 && G <= 384) ? 384 - G : 0, nb = G - idle0;
            __syncthreads();
            if (c >= idle0) conv_moe(p, (LAS float*)ldsb + (otid() >> 6) * (64 * 33), otid() & 63, (c - idle0) * 8 + (otid() >> 6), nb * 8, CONV_LATE0, CONV_LATE); } }
    else if constexpr (PH == PH_QKV) {
        if constexpr (OPT_MLA) {
            if constexpr (!QFUSE) { g8::DenseSched S; S.init(WSP(const bf16_t, WS_LAT), LATP, WSP(const bf16_t, WS_WQT), QL, T, 2048);
              g8::EpiQ E{ldsb, WSP(const float, WS_SSQP), IN_F(12), WSP(const float, WS_COS), WSP(const float, WS_SIN), WSP(bf16_t, WS_Q)};
              g8::gemm_phase<g8::EpiQ, g8::DenseSched, false>(ldsb, QL * 2, LATP * 2, S, E); }
            { g8::DenseSched S; S.init(WSP(const bf16_t, WS_LAT) + QL, LATP, WSP(const bf16_t, WS_WKVT), KVL, T, 2048);
              g8::EpiKV E{ldsb, WSP(const float, WS_SSQP), WSP(const float, WS_PESSQ), WSP(const float, WS_ROPEK), IN_F(13), WSP(bf16_t, WS_K), WSP(bf16_t, WS_V)};
              g8::gemm_phase<g8::EpiKV, g8::DenseSched, false>(ldsb, KVL * 2, LATP * 2, S, E); } }
        else { { FQ f{p}; rowgemm<QL, 1536>(f, lds); } __syncthreads(); { FKV f{p}; rowgemm<KVL, 2048>(f, lds); } } }
    else if constexpr (PH == PH_ATTN) { if constexpr (OPT_ATT) att::attn_phase(p, ldsb); else ph_attn(p, lds); }
    else if constexpr (PH == PH_WO) {
        if constexpr (OPT_RES) { g8::DenseSched S; S.init(WSP(const bf16_t, WS_O), 1024, WSP(const bf16_t, WS_WOT), 1024, T, 1024);
            g8::EpiRes<true> E{p.in[0], WSP(const float, WS_MOD) + 2048, WSP(bf16_t, WS_X1), 1.f}; g8::gemm_phase<g8::EpiRes<true>, g8::DenseSched, false>(ldsb, 1024 * 2, 1024 * 2, S, E); }
        else { FRes<true> f{p, WSP(const bf16_t, WS_O), IN_F(14), p.in[0], WSP(const float, WS_MOD) + 2048, WSP(bf16_t, WS_X1)}; rowgemm<1024, 1024>(f, lds); } }
    else if constexpr (PH == PH_ROUTE0) { if constexpr (OPT_RTE) ph_router_opt(p, 0, WSP(const bf16_t, WS_X1), ldsb); else ph_router(p, 0, WSP(const bf16_t, WS_X1)); }
    else if constexpr (PH == PH_GU0 || PH == PH_GU1) { constexpr int layer = (PH == PH_GU1);
        if constexpr (OPT_MOE) { g8::moe_tables(p, layer, tab);
            if constexpr (layer == 1 ? MOE1_FP8 : MOE0_FP8) {
                g8::MoeSched S{tab, (const char*)WSP(const unsigned char, WS_H2F), (const char*)WSP(const unsigned char, WS_WGU8) + (size_t)layer * 64 * MiB, WSP(const int, WS_TOK), 1024, 1024, G, vc, (size_t)1048576, true};
                if constexpr (DN1_FP8) { g8::EpiGu8 E{WSP(unsigned char, WS_ACT)}; g8::gemm_phase<g8::EpiGu8, g8::MoeSched, true, true>(ldsb, 1024, 1024, S, E);
                    if constexpr (layer == 0 && MOE0_FP8 && MOE1_FP8) conv_in_moe_tail(p, ldsb, tab, G, vc, CONV_LATEB, CONV_LATEBN); }
                else { g8::EpiGu E{WSP(bf16_t, WS_ACT), 1.f / (F8_SH * F8_SW)}; g8::gemm_phase<g8::EpiGu, g8::MoeSched, true, true>(ldsb, 1024, 1024, S, E); } }
            else { g8::MoeSched S{tab, (const char*)WSP(const bf16_t, WS_H2), (const char*)(WSP(const bf16_t, WS_WGU) + (size_t)layer * 32 * 1048576), WSP(const int, WS_TOK), 1024 * 2, 1024 * 2, G, vc, (size_t)1048576 * 2, true};
                g8::EpiGu E{WSP(bf16_t, WS_ACT), 1.f}; g8::gemm_phase<g8::EpiGu, g8::MoeSched, true>(ldsb, 1024 * 2, 1024 * 2, S, E); } }
        else { FGu f{p, layer}; rowgemm<1024, 1024>(f, lds); } }
    else if constexpr (PH == PH_DN0 || PH == PH_DN1) { constexpr int layer = (PH == PH_DN1);
        if constexpr (OPT_MOE) { g8::moe_tables(p, layer, tab);
            if constexpr (layer == 1 ? MOE1_FP8 : MOE0_FP8) {
                g8::MoeSched S{tab, (const char*)WSP(const unsigned char, WS_ACT), (const char*)WSP(const unsigned char, WS_WDN8) + (size_t)layer * 32 * MiB, WSP(const int, WS_TOK), 512, 512, G, vc, (size_t)524288, false};
                if constexpr (layer == 1 && YS1_FP8) { g8::EpiDnLite8 E{WSP(const int, WS_DST), WSP(const float, WS_WSO), WSP(unsigned char, WS_YS), F8_SYO / (F8_SA * F8_SW)};
                    g8::gemm_phase<g8::EpiDnLite8, g8::MoeSched, false, true>(ldsb, 512, 512, S, E); }
                else { g8::EpiDnLite E{WSP(const int, WS_DST), WSP(const float, WS_WSO), WSP(bf16_t, WS_YS), 1.f / (F8_SA * F8_SW)};
                g8::gemm_phase<g8::EpiDnLite, g8::MoeSched, false, true>(ldsb, 512, 512, S, E); }
                if constexpr (layer == 0 && MOE0_FP8 && MOE1_FP8 && DN1_FP8) conv_in_moe_tail(p, ldsb, tab, G, vc, CONV_LATEC, CONV_LATEBN); }
            else { g8::MoeSched S{tab, (const char*)WSP(const bf16_t, WS_ACT), (const char*)(WSP(const bf16_t, WS_WDN) + (size_t)layer * 32 * 524288), WSP(const int, WS_TOK), 512 * 2, 512 * 2, G, vc, (size_t)524288 * 2, false};
                g8::EpiDn E{WSP(const int, WS_DST), WSP(const float, WS_WSO), WSP(bf16_t, WS_YS), 1.f}; g8::gemm_phase<g8::EpiDn, g8::MoeSched, false>(ldsb, 512 * 2, 512 * 2, S, E); } }
        else { FDn f{p, layer}; rowgemm<512, 1024>(f, lds); } }
    else if constexpr (PH == PH_COMB0) ph_combine(p, 0, WSP(const bf16_t, WS_X1));
    else if constexpr (PH == PH_RIN) {
        if constexpr (OPT_RIN) {
            if constexpr (RNN_FP8) { g8::DenseSched S; S.init(WSP(const bf16_t, WS_HB), 512, WSP(const bf16_t, WS_WRINT), 512, T, 2048);
                g8::EpiRin E{WSP(bf16_t, WS_GG), WSP(bf16_t, WS_X1), 1.f / (F8_SH * F8_SW)}; g8::gemm_phase<g8::EpiRin, g8::DenseSched, false, true>(ldsb, 1024, 1024, S, E); }
            else { g8::DenseSched S; S.init(WSP(const bf16_t, WS_HB), 1024, WSP(const bf16_t, WS_WRINT), 1024, T, 2048);
                g8::EpiRin E{WSP(bf16_t, WS_GG), WSP(bf16_t, WS_X1), 1.f}; g8::gemm_phase<g8::EpiRin, g8::DenseSched, false>(ldsb, 1024 * 2, 1024 * 2, S, E); } }
        else { FRin f{p}; rowgemm<1024, 2048>(f, lds); } }
    else if constexpr (PH == PH_CONV) ph_conv(p);
    else if constexpr (PH == PH_GATE) {
        if constexpr (OPT_RNN) { g8::GateSched S{(const char*)WSP(const bf16_t, WS_H2), (const char*)WSP(const bf16_t, WS_WGT), G, vc};
            g8::EpiGate E{WSP(const bf16_t, WS_H2), IN_F(20), IN_F(22), IN_F(25), IN_F(27), WSP(const float, WS_SPL), WSP(unsigned, WS_SF), WSP(unsigned, WS_SB)};
            g8::gemm_phase<g8::EpiGate, g8::GateSched, false>(ldsb, 256 * 2, 1024 * 2, S, E); }
        else { FGate f{p}; rowgemm<256, 1024>(f, lds); } }
    else if constexpr (PH == PH_SCAN) { if constexpr (OPT_RNN) ph_scan1(p); else ph_scan(p); }
    else if constexpr (PH == PH_SCAN2) { if constexpr (OPT_RNN) ph_scan2(p); }
    else if constexpr (PH == PH_RO) {
        if constexpr (OPT_RES) {
            if constexpr (RNN_FP8) { g8::DenseSched S; S.init(WSP(const bf16_t, WS_YF), 512, WSP(const bf16_t, WS_WROT), 512, T, 1024);
                g8::EpiRes<false> E{WSP(const void, WS_X2), WSP(const float, WS_MOD) + 16 * 6144 + 2048, WSP(bf16_t, WS_X1), 1.f / (F8_SY * F8_SW)}; g8::gemm_phase<g8::EpiRes<false>, g8::DenseSched, false, true>(ldsb, 1024, 1024, S, E); }
            else { g8::DenseSched S; S.init(WSP(const bf16_t, WS_GG), 1024, WSP(const bf16_t, WS_WROT), 1024, T, 1024);
                g8::EpiRes<false> E{WSP(const void, WS_X2), WSP(const float, WS_MOD) + 16 * 6144 + 2048, WSP(bf16_t, WS_X1), 1.f}; g8::gemm_phase<g8::EpiRes<false>, g8::DenseSched, false>(ldsb, 1024 * 2, 1024 * 2, S, E); } }
        else { FRes<false> f{p, WSP(const bf16_t, WS_GG), IN_F(28), WSP(const void, WS_X2), WSP(const float, WS_MOD) + 16 * 6144 + 2048, WSP(bf16_t, WS_X1)}; rowgemm<1024, 1024>(f, lds); } }
    else if constexpr (PH == PH_ROUTE1) { if constexpr (OPT_RTE) ph_router_opt(p, 1, WSP(const bf16_t, WS_X1), ldsb); else ph_router(p, 1, WSP(const bf16_t, WS_X1)); }
    else if constexpr (PH == PH_COMB1) ph_combine(p, 1, WSP(const bf16_t, WS_X1));
}
#ifndef PROBE_MASK
#define PROBE_MASK 0u
#endif
template <int PH> __device__ __forceinline__ void run_from(const Params& p, float* lds, const XcdBarrier& bar) {
    run_phase<PH>(p, lds);
    if constexpr ((PROBE_MASK >> PH) & 1u) { xcd_barrier(bar); run_phase<PH>(p, lds); }
    if constexpr (PH + 1 < PH_COUNT) { xcd_barrier(bar); run_from<PH + 1>(p, lds, bar); }
}

__global__ void __launch_bounds__(512, 2) k_mega(Params p) {
    extern __shared__ __attribute__((aligned(16))) unsigned char lds_raw[];
    float* lds = (float*)lds_raw;
    volatile LAS unsigned* st = (volatile LAS unsigned*)((LAS unsigned char*)lds_raw + LDS_BYTES - 64);
    if (otid() == 0) { st[0] = 0u; st[1] = 0u; }
    __syncthreads();
    XcdBarrier bar = xcd_barrier_post(WSP(unsigned, WS_CTL) + CW_BAR, st);
    run_from<0>(p, lds, bar);
}

extern "C" void kernel_launch(void* const* d_in, const int* in_sizes, int n_in, void* d_out, int out_size, void* d_ws, size_t ws_size, hipStream_t stream) {
    if (n_in != 33 || ws_size < WS_END) { fprintf(stderr, "kernel_launch: unexpected n_in %d / ws_size %zu\n", n_in, ws_size); return; }
    static int grid = 0;
    if (grid == 0) {
        int dev = 0, cus = 0;
        if (hipGetDevice(&dev) != hipSuccess || hipDeviceGetAttribute(&cus, hipDeviceAttributeMultiprocessorCount, dev) != hipSuccess) { grid = -1; return; }
        if (hipFuncSetAttribute((const void*)k_mega, hipFuncAttributeMaxDynamicSharedMemorySize, LDS_BYTES) != hipSuccess) { grid = -1; return; }
        int nb = 0;
        if (hipOccupancyMaxActiveBlocksPerMultiprocessor(&nb, (const void*)k_mega, 512, LDS_BYTES) != hipSuccess || nb < 1) { grid = -1; return; }
        grid = cus;
    }
    if (grid < 0) return;
    Params p{};
    for (int i = 0; i < 33; ++i) p.in[i] = d_in[i];
    p.out = (float*)d_out; p.ws = (unsigned char*)d_ws;
    (void)hipMemsetAsync((char*)d_ws + WS_CTL, 0, 1 * MiB, stream);
    k_mega<<<dim3(grid), dim3(512), LDS_BYTES, stream>>>(p);
}
#ifdef PHASE_KERNELS
template <int PH> __global__ void __launch_bounds__(512, 2) k_one(Params p) {
    extern __shared__ __attribute__((aligned(16))) unsigned char lds_raw[];
    run_phase<PH>(p, (float*)lds_raw);
}
template __global__ void k_one<0>(Params); template __global__ void k_one<1>(Params); template __global__ void k_one<2>(Params); template __global__ void k_one<3>(Params);
template __global__ void k_one<4>(Params); template __global__ void k_one<5>(Params); template __global__ void k_one<6>(Params); template __global__ void k_one<7>(Params);
template __global__ void k_one<8>(Params); template __global__ void k_one<9>(Params); template __global__ void k_one<10>(Params); template __global__ void k_one<11>(Params);
template __global__ void k_one<12>(Params); template __global__ void k_one<13>(Params); template __global__ void k_one<14>(Params); template __global__ void k_one<15>(Params);
template __global__ void k_one<16>(Params); template __global__ void k_one<17>(Params); template __global__ void k_one<18>(Params); template __global__ void k_one<19>(Params);
#endif
```

```cpp
#include <hip/hip_runtime.h>
#include <stdint.h>
#include <stdio.h>

constexpr int T = 32768, D = 1024, NB = 16, SQ = 2048, NH = 16;
constexpr int QL = 384, KVL = 256, LATN = 672, LATP = 768;
constexpr int NE = 32, DE = 512;
constexpr float EPS = 1e-6f;
constexpr bool QFUSE = true;
constexpr bool MOE0_FP8 = true, MOE1_FP8 = true;
constexpr bool RNN_FP8 = false;
constexpr float F8_SY = 4.f;
constexpr bool DN1_FP8 = true;
constexpr float F8_SH = 16.f, F8_SW = 64.f, F8_SA = 8.f;
constexpr float QSCALE = 0.10206207261596577f * 1.4426950408889634f;

typedef unsigned short bf16_t;
typedef float f32x4 __attribute__((ext_vector_type(4)));
typedef unsigned u32x2 __attribute__((ext_vector_type(2)));
typedef unsigned u32x4 __attribute__((ext_vector_type(4)));

__device__ __forceinline__ int otid() { int t = (int)__builtin_amdgcn_workitem_id_x(); asm volatile("" : "+v"(t)); return t; }
__device__ __forceinline__ float bf2f(bf16_t v) { return __uint_as_float(((unsigned)v) << 16); }
__device__ __forceinline__ bf16_t f2bf(float f) { unsigned u = __float_as_uint(f); return (bf16_t)((u + 0x7fffu + ((u >> 16) & 1u)) >> 16); }
__device__ __forceinline__ unsigned pk2(float lo, float hi) { return (unsigned)f2bf(lo) | ((unsigned)f2bf(hi) << 16); }
__device__ __forceinline__ unsigned pk4_fp8_(float a, float b, float c, float d) {
    a = fminf(fmaxf(a, -448.f), 448.f); b = fminf(fmaxf(b, -448.f), 448.f); c = fminf(fmaxf(c, -448.f), 448.f); d = fminf(fmaxf(d, -448.f), 448.f);
    int r = 0; r = __builtin_amdgcn_cvt_pk_fp8_f32(a, b, r, false); r = __builtin_amdgcn_cvt_pk_fp8_f32(c, d, r, true); return (unsigned)r; }
__device__ __forceinline__ float wave_sum(float v) {
#pragma unroll
    for (int o = 1; o < 64; o <<= 1) v += __shfl_xor(v, o);
    return v;
}
__device__ __forceinline__ float sigmoidf_(float x) { return 1.f / (1.f + __expf(-x)); }
__device__ __forceinline__ float siluf_(float x) { return x * sigmoidf_(x); }
__device__ __forceinline__ float gelu_tanh(float x) { const float u = 0.7978845608028654f * (x + 0.044715f * x * x * x); return 0.5f * x * (1.f + tanhf(u)); }

constexpr size_t MiB = 1u << 20;
constexpr size_t WS_CTL = 0;
constexpr size_t WS_MOD = 1 * MiB;
constexpr size_t WS_COS = 2 * MiB;
constexpr size_t WS_SIN = 4 * MiB;
constexpr size_t WS_RTE = 6 * MiB;
constexpr size_t WS_TOK = 7 * MiB;
constexpr size_t WS_SSQ = 11 * MiB;
constexpr size_t WS_DST = 12 * MiB;
constexpr size_t WS_WSO = 16 * MiB;
constexpr size_t WS_W1T = 20 * MiB;
constexpr size_t WS_WQT = 22 * MiB;
constexpr size_t WS_WKVT = 24 * MiB;
constexpr size_t WS_WOT = 25 * MiB;
constexpr size_t WS_WRINT = 27 * MiB;
constexpr size_t WS_WGT = 31 * MiB;
constexpr size_t WS_WROT = 33 * MiB;
constexpr size_t WS_WGU = 36 * MiB;
constexpr size_t WS_WDN = 164 * MiB;
constexpr size_t WS_WGU8 = WS_WGU;
constexpr size_t WS_WDN8 = WS_WDN;
constexpr size_t WS_HB = 228 * MiB;
constexpr size_t WS_X1 = 292 * MiB;
constexpr size_t WS_H2 = 356 * MiB;
constexpr size_t WS_X2 = 420 * MiB;
constexpr size_t WS_U = 484 * MiB;
constexpr size_t WS_LAT = WS_U;
constexpr size_t WS_Q = WS_U + 48 * MiB;
constexpr size_t WS_K = WS_U + 144 * MiB;
constexpr size_t WS_V = WS_U + 240 * MiB;
constexpr size_t WS_O = WS_U + 304 * MiB;
constexpr size_t WS_SSQP = WS_U + 368 * MiB;
constexpr size_t WS_ROPEK = WS_U + 372 * MiB;
constexpr size_t WS_PESSQ = WS_U + 376 * MiB;
constexpr size_t WS_ACT = WS_U;
constexpr size_t WS_YS = WS_U + 72 * MiB;
constexpr size_t WS_YF = WS_U + 448 * MiB;
constexpr size_t WS_H2F = WS_U + 200 * MiB;
constexpr size_t WS_AF = WS_U;
constexpr size_t WS_AB = WS_U + 128 * MiB;
constexpr size_t WS_BXF = WS_U + 256 * MiB;
constexpr size_t WS_BXB = WS_U + 320 * MiB;
constexpr size_t WS_GG = WS_U + 384 * MiB;
constexpr size_t WS_SF = WS_U;
constexpr size_t WS_SB = WS_U + 128 * MiB;
constexpr size_t WS_SUM = WS_U + 256 * MiB;
constexpr size_t WS_SMAX = 11 * MiB + 768 * 1024;
constexpr size_t WS_SPL = 11 * MiB + 512 * 1024;
constexpr size_t WS_END = 1024 * MiB;
constexpr int CW_CNT = 1024;

struct Params { const void* in[33]; float* out; unsigned char* ws; };
__host__ __device__ __forceinline__ size_t kidx(int bh, int s, int d) { return ((size_t)(bh * 32 + (s >> 6)) * 12 + (d >> 3)) * 512 + (s & 63) * 8 + (d & 7); }
__host__ __device__ __forceinline__ size_t vidx(int bh, int s, int d) { return ((size_t)(bh * 32 + (s >> 6)) * 2 + (d >> 5)) * 2048 + (s & 63) * 32 + (d & 31); }

#define IN_F(i) ((const float*)p.in[i])
#define WSP(T_, off) ((T_*)(p.ws + (off)))

template <int K, int N, class F>
__device__ __forceinline__ void rowgemm(const F& f, float* lds) {
    constexpr int R = 8, NC = (N + 511) / 512;
    float* As = lds;
    float* Cs = lds + R * K;
    int* info = (int*)(Cs + R * N);
    const int tid = otid();
    const int nun = f.nunits();
    for (int u = blockIdx.x; u < nun; u += gridDim.x) {
        f.prep(u, info);
        __syncthreads();
        for (int i = tid; i < R * K; i += 512) { const int r = i / K, k = i % K; As[i] = f.a(u, info, r, k); }
        __syncthreads();
        float acc[NC][R];
#pragma unroll
        for (int c = 0; c < NC; ++c)
#pragma unroll
            for (int r = 0; r < R; ++r) acc[c][r] = 0.f;
        for (int k = 0; k < K; k += 4) {
            float bv[NC][4];
#pragma unroll
            for (int c = 0; c < NC; ++c) { const int n = tid + c * 512;
#pragma unroll
                for (int kk = 0; kk < 4; ++kk) bv[c][kk] = (n < N) ? f.b(u, info, k + kk, n) : 0.f; }
#pragma unroll
            for (int r = 0; r < R; ++r) { const f32x4 av = *(const f32x4*)(As + r * K + k);
#pragma unroll
                for (int c = 0; c < NC; ++c) { acc[c][r] += av[0] * bv[c][0]; acc[c][r] += av[1] * bv[c][1]; acc[c][r] += av[2] * bv[c][2]; acc[c][r] += av[3] * bv[c][3]; } }
        }
#pragma unroll
        for (int c = 0; c < NC; ++c) { const int n = tid + c * 512; if (n < N) {
#pragma unroll
            for (int r = 0; r < R; ++r) Cs[r * N + n] = acc[c][r]; } }
        __syncthreads();
        f.epi(u, info, Cs);
        __syncthreads();
    }
}

__device__ __forceinline__ void ph_prologue(const Params& p, float* lds) {
    const int tid = otid();
    float* cact = lds;
    float* red = lds + 16 * 1024;
    const float* c = IN_F(1);
    { float cv[32];
#pragma unroll
      for (int k = 0; k < 32; ++k) cv[k] = c[tid + 512 * k];
#pragma unroll
      for (int k = 0; k < 32; ++k) cact[tid + 512 * k] = siluf_(cv[k]); }
    __syncthreads();
    const float* wada = IN_F(5); const float* bada = IN_F(6);
    float* mod = WSP(float, WS_MOD);
    const int cl = tid & 31, ks = tid >> 5;
    for (int t = blockIdx.x; t < 384; t += gridDim.x) {
        const int l = t / 192, col0 = (t % 192) * 32;
        float acc[16];
#pragma unroll
        for (int b = 0; b < 16; ++b) acc[b] = 0.f;
        const float* w = wada + (size_t)l * 1024 * 6144 + col0 + cl;
#pragma unroll 1
        for (int k0 = ks * 64; k0 < ks * 64 + 64; k0 += 32) { float wv[32];
#pragma unroll
            for (int q = 0; q < 32; ++q) wv[q] = __builtin_nontemporal_load(w + (size_t)(k0 + q) * 6144);
#pragma unroll
            for (int q = 0; q < 32; ++q) {
#pragma unroll
                for (int b = 0; b < 16; ++b) acc[b] += cact[b * 1024 + k0 + q] * wv[q];
                asm volatile("" ::: "memory"); } }
#pragma unroll
        for (int b = 0; b < 16; ++b) red[(ks * 16 + b) * 32 + cl] = acc[b];
        __syncthreads();
        { const int b = tid >> 5; float s = 0.f;
#pragma unroll
          for (int q = 0; q < 16; ++q) s += red[(q * 16 + b) * 32 + cl];
          mod[((size_t)l * 16 + b) * 6144 + col0 + cl] = s + bada[l * 6144 + col0 + cl]; }
        __syncthreads();
    }
    { float* spl = WSP(float, WS_SPL); for (int i = blockIdx.x * 512 + tid; i < 2048; i += gridDim.x * 512) { const float lam = (i < 1024) ? IN_F(18)[i] : IN_F(23)[i - 1024]; spl[i] = -8.f * 1.4426950408889634f * log1pf(expf(-lam)); } }
    if (blockIdx.x == 0 && tid < 64) { float mq = 0.f, mk = 0.f; for (int i = tid; i < 96; i += 64) { mq = fmaxf(mq, fabsf(IN_F(12)[i])); mk = fmaxf(mk, fabsf(IN_F(13)[i])); }
#pragma unroll
        for (int o = 1; o < 64; o <<= 1) { mq = fmaxf(mq, __shfl_xor(mq, o)); mk = fmaxf(mk, __shfl_xor(mk, o)); }
        if (tid == 0) *WSP(float, WS_SMAX) = 1.02f * 96.f * mq * mk * QSCALE + 0.01f; }
    const int* pos = (const int*)p.in[2];
    float* ct = WSP(float, WS_COS); float* st = WSP(float, WS_SIN);
    for (int i = blockIdx.x * 512 + tid; i < T * 16; i += gridDim.x * 512) {
        const int tok = i >> 4, j = i & 15;
        const float inv = exp2f(-(float)j * (13.287712379549449f / 16.f));
        const float ang = (float)pos[tok] * inv;
        const double rev = (double)ang * 0.15915494309189535;
        const float fr = (float)(rev - floor(rev));
        ct[i] = __builtin_amdgcn_cosf(fr); st[i] = __builtin_amdgcn_sinf(fr);
    }
}

__device__ __forceinline__ void row_load_f32(const float* row, int lane, float (&v)[16]) {
#pragma unroll
    for (int j = 0; j < 4; ++j) { const f32x4 x = *(const f32x4*)(row + j * 256 + lane * 4); v[4 * j] = x[0]; v[4 * j + 1] = x[1]; v[4 * j + 2] = x[2]; v[4 * j + 3] = x[3]; }
}
__device__ __forceinline__ void row_load_bf16(const bf16_t* row, int lane, float (&v)[16]) {
#pragma unroll
    for (int j = 0; j < 4; ++j) { const u32x2 x = *(const u32x2*)(row + j * 256 + lane * 4);
        v[4 * j] = __uint_as_float(x[0] << 16); v[4 * j + 1] = __uint_as_float(x[0] & 0xffff0000u); v[4 * j + 2] = __uint_as_float(x[1] << 16); v[4 * j + 3] = __uint_as_float(x[1] & 0xffff0000u); }
}
__device__ __forceinline__ void row_store_bf16(bf16_t* row, int lane, const float (&v)[16]) {
#pragma unroll
    for (int j = 0; j < 4; ++j) { u32x2 x; x[0] = pk2(v[4 * j], v[4 * j + 1]); x[1] = pk2(v[4 * j + 2], v[4 * j + 3]); *(u32x2*)(row + j * 256 + lane * 4) = x; }
}
__device__ __forceinline__ void row_modulate(float (&v)[16], int lane, const float* g, const float* sh, const float* sc) {
    float s = 0.f;
#pragma unroll
    for (int i = 0; i < 16; ++i) s += v[i] * v[i];
    const float rstd = rsqrtf(wave_sum(s) * (1.f / 1024.f) + EPS);
#pragma unroll
    for (int j = 0; j < 4; ++j) { const int c0 = j * 256 + lane * 4;
        const f32x4 gg = *(const f32x4*)(g + c0), s1 = *(const f32x4*)(sc + c0), s0 = *(const f32x4*)(sh + c0);
#pragma unroll
        for (int i = 0; i < 4; ++i) v[4 * j + i] = v[4 * j + i] * rstd * gg[i] * (1.f + s1[i]) + s0[i]; }
}

__device__ __forceinline__ size_t sf_tile_base(int tile, int c) { return ((size_t)(tile * 16 + (c >> 6)) * 256) * 64 + (c & 63); }
__device__ __forceinline__ void ph_norm0(const Params& p) {
    const int lane = otid() & 63, gw = blockIdx.x * 8 + (otid() >> 6), ngw = gridDim.x * 8;
    const float* x = IN_F(0); const float* g = IN_F(3); const float* mod = WSP(float, WS_MOD); bf16_t* hb = WSP(bf16_t, WS_HB);
#pragma unroll 1
    for (int run = gw; run < T / 16; run += ngw) { const int row0 = run * 16, b = row0 >> 11; const float* mb = mod + (size_t)b * 6144;
        float gm[16], sh[16];
#pragma unroll
        for (int j = 0; j < 4; ++j) { const int c0 = j * 256 + lane * 4; const f32x4 gg = *(const f32x4*)(g + c0), s1 = *(const f32x4*)(mb + 1024 + c0), s0 = *(const f32x4*)(mb + c0);
#pragma unroll
            for (int i = 0; i < 4; ++i) { gm[4 * j + i] = gg[i] * (1.f + s1[i]); sh[4 * j + i] = s0[i]; } }
        f32x4 nx[4], ny[4];
#pragma unroll
        for (int j = 0; j < 4; ++j) { nx[j] = __builtin_nontemporal_load((const f32x4*)(x + (size_t)row0 * D + j * 256 + lane * 4)); ny[j] = __builtin_nontemporal_load((const f32x4*)(x + (size_t)(row0 + 1) * D + j * 256 + lane * 4)); }
#pragma unroll 1
        for (int k = 0; k < 16; ++k) { const int row = row0 + k, nrow = row0 + (k < 14 ? k + 2 : 15); float v[16];
#pragma unroll
            for (int j = 0; j < 4; ++j) { v[4 * j] = nx[j][0]; v[4 * j + 1] = nx[j][1]; v[4 * j + 2] = nx[j][2]; v[4 * j + 3] = nx[j][3]; nx[j] = ny[j]; }
#pragma unroll
            for (int j = 0; j < 4; ++j) ny[j] = __builtin_nontemporal_load((const f32x4*)(x + (size_t)nrow * D + j * 256 + lane * 4));
            float s_ = 0.f;
#pragma unroll
            for (int i = 0; i < 16; ++i) s_ += v[i] * v[i];
            const float rstd = rsqrtf(wave_sum(s_) * (1.f / 1024.f) + EPS);
#pragma unroll
            for (int i = 0; i < 16; ++i) v[i] = v[i] * rstd * gm[i] + sh[i];
            row_store_bf16(hb + (size_t)row * D, lane, v); } }
}

struct FLat { const Params& p;
    __device__ __forceinline__ int nunits() const { return T / 8; }
    __device__ __forceinline__ void prep(int, int*) const {}
    __device__ __forceinline__ float a(int u, const int*, int r, int k) const { return bf2f(WSP(const bf16_t, WS_HB)[(size_t)(u * 8 + r) * D + k]); }
    __device__ __forceinline__ float b(int, const int*, int k, int n) const { return IN_F(7)[(size_t)k * LATN + n]; }
    __device__ __forceinline__ void epi(int u, const int*, const float* Cs) const {
        bf16_t* lat = WSP(bf16_t, WS_LAT); float* ssq = WSP(float, WS_SSQ);
        const int tid = otid(), r = tid >> 6, lane = tid & 63; const int row = u * 8 + r;
        float s0 = 0.f, s1 = 0.f;
        for (int n = lane; n < LATN; n += 64) { const float v = Cs[r * LATN + n]; lat[(size_t)row * LATP + n] = f2bf(v); if (n < QL) s0 += v * v; else if (n < QL + KVL) s1 += v * v; }
        s0 = wave_sum(s0); s1 = wave_sum(s1);
        if (lane == 0) { ssq[row * 2] = s0; ssq[row * 2 + 1] = s1; }
    }
};
struct FQ { const Params& p;
    __device__ __forceinline__ int nunits() const { return T / 8; }
    __device__ __forceinline__ void prep(int, int*) const {}
    __device__ __forceinline__ float a(int u, const int*, int r, int k) const { const int row = u * 8 + r;
        const float rstd = rsqrtf(WSP(const float, WS_SSQ)[row * 2] * (1.f / QL) + EPS);
        return bf2f(WSP(const bf16_t, WS_LAT)[(size_t)row * LATP + k]) * rstd * IN_F(8)[k]; }
    __device__ __forceinline__ float b(int, const int*, int k, int n) const { return IN_F(10)[(size_t)k * 1536 + n]; }
    __device__ __forceinline__ void epi(int u, const int*, const float* Cs) const {
        const int tid = otid(); if (tid >= 128) return;
        const int r = tid >> 4, h = tid & 15, row = u * 8 + r, b = row >> 11, s = row & 2047;
        const float* c = Cs + r * 1536 + h * 96; const float* gn = IN_F(12);
        float ss = 0.f; for (int d = 0; d < 96; ++d) ss += c[d] * c[d];
        const float rstd = rsqrtf(ss * (1.f / 96.f) + EPS) ;
        bf16_t* q = WSP(bf16_t, WS_Q) + ((size_t)(b * NH + h) * SQ + s) * 96;
        for (int d = 0; d < 64; ++d) q[d] = f2bf(c[d] * rstd * gn[d] * QSCALE);
        const float* ct = WSP(const float, WS_COS) + (size_t)row * 16; const float* st = WSP(const float, WS_SIN) + (size_t)row * 16;
        for (int i = 0; i < 16; ++i) { const float x1 = c[64 + i] * rstd * gn[64 + i], x2 = c[80 + i] * rstd * gn[80 + i];
            q[64 + i] = f2bf((x1 * ct[i] - x2 * st[i]) * QSCALE); q[80 + i] = f2bf((x1 * st[i] + x2 * ct[i]) * QSCALE); }
    }
};
struct FKV { const Params& p;
    __device__ __forceinline__ int nunits() const { return T / 8; }
    __device__ __forceinline__ void prep(int, int*) const {}
    __device__ __forceinline__ float a(int u, const int*, int r, int k) const { const int row = u * 8 + r;
        const float rstd = rsqrtf(WSP(const float, WS_SSQ)[row * 2 + 1] * (1.f / KVL) + EPS);
        return bf2f(WSP(const bf16_t, WS_LAT)[(size_t)row * LATP + QL + k]) * rstd * IN_F(9)[k]; }
    __device__ __forceinline__ float b(int, const int*, int k, int n) const { return IN_F(11)[(size_t)k * 2048 + n]; }
    __device__ __forceinline__ void epi(int u, const int*, const float* Cs) const {
        const int tid = otid(); if (tid >= 128) return;
        const int r = tid >> 4, h = tid & 15, row = u * 8 + r, b = row >> 11, s = row & 2047;
        const float* c = Cs + r * 2048 + h * 128; const float* gn = IN_F(13);
        const bf16_t* pe = WSP(const bf16_t, WS_LAT) + (size_t)row * LATP + QL + KVL;
        float ss = 0.f; for (int d = 0; d < 64; ++d) ss += c[d] * c[d];
        for (int j = 0; j < 32; ++j) { const float v = bf2f(pe[j]); ss += v * v; }
        const float rstd = rsqrtf(ss * (1.f / 96.f) + EPS);
        bf16_t* kk = WSP(bf16_t, WS_K); bf16_t* vv = WSP(bf16_t, WS_V); const int bh = b * NH + h;
        for (int d = 0; d < 64; ++d) { kk[kidx(bh, s, d)] = f2bf(c[d] * rstd * gn[d]); vv[vidx(bh, s, d)] = f2bf(c[64 + d]); }
        const float* ct = WSP(const float, WS_COS) + (size_t)row * 16; const float* st = WSP(const float, WS_SIN) + (size_t)row * 16;
        for (int i = 0; i < 16; ++i) { const float x1 = bf2f(pe[i]) * rstd * gn[64 + i], x2 = bf2f(pe[16 + i]) * rstd * gn[80 + i];
            kk[kidx(bh, s, 64 + i)] = f2bf(x1 * ct[i] - x2 * st[i]); kk[kidx(bh, s, 80 + i)] = f2bf(x1 * st[i] + x2 * ct[i]); }
    }
};

__device__ __forceinline__ void ph_attn(const Params& p, float* lds) {
    constexpr int KT = 16;
    float* Ks = lds;
    float* Vs = lds + KT * 96;
    const int tid = otid();
    const bf16_t* Qg = WSP(const bf16_t, WS_Q); const bf16_t* Kg = WSP(const bf16_t, WS_K); const bf16_t* Vg = WSP(const bf16_t, WS_V);
    bf16_t* Og = WSP(bf16_t, WS_O);
    for (int u = blockIdx.x; u < 1024; u += gridDim.x) {
        const int bh = u >> 2, qc = u & 3, s = qc * 512 + tid;
        unsigned qp[48];
        { const bf16_t* qptr = Qg + ((size_t)bh * SQ + s) * 96;
#pragma unroll
          for (int d = 0; d < 48; d += 4) { const u32x4 x = *(const u32x4*)(qptr + 2 * d); qp[d] = x[0]; qp[d + 1] = x[1]; qp[d + 2] = x[2]; qp[d + 3] = x[3]; } }
        float o[64];
#pragma unroll
        for (int d = 0; d < 64; ++d) o[d] = 0.f;
        float m = -INFINITY, l = 0.f;
        for (int t0 = 0; t0 < SQ; t0 += KT) {
            __syncthreads();
            for (int i = tid; i < KT * 96; i += 512) Ks[i] = bf2f(Kg[kidx(bh, t0 + i / 96, i % 96)]);
            for (int i = tid; i < KT * 64; i += 512) Vs[i] = bf2f(Vg[vidx(bh, t0 + i / 64, i % 64)]);
            __syncthreads();
#pragma unroll 1
            for (int j = 0; j < KT; ++j) { float a = 0.f;
#pragma unroll
                for (int d = 0; d < 96; d += 4) { const f32x4 kv = *(const f32x4*)(Ks + j * 96 + d); const unsigned w0 = qp[d >> 1], w1 = qp[(d >> 1) + 1];
                    a += __uint_as_float(w0 << 16) * kv[0]; a += __uint_as_float(w0 & 0xffff0000u) * kv[1]; a += __uint_as_float(w1 << 16) * kv[2]; a += __uint_as_float(w1 & 0xffff0000u) * kv[3]; }
                const float mn = fmaxf(m, a), alpha = exp2f(m - mn), pj = exp2f(a - mn); m = mn;
                l = l * alpha + pj;
#pragma unroll
                for (int d = 0; d < 64; d += 4) { const f32x4 vv = *(const f32x4*)(Vs + j * 64 + d);
                    o[d] = o[d] * alpha + pj * vv[0]; o[d + 1] = o[d + 1] * alpha + pj * vv[1]; o[d + 2] = o[d + 2] * alpha + pj * vv[2]; o[d + 3] = o[d + 3] * alpha + pj * vv[3]; } }
        }
        const float rl = 1.f / l; const int b = bh >> 4, h = bh & 15;
        bf16_t* op = Og + ((size_t)(b * SQ + s)) * D + h * 64;
#pragma unroll
        for (int d = 0; d < 64; d += 8) { u32x4 x;
#pragma unroll
            for (int i = 0; i < 4; ++i) x[i] = pk2(o[d + 2 * i] * rl, o[d + 2 * i + 1] * rl);
            *(u32x4*)(op + d) = x; }
    }
}

template <bool RESID_F32>
struct FRes { const Params& p; const bf16_t* A; const float* W; const void* resid; const float* gate  ; bf16_t* out;
    __device__ __forceinline__ int nunits() const { return T / 8; }
    __device__ __forceinline__ void prep(int, int*) const {}
    __device__ __forceinline__ float a(int u, const int*, int r, int k) const { return bf2f(A[(size_t)(u * 8 + r) * D + k]); }
    __device__ __forceinline__ float b(int, const int*, int k, int n) const { return W[(size_t)k * D + n]; }
    __device__ __forceinline__ void epi(int u, const int*, const float* Cs) const {
        for (int i = otid(); i < 8 * D; i += 512) { const int r = i >> 10, n = i & 1023, row = u * 8 + r, b = row >> 11;
            const float rv = RESID_F32 ? ((const float*)resid)[(size_t)row * D + n] : bf2f(((const bf16_t*)resid)[(size_t)row * D + n]);
            out[(size_t)row * D + n] = f2bf(rv + gate[(size_t)b * 6144 + n] * Cs[i]); }
    }
};

__device__ __forceinline__ void ph_router(const Params& p, int layer, const bf16_t* xin) {
    const int lane = otid() & 63, gw = blockIdx.x * 8 + (otid() >> 6), ngw = gridDim.x * 8;
    const float* g = IN_F(4) + layer * D; const float* mod = WSP(float, WS_MOD) + (size_t)layer * 16 * 6144;
    const float* wr = IN_F(29); const float* rb = IN_F(30);
    bf16_t* h2 = WSP(bf16_t, WS_H2);
    int* re = WSP(int, WS_RTE); int* rp = re + T * 2; float* rw = (float*)(rp + T * 2);
    int* tok = WSP(int, WS_TOK); unsigned* cnt = WSP(unsigned, WS_CTL) + CW_CNT + layer * 32;
    for (int row = gw; row < T; row += ngw) { const int b = row >> 11; float v[16];
        row_load_bf16(xin + (size_t)row * D, lane, v);
        row_modulate(v, lane, g, mod + (size_t)b * 6144 + 3072, mod + (size_t)b * 6144 + 4096);
        row_store_bf16(h2 + (size_t)row * D, lane, v);
        float lg[32];
#pragma unroll
        for (int e = 0; e < 32; ++e) lg[e] = 0.f;
#pragma unroll
        for (int j = 0; j < 4; ++j)
#pragma unroll
            for (int i = 0; i < 4; ++i) { const float* w = wr + (size_t)(j * 256 + lane * 4 + i) * 32; const float hv = v[4 * j + i];
#pragma unroll
                for (int e = 0; e < 32; e += 4) { const f32x4 wv = *(const f32x4*)(w + e); lg[e] += hv * wv[0]; lg[e + 1] += hv * wv[1]; lg[e + 2] += hv * wv[2]; lg[e + 3] += hv * wv[3]; } }
#pragma unroll
        for (int e = 0; e < 32; ++e) lg[e] = wave_sum(lg[e]);
        float best = -INFINITY; int e1 = 0, e2 = 1; float s1 = 0.f, s2 = 0.f;
#pragma unroll
        for (int gq = 0; gq < 8; ++gq) {
            float sc[4], bi[4];
#pragma unroll
            for (int i = 0; i < 4; ++i) { sc[i] = 1.f / (1.f + expf(-lg[4 * gq + i])); bi[i] = sc[i] + rb[4 * gq + i]; }
            int i1 = 0; float v1 = bi[0], t1 = sc[0];
#pragma unroll
            for (int i = 1; i < 4; ++i) if (bi[i] > v1) { v1 = bi[i]; t1 = sc[i]; i1 = i; }
            int i2 = -1; float v2 = -INFINITY, t2 = 0.f;
#pragma unroll
            for (int i = 0; i < 4; ++i) if (i != i1 && bi[i] > v2) { v2 = bi[i]; t2 = sc[i]; i2 = i; }
            const float gs = v1 + v2;
            if (gs > best) { best = gs; e1 = 4 * gq + i1; e2 = 4 * gq + i2; s1 = t1; s2 = t2; }
        }
        if (lane == 0) {
            const float inv = 1.f / (s1 + s2);
            const int p1 = (int)atomicAdd(cnt + e1, 1u), p2 = (int)atomicAdd(cnt + e2, 1u);
            re[row * 2] = e1; re[row * 2 + 1] = e2; rp[row * 2] = p1; rp[row * 2 + 1] = p2; rw[row * 2] = s1 * inv; rw[row * 2 + 1] = s2 * inv;
            tok[(size_t)e1 * T + p1] = row; tok[(size_t)e2 * T + p2] = row;
            int* dstp = WSP(int, WS_DST); float* wso = WSP(float, WS_WSO);
            dstp[(size_t)e1 * T + p1] = row * 2; dstp[(size_t)e2 * T + p2] = row * 2 + 1; wso[(size_t)e1 * T + p1] = s1 * inv; wso[(size_t)e2 * T + p2] = s2 * inv;
        }
    }
}

struct MoeUnit {
    static __device__ __forceinline__ void prep(const Params& p, int layer, int u, int* info) {
        if (otid() == 0) {
            const unsigned* cnt = WSP(const unsigned, WS_CTL) + CW_CNT + layer * 32; const int* tok = WSP(const int, WS_TOK);
            int e = 0, g0 = 0, seg = 0;
            for (; e < 32; ++e) { const int c = (int)cnt[e], ng = (c + 7) >> 3; if (u < g0 + ng) break; g0 += ng; seg += ((c + 255) >> 8) << 8; }
            if (e >= 32) { info[0] = -1; }
            else { const int c = (int)cnt[e], pos0 = (u - g0) * 8; info[0] = e; info[1] = pos0; info[2] = c; info[3] = seg;
                for (int r = 0; r < 8; ++r) info[8 + r] = (pos0 + r < c) ? tok[(size_t)e * T + pos0 + r] : -1; }
        }
    }
};
struct FGu { const Params& p; int layer;
    __device__ __forceinline__ int nunits() const { return (2 * T) / 8 + 32; }
    __device__ __forceinline__ void prep(int u, int* info) const { MoeUnit::prep(p, layer, u, info); }
    __device__ __forceinline__ float a(int, const int* info, int r, int k) const { const int t = info[8 + r]; return (info[0] >= 0 && t >= 0) ? bf2f(WSP(const bf16_t, WS_H2)[(size_t)t * D + k]) : 0.f; }
    __device__ __forceinline__ float b(int, const int* info, int k, int n) const { const int e = info[0] < 0 ? 0 : info[0]; return IN_F(31)[((size_t)(layer * 32 + e) * 1024 + k) * 1024 + n]; }
    __device__ __forceinline__ void epi(int, const int* info, const float* Cs) const {
        if (info[0] < 0) return;
        bf16_t* act = WSP(bf16_t, WS_ACT);
        for (int i = otid(); i < 8 * DE; i += 512) { const int r = i >> 9, c = i & 511;
            if (info[8 + r] >= 0) act[(size_t)(info[3] + info[1] + r) * DE + c] = f2bf(siluf_(Cs[r * 1024 + c]) * Cs[r * 1024 + 512 + c]); }
    }
};
struct FDn { const Params& p; int layer;
    __device__ __forceinline__ int nunits() const { return (2 * T) / 8 + 32; }
    __device__ __forceinline__ void prep(int u, int* info) const { MoeUnit::prep(p, layer, u, info); }
    __device__ __forceinline__ float a(int, const int* info, int r, int k) const { return (info[0] >= 0 && info[8 + r] >= 0) ? bf2f(WSP(const bf16_t, WS_ACT)[(size_t)(info[3] + info[1] + r) * DE + k]) : 0.f; }
    __device__ __forceinline__ float b(int, const int* info, int k, int n) const { const int e = info[0] < 0 ? 0 : info[0]; return IN_F(32)[((size_t)(layer * 32 + e) * 512 + k) * 1024 + n]; }
    __device__ __forceinline__ void epi(int, const int* info, const float* Cs) const {
        if (info[0] < 0) return;
        const int* re = WSP(const int, WS_RTE); const float* rw = (const float*)(re + T * 4);
        bf16_t* ys = WSP(bf16_t, WS_YS);
        for (int i = otid(); i < 8 * D; i += 512) { const int r = i >> 10, n = i & 1023; const int t = info[8 + r];
            if (t >= 0) { const int slot = (re[t * 2] == info[0]) ? 0 : 1; ys[((size_t)t * 2 + slot) * D + n] = f2bf(rw[t * 2 + slot] * Cs[i]); } }
    }
};

__device__ __forceinline__ void ph_combine(const Params& p, int layer, const bf16_t* xmid) {
    const int lane = otid() & 63, gw = blockIdx.x * 8 + (otid() >> 6), ngw = gridDim.x * 8;
    const float* mod = WSP(float, WS_MOD); const bf16_t* ys = WSP(const bf16_t, WS_YS);
#pragma unroll 1
    for (int run = gw; run < T / 16; run += ngw) { const int row0 = run * 16, b = row0 >> 11;
        const float* g2 = mod + ((size_t)layer * 16 + b) * 6144 + 5120; const float* m1 = mod + ((size_t)16 + b) * 6144;
        float gt[16], gm[16], sh[16];
#pragma unroll
        for (int j = 0; j < 4; ++j) { const int c0 = j * 256 + lane * 4; const f32x4 gg = *(const f32x4*)(g2 + c0);
#pragma unroll
            for (int i = 0; i < 4; ++i) gt[4 * j + i] = gg[i];
            if (layer == 0) { const f32x4 gn = *(const f32x4*)(IN_F(3) + D + c0), s1 = *(const f32x4*)(m1 + 1024 + c0), s0 = *(const f32x4*)(m1 + c0);
#pragma unroll
                for (int i = 0; i < 4; ++i) { gm[4 * j + i] = gn[i] * (1.f + s1[i]); sh[4 * j + i] = s0[i]; } } }
        u32x2 nv[4], n0[4], n1[4];
#pragma unroll
        for (int j = 0; j < 4; ++j) { nv[j] = __builtin_nontemporal_load((const u32x2*)(xmid + (size_t)row0 * D + j * 256 + lane * 4)); n0[j] = __builtin_nontemporal_load((const u32x2*)(ys + (size_t)row0 * 2 * D + j * 256 + lane * 4)); n1[j] = __builtin_nontemporal_load((const u32x2*)(ys + (size_t)row0 * 2 * D + D + j * 256 + lane * 4)); }
#pragma unroll 1
        for (int k = 0; k < 16; ++k) { const int row = row0 + k, nrow = row0 + (k < 15 ? k + 1 : k); float v[16];
#pragma unroll
            for (int j = 0; j < 4; ++j) {
                const float a0 = __uint_as_float(nv[j][0] << 16), a1 = __uint_as_float(nv[j][0] & 0xffff0000u), a2 = __uint_as_float(nv[j][1] << 16), a3 = __uint_as_float(nv[j][1] & 0xffff0000u);
                const float p0 = __uint_as_float(n0[j][0] << 16), p1 = __uint_as_float(n0[j][0] & 0xffff0000u), p2 = __uint_as_float(n0[j][1] << 16), p3 = __uint_as_float(n0[j][1] & 0xffff0000u);
                const float q0 = __uint_as_float(n1[j][0] << 16), q1 = __uint_as_float(n1[j][0] & 0xffff0000u), q2 = __uint_as_float(n1[j][1] << 16), q3 = __uint_as_float(n1[j][1] & 0xffff0000u);
                v[4 * j] = a0 + gt[4 * j] * (p0 + q0); v[4 * j + 1] = a1 + gt[4 * j + 1] * (p1 + q1); v[4 * j + 2] = a2 + gt[4 * j + 2] * (p2 + q2); v[4 * j + 3] = a3 + gt[4 * j + 3] * (p3 + q3); }
#pragma unroll
            for (int j = 0; j < 4; ++j) { nv[j] = __builtin_nontemporal_load((const u32x2*)(xmid + (size_t)nrow * D + j * 256 + lane * 4)); n0[j] = __builtin_nontemporal_load((const u32x2*)(ys + (size_t)nrow * 2 * D + j * 256 + lane * 4)); n1[j] = __builtin_nontemporal_load((const u32x2*)(ys + (size_t)nrow * 2 * D + D + j * 256 + lane * 4)); }
            if (layer == 0) {
                row_store_bf16(WSP(bf16_t, WS_X2) + (size_t)row * D, lane, v);
                float s_ = 0.f;
#pragma unroll
                for (int i = 0; i < 16; ++i) s_ += v[i] * v[i];
                const float rstd = rsqrtf(wave_sum(s_) * (1.f / 1024.f) + EPS);
#pragma unroll
                for (int i = 0; i < 16; ++i) v[i] = v[i] * rstd * gm[i] + sh[i];
                if (RNN_FP8) {
#pragma unroll
                    for (int j = 0; j < 4; ++j) *(unsigned*)(WSP(unsigned char, WS_HB) + (size_t)row * D + j * 256 + lane * 4) = pk4_fp8_(v[4 * j] * F8_SH, v[4 * j + 1] * F8_SH, v[4 * j + 2] * F8_SH, v[4 * j + 3] * F8_SH); }
                else row_store_bf16(WSP(bf16_t, WS_HB) + (size_t)row * D, lane, v);
            } else {
#pragma unroll
                for (int j = 0; j < 4; ++j) { f32x4 o = {v[4 * j], v[4 * j + 1], v[4 * j + 2], v[4 * j + 3]}; __builtin_nontemporal_store(o, (f32x4*)(p.out + (size_t)row * D + j * 256 + lane * 4)); }
            }
        } }
}

struct FRin { const Params& p;
    __device__ __forceinline__ int nunits() const { return T / 8; }
    __device__ __forceinline__ void prep(int, int*) const {}
    __device__ __forceinline__ float a(int u, const int*, int r, int k) const { return bf2f(WSP(const bf16_t, WS_HB)[(size_t)(u * 8 + r) * D + k]); }
    __device__ __forceinline__ float b(int, const int*, int k, int n) const { return IN_F(15)[(size_t)k * 2048 + n]; }
    __device__ __forceinline__ void epi(int u, const int*, const float* Cs) const {
        bf16_t* gg = WSP(bf16_t, WS_GG); bf16_t* xb = WSP(bf16_t, WS_X1);
        for (int i = otid(); i < 8 * 2048; i += 512) { const int r = i >> 11, n = i & 2047, row = u * 8 + r;
            if (n < 1024) gg[(size_t)row * D + n] = f2bf(gelu_tanh(Cs[i])); else xb[(size_t)row * D + n - 1024] = f2bf(Cs[i]); }
    }
};
__device__ __forceinline__ void ph_conv(const Params& p) {
    const bf16_t* xb = WSP(const bf16_t, WS_X1); bf16_t* xc = WSP(bf16_t, WS_H2);
    const float* cw = IN_F(16); const float* cb = IN_F(17);
    for (int it = blockIdx.x * 512 + otid(); it < (T / 16) * 128; it += gridDim.x * 512) {
        const int cg = it & 127, rb = it >> 7, c0 = cg * 8, row0 = rb * 16, s0 = row0 & 2047;
        float w[4][8], bias[8];
#pragma unroll
        for (int k = 0; k < 4; ++k) { const f32x4 a = *(const f32x4*)(cw + k * D + c0), b2 = *(const f32x4*)(cw + k * D + c0 + 4);
#pragma unroll
            for (int j = 0; j < 4; ++j) { w[k][j] = a[j]; w[k][4 + j] = b2[j]; } }
        { const f32x4 a = *(const f32x4*)(cb + c0), b2 = *(const f32x4*)(cb + c0 + 4);
#pragma unroll
          for (int j = 0; j < 4; ++j) { bias[j] = a[j]; bias[4 + j] = b2[j]; } }
        u32x4 win[19];
#pragma unroll
        for (int r = 0; r < 19; ++r) { const int ss = s0 + r - 2; win[r] = (ss >= 0 && ss < SQ) ? *(const u32x4*)(xb + (size_t)(row0 + r - 2) * D + c0) : (u32x4){0u, 0u, 0u, 0u}; }
#pragma unroll
        for (int r = 0; r < 16; ++r) { float a[8];
#pragma unroll
            for (int j = 0; j < 8; ++j) a[j] = bias[j];
#pragma unroll
            for (int k = 0; k < 4; ++k)
#pragma unroll
                for (int q = 0; q < 4; ++q) { const unsigned x = win[r + k][q]; a[2 * q] += __uint_as_float(x << 16) * w[k][2 * q]; a[2 * q + 1] += __uint_as_float(x & 0xffff0000u) * w[k][2 * q + 1]; }
            u32x4 o; o[0] = pk2(a[0], a[1]); o[1] = pk2(a[2], a[3]); o[2] = pk2(a[4], a[5]); o[3] = pk2(a[6], a[7]);
            *(u32x4*)(xc + (size_t)(row0 + r) * D + c0) = o; }
    }
}
struct FGate { const Params& p;
    __device__ __forceinline__ int nunits() const { return (T / 8) * 4; }
    __device__ __forceinline__ void prep(int, int*) const {}
    __device__ __forceinline__ float a(int u, const int*, int r, int k) const { const int n = u & 3, rg = u >> 2; return bf2f(WSP(const bf16_t, WS_H2)[(size_t)(rg * 8 + r) * D + n * 256 + k]); }
    __device__ __forceinline__ float b(int u, const int*, int k, int j) const { const int n = u & 3, gate = j >> 8, e = j & 255;
        const float* W = gate == 0 ? IN_F(19) : gate == 1 ? IN_F(21) : gate == 2 ? IN_F(24) : IN_F(26);
        return W[((size_t)n * 256 + k) * 256 + e]; }
    __device__ __forceinline__ void epi(int u, const int*, const float* Cs) const {
        const int n = u & 3, rg = u >> 2;
        float* af = WSP(float, WS_AF); bf16_t* bxf = WSP(bf16_t, WS_BXF); float* ab = WSP(float, WS_AB); bf16_t* bxb = WSP(bf16_t, WS_BXB);
        const bf16_t* xc = WSP(const bf16_t, WS_H2);
        for (int i = otid(); i < 8 * 256; i += 512) { const int r = i >> 8, e = i & 255, row = rg * 8 + r, c = n * 256 + e, s = row & 2047;
            const float x = bf2f(xc[(size_t)row * D + c]);
            const float rf = sigmoidf_(Cs[r * 1024 + e] + IN_F(20)[c]), jf = sigmoidf_(Cs[r * 1024 + 256 + e] + IN_F(22)[c]);
            const float rb = sigmoidf_(Cs[r * 1024 + 512 + e] + IN_F(25)[c]), jb = sigmoidf_(Cs[r * 1024 + 768 + e] + IN_F(27)[c]);
            const float laf = -8.f * rf * log1pf(expf(-IN_F(18)[c])), lab = -8.f * rb * log1pf(expf(-IN_F(23)[c]));
            const float mf = (s == 0) ? 1.f : sqrtf(-expm1f(2.f * laf)), mb = (s == SQ - 1) ? 1.f : sqrtf(-expm1f(2.f * lab));
            const size_t o = (size_t)row * D + c;
            af[o] = expf(laf); bxf[o] = f2bf(mf * jf * x); ab[o] = expf(lab); bxb[o] = f2bf(mb * jb * x); }
    }
};
__device__ __forceinline__ void ph_scan(const Params& p) {
    float* af = WSP(float, WS_AF); const bf16_t* bxf = WSP(const bf16_t, WS_BXF); const float* ab = WSP(const float, WS_AB); const bf16_t* bxb = WSP(const bf16_t, WS_BXB);
    bf16_t* gy = WSP(bf16_t, WS_GG);
    const int wave = otid() >> 6, lane = otid() & 63;
    if (wave == 0)
    for (int u = blockIdx.x; u < 256; u += gridDim.x) { const int b = u >> 4, c = (u & 15) * 64 + lane;
        const size_t base = (size_t)b * SQ * D + c; float h = 0.f;
#pragma unroll 8
        for (int t = 0; t < SQ; ++t) { const size_t o = base + (size_t)t * D; h = af[o] * h + bf2f(bxf[o]); af[o] = h; }
        h = 0.f;
#pragma unroll 8
        for (int t = SQ - 1; t >= 0; --t) { const size_t o = base + (size_t)t * D; h = ab[o] * h + bf2f(bxb[o]); gy[o] = f2bf(bf2f(gy[o]) * (af[o] + h)); }
    }
}

#define LAS __attribute__((address_space(3)))
typedef short bf16x8 __attribute__((ext_vector_type(8)));
namespace g8 {
constexpr int BM = 256, BK = 64, HALF = 128, HTB = HALF * BK * 2, STAGE_BYTES = 8 * HTB;
__host__ __device__ __forceinline__ int lds_byte(int r, int c) { const int st = (r >> 4) * 2 + (c >> 5), rr = r & 15, cc = c & 31, ob = rr * 64 + cc * 2; return st * 1024 + (ob ^ (((ob >> 9) & 1) << 5)); }
__host__ __device__ __forceinline__ void stage_rc(int b, int& R, int& C) { const int st = b / 1024, sb = b % 1024, swz = sb ^ (((sb >> 9) & 1) << 5); R = (st >> 1) * 16 + swz / 64; C = (st & 1) * 32 + (swz % 64) / 2; }
__host__ __device__ __forceinline__ int perm32(int rho) { const int n = rho >> 4, i = rho & 15; return 8 * (i >> 2) + 4 * n + (i & 3); }

struct Unit { const char* a; const char* b; const int* rows; int nvalid; int pm, pn, e, row0; };

__device__ __forceinline__ unsigned cvt_pk_bf16(float lo, float hi) { unsigned r; asm volatile("v_cvt_pk_bf16_f32 %0, %1, %2" : "=v"(r) : "v"(lo), "v"(hi)); return r; }

template <class Epi, class Sched, bool GATHER, bool FP8 = false>
__device__ __forceinline__ void gemm_phase(LAS unsigned char* lds, const int KB, const int ldaB, const Sched& S, const Epi& E) {
    int tid_ = otid();
    const int tid = tid_, wid = __builtin_amdgcn_readfirstlane(tid >> 6), lane = tid & 63, wr = wid >> 2, wc = wid & 3, fr = lane & 15, fq = lane >> 4;
    const int nt = KB / 128;
    int Rr[2], Cc[2]; unsigned voffB[2];
#pragma unroll
    for (int i = 0; i < 2; ++i) { int R, C; stage_rc(tid * 16 + i * 8192, R, C); const int Rb = (R & ~31) + perm32(R & 31); Rr[i] = R; Cc[i] = C; voffB[i] = (unsigned)(Rb * KB + C * 2); }
    const size_t kstep = (size_t)(BK * 2);
    const size_t hstep = (size_t)HALF * KB;
    const unsigned ldsw = (unsigned)wid * 1024u;
    const int aoff = lds_byte(wr * 64 + fr, fq * 8), boff = lds_byte(wc * 32 + fr, fq * 8);
#define G8_SA(b, h) (((b) * 2 + (h)) * HTB)
#define G8_SB(b, h) ((4 + (b) * 2 + (h)) * HTB)
#define G8_STAGE(bufoff, gbase, voff) do { _Pragma("unroll") for (int _i = 0; _i < 2; ++_i) \
        __builtin_amdgcn_global_load_lds((const unsigned*)((const char*)(gbase) + (voff)[_i]), (LAS unsigned*)(lds + (bufoff) + ldsw + _i * 8192), 16, 0, 0); } while (0)
#define G8_LD8(addr) __builtin_shufflevector(*(const LAS v4i_*)(addr), *(const LAS v4i_*)((addr) + 1024), 0, 1, 2, 3, 4, 5, 6, 7)
#define G8_LDA(dst, b, h) do { _Pragma("unroll") for (int m = 0; m < 4; ++m) dst[m] = G8_LD8(lds + G8_SA(b, h) + aoff + m * 2048); } while (0)
#define G8_LDB(dst, b, h) do { _Pragma("unroll") for (int n = 0; n < 2; ++n) dst[n] = G8_LD8(lds + G8_SB(b, h) + boff + n * 2048); } while (0)
#define G8_H0(x) __builtin_bit_cast(bf16x8, __builtin_shufflevector(x, x, 0, 1, 2, 3))
#define G8_H1(x) __builtin_bit_cast(bf16x8, __builtin_shufflevector(x, x, 4, 5, 6, 7))
#define G8_MMA(ai, bj, At, Bt) do { __builtin_amdgcn_s_setprio(1); _Pragma("unroll") for (int m = 0; m < 4; ++m) _Pragma("unroll") for (int n = 0; n < 2; ++n) { \
        if constexpr (FP8) acc[ai][bj][m][n] = __builtin_amdgcn_mfma_scale_f32_16x16x128_f8f6f4(Bt[n], At[m], acc[ai][bj][m][n], 0, 0, 0, 127, 0, 127); \
        else { acc[ai][bj][m][n] = __builtin_amdgcn_mfma_f32_16x16x32_bf16(G8_H0(Bt[n]), G8_H0(At[m]), acc[ai][bj][m][n], 0, 0, 0); \
               acc[ai][bj][m][n] = __builtin_amdgcn_mfma_f32_16x16x32_bf16(G8_H1(Bt[n]), G8_H1(At[m]), acc[ai][bj][m][n], 0, 0, 0); } } \
        __builtin_amdgcn_s_setprio(0); } while (0)
#define G8_WAIT_V(n) asm volatile("s_waitcnt vmcnt(" #n ")" ::: "memory")
#define G8_WAIT_L(n) asm volatile("s_waitcnt lgkmcnt(" #n ")" ::: "memory")
#define G8_BAR __builtin_amdgcn_s_barrier()
#define G8_SCHED __builtin_amdgcn_sched_barrier(0)
#define G8_AOFF(dst, u) do { _Pragma("unroll") for (int h = 0; h < 2; ++h) _Pragma("unroll") for (int i = 0; i < 2; ++i) { const int rl = h * HALF + Rr[i]; \
        if constexpr (GATHER) { const int rr = (rl < (u).nvalid) ? (u).rows[rl] : (u).rows[0]; dst[h][i] = (unsigned)(rr * ldaB + Cc[i] * 2); } \
        else dst[h][i] = (unsigned)(rl * ldaB + Cc[i] * 2); } } while (0)
    Unit cur, nxt; int ui = 0;
    if (!S.next(0, cur)) return;
    f32x4 acc[2][2][4][2];
#pragma unroll
    for (int a = 0; a < 2; ++a)
#pragma unroll
        for (int b = 0; b < 2; ++b)
#pragma unroll
            for (int m = 0; m < 4; ++m)
#pragma unroll
                for (int n = 0; n < 2; ++n) acc[a][b][m][n] = (f32x4){0.f, 0.f, 0.f, 0.f};
    typedef int v8i_ __attribute__((ext_vector_type(8))); typedef int v4i_ __attribute__((ext_vector_type(4)));
    v8i_ At[4], B0[2], B1[2];
    unsigned vA[2][2];
    LAS int* xr = (LAS int*)(lds + 131072 + 2048 + wid * 256);
    G8_AOFF(vA, cur);
    const char* cA = cur.a; const char* cB = cur.b;
    G8_STAGE(G8_SB(0, 0), cB, voffB); G8_STAGE(G8_SB(0, 1), cB + hstep, voffB); G8_STAGE(G8_SA(0, 0), cA, vA[0]); G8_STAGE(G8_SA(0, 1), cA, vA[1]);
    if (wr == 1) G8_BAR;
    G8_WAIT_V(2); G8_BAR;
    G8_STAGE(G8_SB(1, 0), cB + kstep, voffB); G8_STAGE(G8_SA(1, 0), cA + kstep, vA[0]); G8_STAGE(G8_SB(1, 1), cB + hstep + kstep, voffB);
    G8_WAIT_V(6); G8_BAR;
    for (;;) {
        const bool has_next = S.next(ui + 1, nxt);
        const char* nA = has_next ? nxt.a : cA; const char* nB = has_next ? nxt.b : cB;
#pragma unroll 1
        for (int t = 0; t < nt; t += 2) {
            const bool last = (t == nt - 2);
            const char* a1 = cA + (size_t)(t + 1) * kstep;
            const char* a2 = last ? nA : cA + (size_t)(t + 2) * kstep; const char* b2 = last ? nB : cB + (size_t)(t + 2) * kstep;
            const char* a3 = a2 + kstep; const char* b3 = b2 + kstep;
            G8_LDB(B0, 0, 0); G8_LDB(B1, 0, 1); G8_SCHED; G8_LDA(At, 0, 0); G8_STAGE(G8_SA(1, 1), a1, vA[1]);
            if constexpr (GATHER) {
                if (t == 0 && has_next) { const int hi_ = lane >> 4, h_ = hi_ >> 1, i_ = hi_ & 1; int rl = h_ * HALF + ((wid + 8 * i_) >> 1) * 16 + (lane & 15); rl = rl < nxt.nvalid ? rl : 0;
                    __builtin_amdgcn_global_load_lds((const unsigned*)(nxt.rows + rl), (LAS unsigned*)xr, 4, 0, 0); }
            }
            G8_WAIT_V(8); G8_WAIT_L(0); G8_BAR; G8_MMA(0, 0, At, B0); G8_MMA(0, 1, At, B1); G8_BAR; G8_SCHED;
            if constexpr (!GATHER && FP8) {
                if (last && has_next) { const int t2_ = otid();
#pragma unroll
                    for (int i = 0; i < 2; ++i) { int R_, C_; stage_rc(t2_ * 16 + i * 8192, R_, C_); const int Rb_ = (R_ & ~31) + perm32(R_ & 31);
                        vA[0][i] = (unsigned)(R_ * ldaB + C_ * 2); vA[1][i] = (unsigned)((HALF + R_) * ldaB + C_ * 2); voffB[i] = (unsigned)(Rb_ * KB + C_ * 2); } }
            }
            if constexpr (GATHER) {
                if (last && has_next) {
#pragma unroll
                    for (int h = 0; h < 2; ++h)
#pragma unroll
                        for (int i = 0; i < 2; ++i) vA[h][i] = (unsigned)(xr[(h * 2 + i) * 16 + (lane >> 2)] * ldaB + Cc[i] * 2); }
            }
            G8_LDA(At, 0, 1); G8_STAGE(G8_SB(0, 0), b2, voffB); G8_STAGE(G8_SB(0, 1), b2 + hstep, voffB); G8_STAGE(G8_SA(0, 0), a2, vA[0]);
            G8_WAIT_V(8); G8_WAIT_L(0); G8_BAR; G8_MMA(1, 0, At, B0); G8_MMA(1, 1, At, B1); G8_BAR; G8_SCHED;
            G8_LDB(B0, 1, 0); G8_LDB(B1, 1, 1); G8_SCHED; G8_LDA(At, 1, 0); G8_STAGE(G8_SA(0, 1), a2, vA[1]);
            G8_WAIT_V(8); G8_WAIT_L(0); G8_BAR; G8_MMA(0, 0, At, B0); G8_MMA(0, 1, At, B1); G8_BAR; G8_SCHED;
            G8_LDA(At, 1, 1); G8_STAGE(G8_SB(1, 0), b3, voffB); G8_STAGE(G8_SB(1, 1), b3 + hstep, voffB); G8_STAGE(G8_SA(1, 0), a3, vA[0]);
            G8_WAIT_V(8); G8_WAIT_L(0); G8_BAR; G8_MMA(1, 0, At, B0); G8_MMA(1, 1, At, B1); G8_BAR; G8_SCHED;
        }
        if (wr == 0) G8_BAR;
        E(acc, cur, wr, wc, fr, fq);
        if (!has_next) break;
#pragma unroll
        for (int a = 0; a < 2; ++a)
#pragma unroll
            for (int b = 0; b < 2; ++b)
#pragma unroll
                for (int m = 0; m < 4; ++m)
#pragma unroll
                    for (int n = 0; n < 2; ++n) acc[a][b][m][n] = (f32x4){0.f, 0.f, 0.f, 0.f};
        cur = nxt; cA = nA; cB = nB; ++ui;
        if (wr == 1) G8_BAR;
    }
    G8_WAIT_V(0);
    G8_BAR;
#undef G8_SA
#undef G8_SB
#undef G8_STAGE
#undef G8_LD8
#undef G8_H0
#undef G8_H1
#undef G8_LDA
#undef G8_LDB
#undef G8_MMA
#undef G8_AOFF
}

struct DenseSched { const char* A; const char* B; int nM, nN, nwg, G, c, lda, K;
    __device__ __forceinline__ void init(const void* A_, int lda_, const void* B_, int K_, int M, int N) { A = (const char*)A_; B = (const char*)B_; lda = lda_; K = K_; nM = M / 256; nN = N / 256; nwg = nM * nN; G = gridDim.x; c = blockIdx.x; }
    __device__ __forceinline__ bool next(int i, Unit& u) const {
        const long L = (long)i * G + c; if (L >= nwg) return false;
        int wgid = (int)L; { const int q = nwg / 8, r = nwg % 8, xcd = wgid % 8, off = wgid / 8; wgid = (xcd < r ? xcd * (q + 1) : r * (q + 1) + (xcd - r) * q) + off; }
        const int nig = 8 * nN, gid = wgid / nig, fm = gid * 8, gsz = (nM - fm) < 8 ? (nM - fm) : 8;
        u.pm = fm + ((wgid % nig) % gsz); u.pn = (wgid % nig) / gsz; u.e = 0; u.row0 = u.pm * 256; u.rows = nullptr; u.nvalid = 256;
        u.a = A + (size_t)u.pm * 256 * lda * 2; u.b = B + (size_t)u.pn * 256 * K * 2; return true; }
};
struct MoeSched { const LAS int* tab; const char* A; const char* B; const int* tok; int ldaB, KB  , G, vc; size_t bstride; bool gather;
    __device__ __forceinline__ bool next(int i, Unit& u) const {
        const int L = i * G + vc; const int ntile = tab[32]; if (L >= ntile * 4) return false;
        const int tl = L >> 2; u.pn = L & 3;
        const int e = __builtin_amdgcn_readfirstlane(tab[192 + tl]);
        const int t0 = __builtin_amdgcn_readfirstlane(tl - tab[e]), segr = __builtin_amdgcn_readfirstlane(tab[128 + e]), cn = __builtin_amdgcn_readfirstlane(tab[64 + e]);
        u.e = e; u.pm = t0; u.row0 = segr + t0 * 256; const int nv = cn - t0 * 256; u.nvalid = nv < 256 ? nv : 256;
        u.rows = tok + (size_t)e * T + t0 * 256;
        u.a = gather ? A : A + (size_t)u.row0 * ldaB; u.b = B + (size_t)e * bstride + (size_t)u.pn * 256 * KB; return true; }
};
__device__ __forceinline__ void moe_tables(const Params& p, int layer, LAS int* tab) {
    __syncthreads();
    if (otid() < 32) { const unsigned* cnt = WSP(const unsigned, WS_CTL) + CW_CNT + layer * 32; const int e = otid();
        const int c = (int)__hip_atomic_load(cnt + e, __ATOMIC_RELAXED, __HIP_MEMORY_SCOPE_AGENT), nt_ = (c + 255) >> 8; int incl = nt_;
#pragma unroll
        for (int o = 1; o < 32; o <<= 1) { const int v = __shfl_up(incl, o, 32); if (e >= o) incl += v; }
        const int tp = incl - nt_; tab[e] = tp; tab[64 + e] = c; tab[128 + e] = tp << 8; if (e == 31) tab[32] = incl; }
    __syncthreads();
    { const int t = otid(); if (t < 320) { int e = 0;
#pragma unroll 1
        for (int q = 1; q < 32; ++q) e += (tab[q] <= t) ? 1 : 0;
        tab[192 + t] = e; } }
    __syncthreads();
}

__device__ __forceinline__ float frcp(float x) { return __builtin_amdgcn_rcpf(x); }
__device__ __forceinline__ float fsig(float x) { return frcp(1.f + __builtin_amdgcn_exp2f(-1.4426950408889634f * x)); }
__device__ __forceinline__ float fast_tanh(float x) { const float e = __builtin_amdgcn_exp2f(2.885390081777927f * x); return 1.f - 2.f * frcp(e + 1.f); }
__device__ __forceinline__ float gelu_fast(float x) { const float u = 0.7978845608028654f * (x + 0.044715f * x * x * x); return 0.5f * x * (1.f + fast_tanh(u)); }
template <bool RF32> struct EpiRes { const void* resid; const float* gate; bf16_t* out; float inv;
    __device__ __forceinline__ void operator()(const f32x4 (&acc)[2][2][4][2], const Unit& u, int wr, int wc, int fr, int fq) const {
        const int b = u.row0 >> 11; f32x4 gv[2][2];
#pragma unroll
        for (int bj = 0; bj < 2; ++bj)
#pragma unroll
            for (int n = 0; n < 2; ++n) gv[bj][n] = *(const f32x4*)(gate + (size_t)b * 6144 + u.pn * 256 + bj * 128 + wc * 32 + 8 * fq + 4 * n) * inv;
        const size_t o0 = ((size_t)u.row0 + wr * 64 + fr) * D + u.pn * 256 + wc * 32 + 8 * fq;
#pragma unroll
        for (int ai = 0; ai < 2; ++ai) {
            f32x4 r0[4][2], r1[4][2];
#pragma unroll
            for (int m = 0; m < 4; ++m)
#pragma unroll
                for (int bj = 0; bj < 2; ++bj) { const size_t o = o0 + (size_t)(ai * 128 + m * 16) * D + bj * 128;
                    if constexpr (RF32) { r0[m][bj] = __builtin_nontemporal_load((const f32x4*)((const float*)resid + o)); r1[m][bj] = __builtin_nontemporal_load((const f32x4*)((const float*)resid + o + 4)); }
                    else { const u32x4 x = *(const u32x4*)((const bf16_t*)resid + o);
                        r0[m][bj] = (f32x4){__uint_as_float(x[0] << 16), __uint_as_float(x[0] & 0xffff0000u), __uint_as_float(x[1] << 16), __uint_as_float(x[1] & 0xffff0000u)};
                        r1[m][bj] = (f32x4){__uint_as_float(x[2] << 16), __uint_as_float(x[2] & 0xffff0000u), __uint_as_float(x[3] << 16), __uint_as_float(x[3] & 0xffff0000u)}; } }
#pragma unroll
            for (int m = 0; m < 4; ++m)
#pragma unroll
                for (int bj = 0; bj < 2; ++bj) { const size_t o = o0 + (size_t)(ai * 128 + m * 16) * D + bj * 128;
                    const f32x4 v0 = r0[m][bj] + gv[bj][0] * acc[ai][bj][m][0], v1 = r1[m][bj] + gv[bj][1] * acc[ai][bj][m][1];
                    u32x4 w; w[0] = cvt_pk_bf16(v0[0], v0[1]); w[1] = cvt_pk_bf16(v0[2], v0[3]); w[2] = cvt_pk_bf16(v1[0], v1[1]); w[3] = cvt_pk_bf16(v1[2], v1[3]);
                    *(u32x4*)(out + o) = w; }
            asm volatile("" ::: "memory"); }
    }
};
struct EpiRin { bf16_t* gg; bf16_t* xb; float inv;
    __device__ __forceinline__ void operator()(const f32x4 (&acc)[2][2][4][2], const Unit& u, int wr, int wc, int fr, int fq) const {
        const bool isg = u.pn < 4; bf16_t* dst = isg ? gg : xb; const int cbase = (u.pn & 3) * 256;
#pragma unroll
        for (int ai = 0; ai < 2; ++ai)
#pragma unroll
            for (int m = 0; m < 4; ++m) { const size_t row = (size_t)u.row0 + ai * 128 + wr * 64 + m * 16 + fr;
#pragma unroll
                for (int bj = 0; bj < 2; ++bj) { f32x4 v0 = acc[ai][bj][m][0] * inv, v1 = acc[ai][bj][m][1] * inv;
                    if (isg) {
#pragma unroll
                        for (int j = 0; j < 4; ++j) { v0[j] = gelu_fast(v0[j]); v1[j] = gelu_fast(v1[j]); } }
                    u32x4 w; w[0] = cvt_pk_bf16(v0[0], v0[1]); w[1] = cvt_pk_bf16(v0[2], v0[3]); w[2] = cvt_pk_bf16(v1[0], v1[1]); w[3] = cvt_pk_bf16(v1[2], v1[3]);
                    *(u32x4*)(dst + row * D + cbase + bj * 128 + wc * 32 + 8 * fq) = w; }
                asm volatile("" ::: "memory"); }
    }
};
struct EpiGu { bf16_t* act; float inv;
    __device__ __forceinline__ void operator()(const f32x4 (&acc)[2][2][4][2], const Unit& u, int wr, int wc, int fr, int fq) const {
#pragma unroll
        for (int ai = 0; ai < 2; ++ai)
#pragma unroll
            for (int m = 0; m < 4; ++m) { const size_t row = (size_t)u.row0 + ai * 128 + wr * 64 + m * 16 + fr; float v[8];
#pragma unroll
                for (int n = 0; n < 2; ++n)
#pragma unroll
                    for (int j = 0; j < 4; ++j) { const float g = acc[ai][0][m][n][j] * inv, uu = acc[ai][1][m][n][j] * inv; v[4 * n + j] = g * uu * fsig(g); }
                u32x4 w; w[0] = cvt_pk_bf16(v[0], v[1]); w[1] = cvt_pk_bf16(v[2], v[3]); w[2] = cvt_pk_bf16(v[4], v[5]); w[3] = cvt_pk_bf16(v[6], v[7]);
                *(u32x4*)(act + row * DE + u.pn * 128 + wc * 32 + 8 * fq) = w;
                asm volatile("" ::: "memory"); }
    }
};
struct EpiDnLite { const int* dst; const float* wso; bf16_t* ys; float oscale;
    __device__ __forceinline__ void operator()(const f32x4 (&acc)[2][2][4][2], const Unit& u, int wr, int wc, int fr, int fq) const {
        const int* dp = dst + (size_t)u.e * T + u.pm * 256; const float* wp = wso + (size_t)u.e * T + u.pm * 256;
        const int cofs = u.pn * 256 + wc * 32 + 8 * fq;
#pragma unroll
        for (int ai = 0; ai < 2; ++ai)
#pragma unroll
            for (int m = 0; m < 4; ++m) { const int rl = ai * 128 + wr * 64 + m * 16 + fr;
                if (rl < u.nvalid) { const int d = dp[rl]; const float w = wp[rl] * oscale; bf16_t* orow = ys + (size_t)d * D + cofs;
#pragma unroll
                    for (int bj = 0; bj < 2; ++bj) { const f32x4 v0 = acc[ai][bj][m][0] * w, v1 = acc[ai][bj][m][1] * w;
                        u32x4 x; x[0] = cvt_pk_bf16(v0[0], v0[1]); x[1] = cvt_pk_bf16(v0[2], v0[3]); x[2] = cvt_pk_bf16(v1[0], v1[1]); x[3] = cvt_pk_bf16(v1[2], v1[3]);
                        *(u32x4*)(orow + bj * 128) = x; } }
                asm volatile("" ::: "memory"); }
    }
};
__device__ __forceinline__ unsigned pk4_fp8(float a, float b, float c, float d) {
    a = fminf(fmaxf(a, -448.f), 448.f); b = fminf(fmaxf(b, -448.f), 448.f); c = fminf(fmaxf(c, -448.f), 448.f); d = fminf(fmaxf(d, -448.f), 448.f);
    int r = 0; r = __builtin_amdgcn_cvt_pk_fp8_f32(a, b, r, false); r = __builtin_amdgcn_cvt_pk_fp8_f32(c, d, r, true); return (unsigned)r; }
struct EpiGu8 { unsigned char* act;
    __device__ __forceinline__ void operator()(const f32x4 (&acc)[2][2][4][2], const Unit& u, int wr, int wc, int fr, int fq) const {
        constexpr float inv = 1.f / (F8_SH * F8_SW);
#pragma unroll
        for (int ai = 0; ai < 2; ++ai)
#pragma unroll
            for (int m = 0; m < 4; ++m) { const size_t row = (size_t)u.row0 + ai * 128 + wr * 64 + m * 16 + fr; float v[8];
#pragma unroll
                for (int n = 0; n < 2; ++n)
#pragma unroll
                    for (int j = 0; j < 4; ++j) { const float g = acc[ai][0][m][n][j] * inv, uu = acc[ai][1][m][n][j] * inv; v[4 * n + j] = g * uu * fsig(g) * F8_SA; }
                u32x2 w; w[0] = pk4_fp8(v[0], v[1], v[2], v[3]); w[1] = pk4_fp8(v[4], v[5], v[6], v[7]);
                *(u32x2*)(act + row * DE + u.pn * 128 + wc * 32 + 8 * fq) = w;
                asm volatile("" ::: "memory"); }
    }
};
struct EpiDn { const int* dst; const float* wso; bf16_t* ys; float oscale;
    __device__ __forceinline__ void operator()(const f32x4 (&acc)[2][2][4][2], const Unit& u, int wr, int wc, int fr, int fq) const {
        const int* dp = dst + (size_t)u.e * T + u.pm * 256; const float* wp = wso + (size_t)u.e * T + u.pm * 256;
        const int cofs = u.pn * 256 + wc * 32 + 8 * fq;
        int dd[8]; float ww[8];
#pragma unroll
        for (int g = 0; g < 8; ++g) { const int rl = (g >> 2) * 128 + wr * 64 + (g & 3) * 16 + fr; const bool ok = rl < u.nvalid; dd[g] = ok ? dp[rl] : -1; ww[g] = ok ? wp[rl] * oscale : 0.f; }
#pragma unroll
        for (int g = 0; g < 8; ++g) { const int ai = g >> 2, m = g & 3;
            if (dd[g] >= 0) { bf16_t* orow = ys + (size_t)dd[g] * D + cofs; const float w = ww[g];
#pragma unroll
                for (int bj = 0; bj < 2; ++bj) { const f32x4 v0 = acc[ai][bj][m][0] * w, v1 = acc[ai][bj][m][1] * w;
                    u32x4 x; x[0] = cvt_pk_bf16(v0[0], v0[1]); x[1] = cvt_pk_bf16(v0[2], v0[3]); x[2] = cvt_pk_bf16(v1[0], v1[1]); x[3] = cvt_pk_bf16(v1[2], v1[3]);
                    *(u32x4*)(orow + bj * 128) = x; } } }
    }
};
__device__ __forceinline__ float quad_sum(float v) { v += __shfl_xor(v, 16); v += __shfl_xor(v, 32); return v; }
struct EpiLat { bf16_t* lat; float* ssqp; float* ropek; float* pessq; const float* cs; const float* sn; const float* knorm;
    __device__ __forceinline__ void operator()(const f32x4 (&acc)[2][2][4][2], const Unit& u, int wr, int wc, int fr, int fq) const {
        f32x4 cq[8], sq_[8];
        const bool pe_wave = (u.pn == 2 && wc == 0);
        if (pe_wave) {
#pragma unroll
            for (int g = 0; g < 8; ++g) { const size_t row = (size_t)u.row0 + (g >> 2) * 128 + wr * 64 + (g & 3) * 16 + fr; cq[g] = *(const f32x4*)(cs + row * 16 + 4 * fq); sq_[g] = *(const f32x4*)(sn + row * 16 + 4 * fq); } }
#pragma unroll
        for (int ai = 0; ai < 2; ++ai)
#pragma unroll
            for (int m = 0; m < 4; ++m) { const size_t row = (size_t)u.row0 + ai * 128 + wr * 64 + m * 16 + fr;
#pragma unroll
                for (int bj = 0; bj < 2; ++bj) { const f32x4 v0 = acc[ai][bj][m][0], v1 = acc[ai][bj][m][1]; const int col = u.pn * 256 + bj * 128 + wc * 32 + 8 * fq;
                    u32x4 w; w[0] = cvt_pk_bf16(v0[0], v0[1]); w[1] = cvt_pk_bf16(v0[2], v0[3]); w[2] = cvt_pk_bf16(v1[0], v1[1]); w[3] = cvt_pk_bf16(v1[2], v1[3]);
                    *(u32x4*)(lat + row * LATP + col) = w;
                    const int sl = u.pn * 2 + bj;
                    if (sl < 5) { float ss = 0.f;
#pragma unroll
                        for (int j = 0; j < 4; ++j) ss += v0[j] * v0[j] + v1[j] * v1[j];
                        ss = quad_sum(ss); if (fq == 0) ssqp[(size_t)(sl * 4 + wc) * T + row] = ss; }
                    else if (wc == 0) {
                        float ss = 0.f; f32x4 o1, o2; const f32x4 c4 = cq[ai * 4 + m], s4 = sq_[ai * 4 + m];
                        const f32x4 g1 = *(const f32x4*)(knorm + 64 + 4 * fq), g2 = *(const f32x4*)(knorm + 80 + 4 * fq);
#pragma unroll
                        for (int j = 0; j < 4; ++j) { ss += v0[j] * v0[j] + v1[j] * v1[j]; const float x1 = v0[j] * g1[j], x2 = v1[j] * g2[j]; o1[j] = x1 * c4[j] - x2 * s4[j]; o2[j] = x1 * s4[j] + x2 * c4[j]; }
                        ss = quad_sum(ss); if (fq == 0) pessq[row] = ss;
                        *(f32x4*)(ropek + row * 32 + 4 * fq) = o1; *(f32x4*)(ropek + row * 32 + 16 + 4 * fq) = o2; } }
                asm volatile("" ::: "memory"); }
    }
};
struct MlaXchg { LAS float* part; LAS float* rr; LAS float* pe; };
__device__ __forceinline__ MlaXchg mla_xchg(LAS unsigned char* lds) { MlaXchg x; x.part = (LAS float*)(lds + 131072 + 4096); x.rr = x.part + 2048; x.pe = x.rr + 256; return x; }
struct EpiQ { LAS unsigned char* lds; const float* ssqp; const float* qnorm; const float* cs; const float* sn; bf16_t* q;
    __device__ __forceinline__ void operator()(const f32x4 (&acc)[2][2][4][2], const Unit& u, int wr, int wc, int fr, int fq) const {
        const MlaXchg X = mla_xchg(lds); const int tid = otid();
        int lb = wr * 64 + fr; asm volatile("" : "+v"(lb));
        if (tid < 256) { float ss = 0.f;
#pragma unroll
            for (int sl = 0; sl < 12; ++sl) ss += ssqp[(size_t)sl * T + u.row0 + tid];
            X.rr[tid] = rsqrtf(ss * (1.f / QL) + EPS); }
        { LAS float* pw = X.part + wc * 512 + lb;
#pragma unroll
        for (int ai = 0; ai < 2; ++ai)
#pragma unroll
            for (int m = 0; m < 4; ++m)
#pragma unroll
                for (int bj = 0; bj < 2; ++bj) { const f32x4 v0 = acc[ai][bj][m][0], v1 = acc[ai][bj][m][1]; float ss = 0.f;
#pragma unroll
                    for (int j = 0; j < 4; ++j) ss += v0[j] * v0[j] + v1[j] * v1[j];
                    ss = quad_sum(ss); if (fq == 0) pw[bj * 256 + ai * 128 + m * 16] = ss; } }
        asm volatile("s_waitcnt lgkmcnt(0)" ::: "memory"); __builtin_amdgcn_s_barrier();
        if (wc == 3) return;
        const int b = u.row0 >> 11; const LAS float* pr = X.part + lb; const LAS float* prr = X.rr + lb;
#pragma unroll
        for (int ai = 0; ai < 2; ++ai) {
        f32x4 cq[4], sq_[4];
        if (wc == 2) {
#pragma unroll
            for (int g = 0; g < 4; ++g) { const size_t row = (size_t)u.row0 + ai * 128 + g * 16 + lb; cq[g] = *(const f32x4*)(cs + row * 16 + 4 * fq); sq_[g] = *(const f32x4*)(sn + row * 16 + 4 * fq); } }
#pragma unroll
            for (int m = 0; m < 4; ++m) { const int rl = ai * 128 + m * 16 + lb; const int row = u.row0 + rl, sq = row & 2047; const float r = prr[ai * 128 + m * 16];
#pragma unroll
                for (int bj = 0; bj < 2; ++bj) { const float tot = pr[(0 * 2 + bj) * 256 + ai * 128 + m * 16] + pr[(1 * 2 + bj) * 256 + ai * 128 + m * 16] + pr[(2 * 2 + bj) * 256 + ai * 128 + m * 16];
                    const float sc = r * rsqrtf(r * r * tot * (1.f / 96.f) + EPS) * QSCALE; const int h = u.pn * 2 + bj;
                    bf16_t* qp = q + ((size_t)(b * NH + h) * SQ + sq) * 96; const f32x4 v0 = acc[ai][bj][m][0], v1 = acc[ai][bj][m][1];
                    if (wc < 2) { const int d0 = wc * 32 + 8 * fq; const f32x4 g0 = *(const f32x4*)(qnorm + d0), g1 = *(const f32x4*)(qnorm + d0 + 4);
                        u32x4 w; w[0] = cvt_pk_bf16(v0[0] * sc * g0[0], v0[1] * sc * g0[1]); w[1] = cvt_pk_bf16(v0[2] * sc * g0[2], v0[3] * sc * g0[3]);
                        w[2] = cvt_pk_bf16(v1[0] * sc * g1[0], v1[1] * sc * g1[1]); w[3] = cvt_pk_bf16(v1[2] * sc * g1[2], v1[3] * sc * g1[3]);
                        *(u32x4*)(qp + d0) = w; }
                    else { const f32x4 c4 = cq[m], s4 = sq_[m];
                        const f32x4 g1 = *(const f32x4*)(qnorm + 64 + 4 * fq), g2 = *(const f32x4*)(qnorm + 80 + 4 * fq); float o1[4], o2[4];
#pragma unroll
                        for (int j = 0; j < 4; ++j) { const float x1 = v0[j] * sc * g1[j], x2 = v1[j] * sc * g2[j]; o1[j] = x1 * c4[j] - x2 * s4[j]; o2[j] = x1 * s4[j] + x2 * c4[j]; }
                        u32x2 w1, w2; w1[0] = cvt_pk_bf16(o1[0], o1[1]); w1[1] = cvt_pk_bf16(o1[2], o1[3]); w2[0] = cvt_pk_bf16(o2[0], o2[1]); w2[1] = cvt_pk_bf16(o2[2], o2[3]);
                        *(u32x2*)(qp + 64 + 4 * fq) = w1; *(u32x2*)(qp + 80 + 4 * fq) = w2; } }
                asm volatile("" ::: "memory"); } }
    }
};
struct EpiKV { LAS unsigned char* lds; const float* ssqp; const float* pessq; const float* ropek; const float* knorm; bf16_t* k; bf16_t* v;
    __device__ __forceinline__ void operator()(const f32x4 (&acc)[2][2][4][2], const Unit& u, int wr, int wc, int fr, int fq) const {
        const MlaXchg X = mla_xchg(lds); const int tid = otid();
        int lb = wr * 64 + fr; asm volatile("" : "+v"(lb));
        if (tid < 256) { float ss = 0.f;
#pragma unroll
            for (int sl = 12; sl < 20; ++sl) ss += ssqp[(size_t)sl * T + u.row0 + tid];
            X.rr[tid] = rsqrtf(ss * (1.f / KVL) + EPS); X.pe[tid] = pessq[u.row0 + tid]; }
        if (wc < 2) { LAS float* pw = X.part + wc * 512 + lb;
#pragma unroll
            for (int ai = 0; ai < 2; ++ai)
#pragma unroll
                for (int m = 0; m < 4; ++m)
#pragma unroll
                    for (int bj = 0; bj < 2; ++bj) { const f32x4 v0 = acc[ai][bj][m][0], v1 = acc[ai][bj][m][1]; float ss = 0.f;
#pragma unroll
                        for (int j = 0; j < 4; ++j) ss += v0[j] * v0[j] + v1[j] * v1[j];
                        ss = quad_sum(ss); if (fq == 0) pw[bj * 256 + ai * 128 + m * 16] = ss; } }
        asm volatile("s_waitcnt lgkmcnt(0)" ::: "memory"); __builtin_amdgcn_s_barrier();
        const int b = u.row0 >> 11; const LAS float* pr = X.part + lb; const LAS float* prr = X.rr + lb; const LAS float* ppe = X.pe + lb;
        f32x4 rks[8];
        if (wc >= 2) {
#pragma unroll
            for (int g = 0; g < 8; ++g) rks[g] = *(const f32x4*)(ropek + (size_t)(u.row0 + (g >> 2) * 128 + (g & 3) * 16 + lb) * 32 + (wc - 2) * 16 + 4 * fq); }
#pragma unroll
        for (int ai = 0; ai < 2; ++ai)
#pragma unroll
            for (int m = 0; m < 4; ++m) { const int rl = ai * 128 + m * 16 + lb; const int row = u.row0 + rl, sq = row & 2047; const float r = prr[ai * 128 + m * 16], pes = ppe[ai * 128 + m * 16];
#pragma unroll
                for (int bj = 0; bj < 2; ++bj) { const float tot = pr[(0 * 2 + bj) * 256 + ai * 128 + m * 16] + pr[(1 * 2 + bj) * 256 + ai * 128 + m * 16];
                    const float rh = rsqrtf((r * r * tot + pes) * (1.f / 96.f) + EPS); const int h = u.pn * 2 + bj; const size_t hs = (size_t)(b * NH + h) * SQ + sq;
                    const f32x4 v0 = acc[ai][bj][m][0], v1 = acc[ai][bj][m][1];
                    if (wc < 2) { const int d0 = wc * 32 + 8 * fq; const float sc = r * rh; const f32x4 g0 = *(const f32x4*)(knorm + d0), g1 = *(const f32x4*)(knorm + d0 + 4);
                        u32x4 w; w[0] = cvt_pk_bf16(v0[0] * sc * g0[0], v0[1] * sc * g0[1]); w[1] = cvt_pk_bf16(v0[2] * sc * g0[2], v0[3] * sc * g0[3]);
                        w[2] = cvt_pk_bf16(v1[0] * sc * g1[0], v1[1] * sc * g1[1]); w[3] = cvt_pk_bf16(v1[2] * sc * g1[2], v1[3] * sc * g1[3]);
                        *(u32x4*)(k + kidx(b * NH + h, sq, d0)) = w; }
                    else { const int d0 = (wc - 2) * 32 + 8 * fq;
                        u32x4 w; w[0] = cvt_pk_bf16(v0[0] * r, v0[1] * r); w[1] = cvt_pk_bf16(v0[2] * r, v0[3] * r); w[2] = cvt_pk_bf16(v1[0] * r, v1[1] * r); w[3] = cvt_pk_bf16(v1[2] * r, v1[3] * r);
                        *(u32x4*)(v + vidx(b * NH + h, sq, d0)) = w;
                        const int e0 = (wc - 2) * 16 + 4 * fq; const f32x4 rk = rks[ai * 4 + m];
                        u32x2 w2; w2[0] = cvt_pk_bf16(rk[0] * rh, rk[1] * rh); w2[1] = cvt_pk_bf16(rk[2] * rh, rk[3] * rh);
                        *(u32x2*)(k + kidx(b * NH + h, sq, 64 + e0)) = w2; } }
                asm volatile("" ::: "memory"); }
    }
};
struct GateSched { const char* A; const char* B; int G, c;
    __device__ __forceinline__ bool next(int i, Unit& u) const {
        const int L = i * G + c; if (L >= 2048) return false;
        const int nb = L >> 9, r = L & 511; u.pm = r >> 2; u.pn = r & 3; u.e = nb; u.row0 = u.pm * 256; u.rows = nullptr; u.nvalid = 256;
        u.a = A + ((size_t)u.pm * 256 * 1024 + nb * 256) * 2; u.b = B + ((size_t)nb * 1024 + u.pn * 256) * 256 * 2; return true; }
};
struct EpiGate { const bf16_t* xc; const float* brf; const float* bif; const float* brb; const float* bib; const float* spl; unsigned* sf; unsigned* sb;
    __device__ __forceinline__ void operator()(const f32x4 (&acc)[2][2][4][2], const Unit& u, int wr, int wc, int fr, int fq) const {
        int lb = wr * 64 + fr; asm volatile("" : "+v"(lb));
        const int c0 = u.e * 256 + u.pn * 64 + wc * 16 + 4 * fq;
        const f32x4 b0 = *(const f32x4*)(brf + c0) * -1.4426950408889634f, b1 = *(const f32x4*)(bif + c0) * -1.4426950408889634f, b2 = *(const f32x4*)(brb + c0) * -1.4426950408889634f, b3 = *(const f32x4*)(bib + c0) * -1.4426950408889634f;
        const f32x4 pf = *(const f32x4*)(spl + c0), pb = *(const f32x4*)(spl + 1024 + c0);
        u32x2 xws[8];
#pragma unroll
        for (int g = 0; g < 8; ++g) xws[g] = *(const u32x2*)(xc + (size_t)(u.row0 + (g >> 2) * 128 + (g & 3) * 16 + lb) * D + c0);
#pragma unroll
        for (int ai = 0; ai < 2; ++ai)
#pragma unroll
            for (int m = 0; m < 4; ++m) { const int row = u.row0 + ai * 128 + m * 16 + lb, sq = row & 2047; const size_t o = (size_t)row * D + c0;
                const u32x2 xw = xws[ai * 4 + m]; const float x[4] = {__uint_as_float(xw[0] << 16), __uint_as_float(xw[0] & 0xffff0000u), __uint_as_float(xw[1] << 16), __uint_as_float(xw[1] & 0xffff0000u)};
                u32x4 wf, wb;
#pragma unroll
                for (int j = 0; j < 4; ++j) {
                    const float rf = frcp(1.f + __builtin_amdgcn_exp2f(acc[ai][0][m][0][j] + b0[j])), jf = frcp(1.f + __builtin_amdgcn_exp2f(acc[ai][0][m][1][j] + b1[j]));
                    const float rb = frcp(1.f + __builtin_amdgcn_exp2f(acc[ai][1][m][0][j] + b2[j])), jb = frcp(1.f + __builtin_amdgcn_exp2f(acc[ai][1][m][1][j] + b3[j]));
                    const float af = __builtin_amdgcn_exp2f(pf[j] * rf), ab = __builtin_amdgcn_exp2f(pb[j] * rb);
                    const float omf = 1.f - af, omb = 1.f - ab;
                    const float mf = (sq == 0) ? 1.f : __builtin_amdgcn_sqrtf(omf * (1.f + af)), mb = (sq == SQ - 1) ? 1.f : __builtin_amdgcn_sqrtf(omb * (1.f + ab));
                    wf[j] = cvt_pk_bf16(omf, mf * jf * x[j]); wb[j] = cvt_pk_bf16(omb, mb * jb * x[j]); }
                { const size_t ot = sf_tile_base(u.pm, c0) + (size_t)(ai * 128 + m * 16 + lb) * 64; *(u32x4*)(sf + ot) = wf; *(u32x4*)(sb + ot) = wb; }
                asm volatile("" ::: "memory"); }
    }
};
}

namespace att {
typedef float f32x16 __attribute__((ext_vector_type(16)));
typedef short s16x4 __attribute__((ext_vector_type(4)));
typedef short v4i16_t __attribute__((ext_vector_type(4)));
constexpr int NSLOT = 3, KSLOT = 12288, VSLOT = 8192, LDS_K = 0, LDS_V = NSLOT * KSLOT, LDS_WS = LDS_V + NSLOT * VSLOT, LDS_OST = LDS_WS + 8 * 256;
constexpr float THR = 8.f;
__device__ __forceinline__ int crow(int r, int hi) { return (r & 3) + 8 * (r >> 2) + 4 * hi; }
typedef float f32x2_t __attribute__((ext_vector_type(2))); typedef __bf16 bf16x2_t __attribute__((ext_vector_type(2)));
__device__ __forceinline__ unsigned cvtpk(float lo, float hi) { f32x2_t v = {lo, hi}; bf16x2_t b = __builtin_convertvector(v, bf16x2_t); return __builtin_bit_cast(unsigned, b); }
__device__ __forceinline__ s16x4 vtr(const LAS unsigned char* p) { return __builtin_bit_cast(s16x4, __builtin_amdgcn_ds_read_tr16_b64_v4i16((LAS v4i16_t*)p)); }

__device__ __forceinline__ float max3f(float a, float b, float c) { return __builtin_fmaxf(__builtin_fmaxf(a, b), c); }
__device__ __forceinline__ float rowmax32(const f32x16& p0, const f32x16& p1) {
    float a = max3f(p0[0], p0[1], p1[0]), b = max3f(p0[2], p0[3], p1[1]); a = max3f(a, p1[2], p1[3]);
#pragma unroll
    for (int r = 4; r < 16; r += 4) { a = max3f(a, p0[r], p0[r + 1]); b = max3f(b, p0[r + 2], p0[r + 3]); a = max3f(a, p1[r], p1[r + 1]); b = max3f(b, p1[r + 2], p1[r + 3]); }
    float m = fmaxf(a, b);
    auto rr = __builtin_amdgcn_permlane32_swap(__float_as_uint(m), __float_as_uint(m), false, false);
    return fmaxf(__uint_as_float(rr[0]), __uint_as_float(rr[1]));
}
__device__ __forceinline__ void attn_unit(int bh, int qb, const bf16_t* Q, const bf16_t* K, const bf16_t* V, bf16_t* O, LAS unsigned char* lds) {
    const int tid = otid(), lane = tid & 63, r32 = lane & 31, hi = lane >> 5; const int wid = __builtin_amdgcn_readfirstlane(tid >> 6);
    const bf16_t* Kh = K + (size_t)bh * SQ * 96; const bf16_t* Vh = V + (size_t)bh * SQ * 64;
    const bf16_t* Qw = Q + ((size_t)bh * SQ + qb * 256 + wid * 32) * 96;
    LAS float* wsf = (LAS float*)(lds + LDS_WS) + wid * 64;
    const bf16_t* ksrc0 = Kh + (size_t)lane * 96 + wid * 8;
    const bf16_t* ksrc1 = Kh + (size_t)lane * 96 + (wid + 8) * 8;
    const bf16_t* vsrc = Vh + (size_t)(16 * (wid & 3) + (lane >> 2)) * 64 + (wid >> 2) * 32 + (lane & 3) * 8;
#define ATT_DMA_K(t, slot) do { \
        __builtin_amdgcn_global_load_lds((const unsigned*)(ksrc0 + (size_t)(t) * 64 * 96), (LAS unsigned*)(lds + LDS_K + (slot) * KSLOT + wid * 1024), 16, 0, 0); \
        if (wid < 4) __builtin_amdgcn_global_load_lds((const unsigned*)(ksrc1 + (size_t)(t) * 64 * 96), (LAS unsigned*)(lds + LDS_K + (slot) * KSLOT + (wid + 8) * 1024), 16, 0, 0); } while (0)
#define ATT_DMA_V(t, slot) __builtin_amdgcn_global_load_lds((const unsigned*)(vsrc + (size_t)(t) * 64 * 64), (LAS unsigned*)(lds + LDS_V + (slot) * VSLOT + wid * 1024), 16, 0, 0)
    ATT_DMA_K(0, 0); ATT_DMA_V(0, 0); ATT_DMA_K(1, 1);
    bf16x8 qr[6];
#pragma unroll
    for (int d0 = 0; d0 < 6; ++d0) qr[d0] = *(const bf16x8*)(Qw + (size_t)r32 * 96 + d0 * 16 + hi * 8);
    f32x16 o[2], negm;
#pragma unroll
    for (int r = 0; r < 16; ++r) { o[0][r] = 0.f; o[1][r] = 0.f; negm[r] = 0.f; }
    float mhat = 0.f, l = 0.f;
    const int kfo = hi * 1024 + r32 * 16;
    const int vfo = ((lane >> 4) & 1) * 32 + (lane & 3) * 8 + (4 * hi + ((lane & 15) >> 2)) * 64;
    asm volatile("s_waitcnt vmcnt(0)" ::: "memory"); __builtin_amdgcn_s_barrier();
    constexpr int NT = SQ / 64;
    f32x16 pA0, pA1, pB0, pB1;
    bool resc = false;
#define ATT_QK(C0, C1, slot) do { const LAS unsigned char* kb_ = lds + LDS_K + (slot) * KSLOT + kfo; C0 = negm; C1 = negm; \
        _Pragma("unroll") for (int d0 = 0; d0 < 6; ++d0) { const bf16x8 b0_ = *(const LAS bf16x8*)(kb_ + d0 * 2048), b1_ = *(const LAS bf16x8*)(kb_ + d0 * 2048 + 512); \
            C0 = __builtin_amdgcn_mfma_f32_32x32x16_bf16(b0_, qr[d0], C0, 0, 0, 0); C1 = __builtin_amdgcn_mfma_f32_32x32x16_bf16(b1_, qr[d0], C1, 0, 0, 0); } } while (0)
#define ATT_DECIDE(C0, C1) do { const float rm_ = rowmax32(C0, C1); resc = false; \
        if (__builtin_expect(__any(rm_ > THR), 0)) { const float dl_ = fmaxf(rm_, 0.f); mhat += dl_; \
            _Pragma("unroll") for (int r = 0; r < 16; ++r) { C0[r] -= dl_; C1[r] -= dl_; negm[r] = -mhat; } \
            const float f_ = __builtin_amdgcn_exp2f(-dl_); l *= f_; if (hi == 0) wsf[r32] = f_; resc = true; } } while (0)
#define ATT_EXP(C0, C1) do { _Pragma("unroll") for (int r = 0; r < 16; ++r) { C0[r] = __builtin_amdgcn_exp2f(C0[r]); C1[r] = __builtin_amdgcn_exp2f(C1[r]); } } while (0)
#define ATT_PACK(P0, P1) do { float s_ = 0.f; _Pragma("unroll") for (int r = 0; r < 16; ++r) s_ += P0[r] + P1[r]; l += s_; \
        _Pragma("unroll") for (int i = 0; i < 4; ++i) { pw0[i] = cvtpk(P0[2 * i], P0[2 * i + 1]); pw1[i] = cvtpk(P0[8 + 2 * i], P0[8 + 2 * i + 1]); pw2[i] = cvtpk(P1[2 * i], P1[2 * i + 1]); pw3[i] = cvtpk(P1[8 + 2 * i], P1[8 + 2 * i + 1]); } } while (0)
#define ATT_VLOAD(slot) do { const LAS unsigned char* vb_ = lds + LDS_V + (slot) * VSLOT + vfo; \
        _Pragma("unroll") for (int i = 0; i < 8; ++i) { vlo[i] = vtr(vb_ + (i >> 2) * 4096 + (i & 3) * 1024); vhi[i] = vtr(vb_ + (i >> 2) * 4096 + (i & 3) * 1024 + 512); } } while (0)
#define ATT_VF(i) (bf16x8){vlo[i][0], vlo[i][1], vlo[i][2], vlo[i][3], vhi[i][0], vhi[i][1], vhi[i][2], vhi[i][3]}
#define ATT_PVEXP(C0, C1) do { \
        o[0] = __builtin_amdgcn_mfma_f32_32x32x16_bf16(__builtin_bit_cast(bf16x8, pw0), ATT_VF(0), o[0], 0, 0, 0); C0[0] = __builtin_amdgcn_exp2f(C0[0]); C0[1] = __builtin_amdgcn_exp2f(C0[1]); C0[2] = __builtin_amdgcn_exp2f(C0[2]); C0[3] = __builtin_amdgcn_exp2f(C0[3]); \
        o[1] = __builtin_amdgcn_mfma_f32_32x32x16_bf16(__builtin_bit_cast(bf16x8, pw0), ATT_VF(4), o[1], 0, 0, 0); C0[4] = __builtin_amdgcn_exp2f(C0[4]); C0[5] = __builtin_amdgcn_exp2f(C0[5]); C0[6] = __builtin_amdgcn_exp2f(C0[6]); C0[7] = __builtin_amdgcn_exp2f(C0[7]); \
        o[0] = __builtin_amdgcn_mfma_f32_32x32x16_bf16(__builtin_bit_cast(bf16x8, pw1), ATT_VF(1), o[0], 0, 0, 0); C0[8] = __builtin_amdgcn_exp2f(C0[8]); C0[9] = __builtin_amdgcn_exp2f(C0[9]); C0[10] = __builtin_amdgcn_exp2f(C0[10]); C0[11] = __builtin_amdgcn_exp2f(C0[11]); \
        o[1] = __builtin_amdgcn_mfma_f32_32x32x16_bf16(__builtin_bit_cast(bf16x8, pw1), ATT_VF(5), o[1], 0, 0, 0); C0[12] = __builtin_amdgcn_exp2f(C0[12]); C0[13] = __builtin_amdgcn_exp2f(C0[13]); C0[14] = __builtin_amdgcn_exp2f(C0[14]); C0[15] = __builtin_amdgcn_exp2f(C0[15]); \
        o[0] = __builtin_amdgcn_mfma_f32_32x32x16_bf16(__builtin_bit_cast(bf16x8, pw2), ATT_VF(2), o[0], 0, 0, 0); C1[0] = __builtin_amdgcn_exp2f(C1[0]); C1[1] = __builtin_amdgcn_exp2f(C1[1]); C1[2] = __builtin_amdgcn_exp2f(C1[2]); C1[3] = __builtin_amdgcn_exp2f(C1[3]); \
        o[1] = __builtin_amdgcn_mfma_f32_32x32x16_bf16(__builtin_bit_cast(bf16x8, pw2), ATT_VF(6), o[1], 0, 0, 0); C1[4] = __builtin_amdgcn_exp2f(C1[4]); C1[5] = __builtin_amdgcn_exp2f(C1[5]); C1[6] = __builtin_amdgcn_exp2f(C1[6]); C1[7] = __builtin_amdgcn_exp2f(C1[7]); \
        o[0] = __builtin_amdgcn_mfma_f32_32x32x16_bf16(__builtin_bit_cast(bf16x8, pw3), ATT_VF(3), o[0], 0, 0, 0); C1[8] = __builtin_amdgcn_exp2f(C1[8]); C1[9] = __builtin_amdgcn_exp2f(C1[9]); C1[10] = __builtin_amdgcn_exp2f(C1[10]); C1[11] = __builtin_amdgcn_exp2f(C1[11]); \
        o[1] = __builtin_amdgcn_mfma_f32_32x32x16_bf16(__builtin_bit_cast(bf16x8, pw3), ATT_VF(7), o[1], 0, 0, 0); C1[12] = __builtin_amdgcn_exp2f(C1[12]); C1[13] = __builtin_amdgcn_exp2f(C1[13]); C1[14] = __builtin_amdgcn_exp2f(C1[14]); C1[15] = __builtin_amdgcn_exp2f(C1[15]); \
        _Pragma("unroll") for (int g_ = 0; g_ < 8; ++g_) { __builtin_amdgcn_sched_group_barrier(0x8, 1, 0); __builtin_amdgcn_sched_group_barrier(0x2, 4, 0); } } while (0)
#define ATT_PV() do { \
        _Pragma("unroll") for (int i = 0; i < 8; ++i) { const int d0_ = i >> 2, ks_ = i & 3; const u32x4 pw_ = ks_ == 0 ? pw0 : ks_ == 1 ? pw1 : ks_ == 2 ? pw2 : pw3; \
            o[d0_] = __builtin_amdgcn_mfma_f32_32x32x16_bf16(__builtin_bit_cast(bf16x8, pw_), ATT_VF(i), o[d0_], 0, 0, 0); } } while (0)
#define ATT_RESC() do { if (resc) { asm volatile("s_waitcnt lgkmcnt(0)" ::: "memory"); \
        _Pragma("unroll") for (int r = 0; r < 16; ++r) { const float f_ = wsf[crow(r, hi)]; o[0][r] *= f_; o[1][r] *= f_; } } } while (0)
#define ATT_WAITBAR(full) do { if (full) asm volatile("s_waitcnt vmcnt(0) lgkmcnt(0)" ::: "memory"); \
        else if (wid < 4) asm volatile("s_waitcnt vmcnt(3) lgkmcnt(0)" ::: "memory"); else asm volatile("s_waitcnt vmcnt(2) lgkmcnt(0)" ::: "memory"); \
        __builtin_amdgcn_s_barrier(); } while (0)
#define ATT_STEP(C0, C1, P0, P1, t, ks, vs, kn) do { u32x4 pw0, pw1, pw2, pw3; s16x4 vlo[8], vhi[8]; \
        if ((t) + 2 < NT) ATT_DMA_K((t) + 2, vs); if ((t) + 1 < NT) ATT_DMA_V((t) + 1, kn); \
        ATT_QK(C0, C1, ks); ATT_VLOAD(vs); ATT_PACK(P0, P1); ATT_DECIDE(C0, C1); ATT_PVEXP(C0, C1); \
        ATT_WAITBAR((t) + 2 >= NT); ATT_RESC(); } while (0)
    ATT_DMA_K(2, 2); ATT_DMA_V(1, 1);
    ATT_QK(pA0, pA1, 0); ATT_DECIDE(pA0, pA1); ATT_EXP(pA0, pA1);
    ATT_WAITBAR(false);
    int ks = 1, vs = 0, kn = 2;
#pragma unroll 1
    for (int t = 1; t + 1 < NT; t += 2) {
        ATT_STEP(pB0, pB1, pA0, pA1, t, ks, vs, kn);
        vs = ks; ks = kn; kn = kn == 2 ? 0 : kn + 1;
        ATT_STEP(pA0, pA1, pB0, pB1, t + 1, ks, vs, kn);
        vs = ks; ks = kn; kn = kn == 2 ? 0 : kn + 1;
    }
    ATT_STEP(pB0, pB1, pA0, pA1, NT - 1, ks, vs, kn);
    { u32x4 pw0, pw1, pw2, pw3; s16x4 vlo[8], vhi[8]; ATT_VLOAD(ks); ATT_PACK(pB0, pB1); ATT_PV(); }
    { auto rr = __builtin_amdgcn_permlane32_swap(__float_as_uint(l), __float_as_uint(l), false, false); l = __uint_as_float(rr[0]) + __uint_as_float(rr[1]); }
    if (hi == 0) wsf[32 + r32] = l;
    asm volatile("s_waitcnt lgkmcnt(0)" ::: "memory");
    LAS bf16_t* stg = (LAS bf16_t*)(lds + LDS_OST) + wid * 2048;
#pragma unroll
    for (int r = 0; r < 16; ++r) { const int orow = crow(r, hi); const float rl = __builtin_amdgcn_rcpf(wsf[32 + orow]);
        stg[orow * 64 + r32] = f2bf(o[0][r] * rl); stg[orow * 64 + 32 + r32] = f2bf(o[1][r] * rl); }
    asm volatile("s_waitcnt lgkmcnt(0)" ::: "memory");
    const int b = bh >> 4, h = bh & 15;
    bf16_t* Ow = O + ((size_t)b * SQ + qb * 256 + wid * 32) * D + h * 64;
#pragma unroll
    for (int i = 0; i < 4; ++i) { const int row = i * 8 + (lane >> 3), ch = lane & 7; const u32x4 v = *(const LAS u32x4*)(stg + row * 64 + ch * 8); *(u32x4*)(Ow + (size_t)row * D + ch * 8) = v; }
    asm volatile("s_waitcnt lgkmcnt(0)" ::: "memory"); __builtin_amdgcn_s_barrier();
#undef ATT_DMA_K
#undef ATT_DMA_V
#undef ATT_QK
#undef ATT_DECIDE
#undef ATT_EXP
#undef ATT_PACK
#undef ATT_PV
#undef ATT_PVEXP
#undef ATT_VLOAD
#undef ATT_VF
#undef ATT_RESC
#undef ATT_WAITBAR
#undef ATT_STEP
}
#define SBAR() __builtin_amdgcn_sched_barrier(0)
#define PINV(x) asm volatile("" : "+v"(x))
struct QfArgs { const bf16_t* lat; const bf16_t* wqt; const float* ssqp; const float* qnorm; const float* cs; const float* sn; };
constexpr int LDS_WQ = LDS_OST;
__device__ __forceinline__ int rope_phys_a(int d) { return 8 * ((d >> 2) & 3) + 4 * (d >> 4) + (d & 3); }
template <bool QF>
__device__ __forceinline__ void attn_unit2(int bh, int qb, const bf16_t* Q, const bf16_t* K, const bf16_t* V, bf16_t* O, LAS unsigned char* lds, const float smax, const QfArgs& qa, bf16x8 (&lf)[24], const bf16_t* lat_next) {
    const int tid = otid(), lane = tid & 63, r32 = lane & 31, hi = lane >> 5; const int wid = __builtin_amdgcn_readfirstlane(tid >> 6);
    const bf16_t* Kh = K + (size_t)bh * SQ * 96; const bf16_t* Vh = V + (size_t)bh * SQ * 64;
    const bf16_t* Qw = Q + ((size_t)bh * SQ + qb * 256 + wid * 32) * 96;
    LAS float* wsf = (LAS float*)(lds + LDS_WS) + wid * 64;
    const bf16_t* ksrc0 = Kh + (size_t)wid * 512 + lane * 8;
    const bf16_t* ksrc1 = Kh + (size_t)(wid + 8) * 512 + lane * 8;
    const bf16_t* vsrc = Vh + (size_t)(wid >> 2) * 2048 + (16 * (wid & 3) + (lane >> 2)) * 32 + (lane & 3) * 8;
#define A2_GLDS(gsrc, ldsaddr) do { unsigned keep_; asm volatile("s_mov_b32 %0, m0\n\ts_mov_b32 m0, %2\n\ts_nop 0\n\tglobal_load_lds_dwordx4 %1, off\n\ts_mov_b32 m0, %0" : "=&s"(keep_) : "v"(gsrc), "s"((unsigned)__builtin_amdgcn_readfirstlane((int)(ldsaddr))) : "memory"); } while (0)
    const unsigned lds0 = (unsigned)(uintptr_t)lds;
#define A2_DMA_K(t, slot) do { \
        A2_GLDS(ksrc0 + (size_t)(t) * 64 * 96, lds0 + LDS_K + (slot) * KSLOT + wid * 1024); \
        if (wid < 4) A2_GLDS(ksrc1 + (size_t)(t) * 64 * 96, lds0 + LDS_K + (slot) * KSLOT + (wid + 8) * 1024); } while (0)
#define A2_DMA_V(t, slot) A2_GLDS(vsrc + (size_t)(t) * 64 * 64, lds0 + LDS_V + (slot) * VSLOT + wid * 1024)
#define A2_WAITBAR(NL, NH) do { if (wid < 4) asm volatile("s_waitcnt vmcnt(" #NL ") lgkmcnt(0)\n\ts_barrier" ::: "memory"); else asm volatile("s_waitcnt vmcnt(" #NH ") lgkmcnt(0)\n\ts_barrier" ::: "memory"); } while (0)
    if (wid < 4) __builtin_amdgcn_s_setprio(1);
    bf16x8 qr[6];
    if constexpr (!QF) {
#pragma unroll
        for (int d0 = 0; d0 < 6; ++d0) qr[d0] = *(const bf16x8*)(Qw + (size_t)r32 * 96 + d0 * 16 + hi * 8);
        A2_DMA_K(0, 0); A2_DMA_V(0, 0); A2_DMA_K(1, 1); A2_DMA_K(2, 2);
    } else {
        const size_t trow = (size_t)(bh >> 4) * SQ + qb * 256 + wid * 32 + r32;
        float ssq_ = 0.f;
#pragma unroll
        for (int sl = 0; sl < 12; ++sl) ssq_ += qa.ssqp[(size_t)sl * T + trow];
        const f32x4 c0 = *(const f32x4*)(qa.cs + trow * 16 + 4 * hi), c1 = *(const f32x4*)(qa.cs + trow * 16 + 8 + 4 * hi);
        const f32x4 s0 = *(const f32x4*)(qa.sn + trow * 16 + 4 * hi), s1 = *(const f32x4*)(qa.sn + trow * 16 + 8 + 4 * hi);
        A2_DMA_K(0, 0); A2_DMA_V(0, 0); A2_DMA_K(1, 1); A2_DMA_K(2, 2);
        f32x16 dq[3];
#pragma unroll
        for (int r = 0; r < 16; ++r) { dq[0][r] = 0.f; dq[1][r] = 0.f; dq[2][r] = 0.f; }
        const LAS unsigned char* wq0 = lds + LDS_WQ + lane * 16;
        bf16x8 wa[3], wb[3];
#define A2_WQLD(W, ks) do { W[0] = *(const LAS bf16x8*)(wq0 + (ks) * 1024); W[1] = *(const LAS bf16x8*)(wq0 + 24576 + (ks) * 1024); W[2] = *(const LAS bf16x8*)(wq0 + 49152 + (ks) * 1024); } while (0)
#define A2_WQMM(W, ks) do { dq[0] = __builtin_amdgcn_mfma_f32_32x32x16_bf16(W[0], lf[ks], dq[0], 0, 0, 0); dq[1] = __builtin_amdgcn_mfma_f32_32x32x16_bf16(W[1], lf[ks], dq[1], 0, 0, 0); dq[2] = __builtin_amdgcn_mfma_f32_32x32x16_bf16(W[2], lf[ks], dq[2], 0, 0, 0); } while (0)
        A2_WQLD(wa, 0); SBAR();
#pragma unroll
        for (int ks = 0; ks < 24; ks += 2) {
            A2_WQLD(wb, ks + 1); SBAR(); A2_WQMM(wa, ks); SBAR();
            if (ks + 2 < 24) { A2_WQLD(wa, ks + 2); SBAR(); } A2_WQMM(wb, ks + 1); SBAR(); }
#undef A2_WQLD
#undef A2_WQMM
        const float rq = rsqrtf(ssq_ * (1.f / QL) + EPS);
        float tot = 0.f;
#pragma unroll
        for (int blk = 0; blk < 3; ++blk)
#pragma unroll
            for (int r = 0; r < 16; ++r) tot += dq[blk][r] * dq[blk][r];
        { auto rr = __builtin_amdgcn_permlane32_swap(__float_as_uint(tot), __float_as_uint(tot), false, false); tot = __uint_as_float(rr[0]) + __uint_as_float(rr[1]); }
        const float scq = rq * rsqrtf(rq * rq * tot * (1.f / 96.f) + EPS) * QSCALE;
#pragma unroll
        for (int blk = 0; blk < 3; ++blk)
#pragma unroll
            for (int k = 0; k < 4; ++k) { const f32x4 g = *(const LAS f32x4*)(lds + LDS_WQ + 73728 + (32 * blk + 8 * k + 4 * hi) * 4);
#pragma unroll
                for (int j = 0; j < 4; ++j) dq[blk][4 * k + j] *= scq * g[j]; }
#pragma unroll
        for (int r = 0; r < 8; ++r) { const float c = r < 4 ? c0[r & 3] : c1[r & 3], sv = r < 4 ? s0[r & 3] : s1[r & 3];
            const float x1 = dq[2][r], x2 = dq[2][r + 8]; dq[2][r] = x1 * c - x2 * sv; dq[2][r + 8] = x1 * sv + x2 * c; }
#pragma unroll
        for (int blk = 0; blk < 3; ++blk)
#pragma unroll
            for (int s2 = 0; s2 < 2; ++s2) {
                const unsigned a0 = cvtpk(dq[blk][8 * s2 + 0], dq[blk][8 * s2 + 1]), a1 = cvtpk(dq[blk][8 * s2 + 2], dq[blk][8 * s2 + 3]);
                const unsigned b0 = cvtpk(dq[blk][8 * s2 + 4], dq[blk][8 * s2 + 5]), b1 = cvtpk(dq[blk][8 * s2 + 6], dq[blk][8 * s2 + 7]);
                const unsigned x0 = hi ? a0 : b0, x1 = hi ? a1 : b1;
                const unsigned y0 = (unsigned)__shfl_xor((int)x0, 32), y1 = (unsigned)__shfl_xor((int)x1, 32);
                u32x4 w; w[0] = hi ? y0 : a0; w[1] = hi ? y1 : a1; w[2] = hi ? b0 : y0; w[3] = hi ? b1 : y1;
                qr[2 * blk + s2] = __builtin_bit_cast(bf16x8, w); }
    }
    f32x16 o[2], negm;
#pragma unroll
    for (int r = 0; r < 16; ++r) { o[0][r] = 0.f; o[1][r] = 0.f; negm[r] = -smax; }
    PINV(negm);
    float l_reg = 0.f;
    const LAS unsigned char* kp0 = lds + LDS_K + hi * 1024 + r32 * 16;
    const LAS unsigned char* vp0 = lds + LDS_V + ((lane >> 4) & 1) * 32 + (lane & 3) * 8 + (4 * hi + ((lane & 15) >> 2)) * 64;
    constexpr int NT = SQ / 64;
    bf16x8 kf[12];
#define A2_KLOAD2(slot, j) do { kf[2 * (j)] = *(const LAS bf16x8*)(kp0 + (slot) * KSLOT + (j) * 2048); kf[2 * (j) + 1] = *(const LAS bf16x8*)(kp0 + (slot) * KSLOT + (j) * 2048 + 512); } while (0)
    f32x16 pA0, pA1, pB0, pB1;
    A2_WAITBAR(5, 3);
#pragma unroll
    for (int j = 0; j < 6; ++j) A2_KLOAD2(0, j);
    pA0 = negm; pA1 = negm;
#pragma unroll
    for (int d0 = 0; d0 < 6; ++d0) { pA0 = __builtin_amdgcn_mfma_f32_32x32x16_bf16(kf[2 * d0], qr[d0], pA0, 0, 0, 0); pA1 = __builtin_amdgcn_mfma_f32_32x32x16_bf16(kf[2 * d0 + 1], qr[d0], pA1, 0, 0, 0); }
#pragma unroll
    for (int r = 0; r < 16; ++r) { pA0[r] = __builtin_amdgcn_exp2f(pA0[r]); if (r < 8) pA1[r] = __builtin_amdgcn_exp2f(pA1[r]); }
    A2_WAITBAR(0, 0);
    A2_DMA_K(3, 0); A2_DMA_V(1, 1);
    int sp = 0, sc = 1, sn = 2;
#pragma unroll
    for (int j = 0; j < 6; ++j) A2_KLOAD2(sc, j);
    A2_WAITBAR(3, 2);
#define A2_VRD(i) do { vlo[i] = vtr(vp_ + ((i) >> 2) * 4096 + ((i) & 3) * 1024); vhi[i] = vtr(vp_ + ((i) >> 2) * 4096 + ((i) & 3) * 1024 + 512); } while (0)
#define A2_VF(i) (bf16x8){vlo[i][0], vlo[i][1], vlo[i][2], vlo[i][3], vhi[i][0], vhi[i][1], vhi[i][2], vhi[i][3]}
#define A2_PAF(k) __builtin_bit_cast(bf16x8, pw##k)
#define A2_GAPA(MF, A0, A1, A2_, W0, W1) do { MF; sacc += A0; sacc += A1; sacc += A2_; PINV(sacc); W0; W1; SBAR(); } while (0)
#define A2_EX4(X, B) do { X[B] = __builtin_amdgcn_exp2f(X[B]); X[B + 1] = __builtin_amdgcn_exp2f(X[B + 1]); X[B + 2] = __builtin_amdgcn_exp2f(X[B + 2]); X[B + 3] = __builtin_amdgcn_exp2f(X[B + 3]); PINV(X); } while (0)
#define A2_EX3(a, b, c) do { a = __builtin_amdgcn_exp2f(a); b = __builtin_amdgcn_exp2f(b); c = __builtin_amdgcn_exp2f(c); } while (0)
#define A2_NOP do { } while (0)
#define A2_STEP(C0, C1, P0, P1, t) do { SBAR(); \
        const LAS unsigned char* vp_ = vp0 + sp * VSLOT; s16x4 vlo[8], vhi[8]; u32x4 pw0, pw1, pw2, pw3; \
        const bool gk_ = (t) + 3 < NT, gv_ = (t) + 1 < NT; \
        A2_VRD(0); SBAR(); float sacc = P0[0] + P0[1]; \
        P1[8] = __builtin_amdgcn_exp2f(P1[8]); P1[9] = __builtin_amdgcn_exp2f(P1[9]); PINV(P1); A2_GAPA(C0 = __builtin_amdgcn_mfma_f32_32x32x16_bf16(kf[0], qr[0], negm, 0, 0, 0), P0[2], P0[3], P0[4], pw0[0] = cvtpk(P0[0], P0[1]), pw0[1] = cvtpk(P0[2], P0[3])); \
        A2_VRD(4); SBAR(); P1[10] = __builtin_amdgcn_exp2f(P1[10]); P1[11] = __builtin_amdgcn_exp2f(P1[11]); PINV(P1); A2_GAPA(C1 = __builtin_amdgcn_mfma_f32_32x32x16_bf16(kf[1], qr[0], negm, 0, 0, 0), P0[5], P0[6], P0[7], pw0[2] = cvtpk(P0[4], P0[5]), pw0[3] = cvtpk(P0[6], P0[7])); \
        A2_VRD(1); SBAR(); P1[12] = __builtin_amdgcn_exp2f(P1[12]); P1[13] = __builtin_amdgcn_exp2f(P1[13]); PINV(P1); A2_GAPA(C0 = __builtin_amdgcn_mfma_f32_32x32x16_bf16(kf[2], qr[1], C0, 0, 0, 0), P0[8], P0[9], P0[10], pw1[0] = cvtpk(P0[8], P0[9]), pw1[1] = cvtpk(P0[10], P0[11])); \
        A2_VRD(5); SBAR(); P1[14] = __builtin_amdgcn_exp2f(P1[14]); P1[15] = __builtin_amdgcn_exp2f(P1[15]); PINV(P1); A2_GAPA(C1 = __builtin_amdgcn_mfma_f32_32x32x16_bf16(kf[3], qr[1], C1, 0, 0, 0), P0[11], P0[12], P0[13], pw1[2] = cvtpk(P0[12], P0[13]), pw1[3] = cvtpk(P0[14], P0[15])); \
        A2_VRD(2); SBAR(); A2_GAPA(C0 = __builtin_amdgcn_mfma_f32_32x32x16_bf16(kf[4], qr[2], C0, 0, 0, 0), P0[14], P0[15], P1[0], pw2[0] = cvtpk(P1[0], P1[1]), pw2[1] = cvtpk(P1[2], P1[3])); \
        A2_VRD(6); SBAR(); A2_GAPA(C1 = __builtin_amdgcn_mfma_f32_32x32x16_bf16(kf[5], qr[2], C1, 0, 0, 0), P1[1], P1[2], P1[3], pw2[2] = cvtpk(P1[4], P1[5]), pw2[3] = cvtpk(P1[6], P1[7])); \
        A2_VRD(3); SBAR(); A2_GAPA(C0 = __builtin_amdgcn_mfma_f32_32x32x16_bf16(kf[6], qr[3], C0, 0, 0, 0), P1[4], P1[5], P1[6], pw3[0] = cvtpk(P1[8], P1[9]), pw3[1] = cvtpk(P1[10], P1[11])); \
        A2_VRD(7); SBAR(); A2_GAPA(C1 = __builtin_amdgcn_mfma_f32_32x32x16_bf16(kf[7], qr[3], C1, 0, 0, 0), P1[7], P1[8], P1[9], pw3[2] = cvtpk(P1[12], P1[13]), pw3[3] = cvtpk(P1[14], P1[15])); \
        A2_GAPA(C0 = __builtin_amdgcn_mfma_f32_32x32x16_bf16(kf[8], qr[4], C0, 0, 0, 0), P1[10], P1[11], P1[12], A2_NOP, A2_NOP); \
        A2_GAPA(C1 = __builtin_amdgcn_mfma_f32_32x32x16_bf16(kf[9], qr[4], C1, 0, 0, 0), P1[13], P1[14], P1[15], A2_NOP, A2_NOP); \
        if (gk_) { A2_DMA_K((t) + 3, sc); } if (gv_) { A2_DMA_V((t) + 1, sn); } SBAR(); \
        C0 = __builtin_amdgcn_mfma_f32_32x32x16_bf16(kf[10], qr[5], C0, 0, 0, 0); C1 = __builtin_amdgcn_mfma_f32_32x32x16_bf16(kf[11], qr[5], C1, 0, 0, 0); SBAR(); \
        l_reg += sacc; SBAR(); \
        o[0] = __builtin_amdgcn_mfma_f32_32x32x16_bf16(A2_PAF(0), A2_VF(0), o[0], 0, 0, 0); A2_EX3(C0[0], C0[1], C0[2]); PINV(C0); SBAR(); \
        o[1] = __builtin_amdgcn_mfma_f32_32x32x16_bf16(A2_PAF(0), A2_VF(4), o[1], 0, 0, 0); A2_EX3(C0[3], C0[4], C0[5]); PINV(C0); SBAR(); \
        if (gv_) { A2_KLOAD2(sn, 0); SBAR(); } o[0] = __builtin_amdgcn_mfma_f32_32x32x16_bf16(A2_PAF(1), A2_VF(1), o[0], 0, 0, 0); A2_EX3(C0[6], C0[7], C0[8]); PINV(C0); SBAR(); \
        if (gv_) { A2_KLOAD2(sn, 1); SBAR(); } o[1] = __builtin_amdgcn_mfma_f32_32x32x16_bf16(A2_PAF(1), A2_VF(5), o[1], 0, 0, 0); A2_EX3(C0[9], C0[10], C0[11]); PINV(C0); SBAR(); \
        if (gv_) { A2_KLOAD2(sn, 2); SBAR(); } o[0] = __builtin_amdgcn_mfma_f32_32x32x16_bf16(A2_PAF(2), A2_VF(2), o[0], 0, 0, 0); A2_EX3(C0[12], C0[13], C0[14]); PINV(C0); SBAR(); \
        if (gv_) { A2_KLOAD2(sn, 3); SBAR(); } o[1] = __builtin_amdgcn_mfma_f32_32x32x16_bf16(A2_PAF(2), A2_VF(6), o[1], 0, 0, 0); A2_EX3(C0[15], C1[0], C1[1]); PINV(C0); PINV(C1); SBAR(); \
        if (gv_) { A2_KLOAD2(sn, 4); SBAR(); } o[0] = __builtin_amdgcn_mfma_f32_32x32x16_bf16(A2_PAF(3), A2_VF(3), o[0], 0, 0, 0); A2_EX3(C1[2], C1[3], C1[4]); PINV(C1); SBAR(); \
        if (gv_) { A2_KLOAD2(sn, 5); SBAR(); } o[1] = __builtin_amdgcn_mfma_f32_32x32x16_bf16(A2_PAF(3), A2_VF(7), o[1], 0, 0, 0); A2_EX3(C1[5], C1[6], C1[7]); PINV(C1); SBAR(); \
        if (gk_) A2_WAITBAR(3, 2); else A2_WAITBAR(0, 0); \
        { const int t_ = sp; sp = sc; sc = sn; sn = t_; } } while (0)
    if (wid < 4) __builtin_amdgcn_s_setprio(1);
#pragma unroll 1
    for (int t = 1; t + 1 < NT; t += 2) { A2_STEP(pB0, pB1, pA0, pA1, t); A2_STEP(pA0, pA1, pB0, pB1, t + 1); }
    A2_STEP(pB0, pB1, pA0, pA1, NT - 1);
    if constexpr (QF) {
#pragma unroll
        for (int ks = 0; ks < 24; ++ks) lf[ks] = *(const bf16x8*)(lat_next + ks * 16); }
    { float sacc = 0.f;
#pragma unroll
      for (int r = 8; r < 16; ++r) pB1[r] = __builtin_amdgcn_exp2f(pB1[r]);
#pragma unroll
      for (int r = 0; r < 16; ++r) sacc += pB0[r] + pB1[r];
      l_reg += sacc;
      u32x4 pw0, pw1, pw2, pw3;
#pragma unroll
      for (int i = 0; i < 4; ++i) { pw0[i] = cvtpk(pB0[2 * i], pB0[2 * i + 1]); pw1[i] = cvtpk(pB0[8 + 2 * i], pB0[8 + 2 * i + 1]); pw2[i] = cvtpk(pB1[2 * i], pB1[2 * i + 1]); pw3[i] = cvtpk(pB1[8 + 2 * i], pB1[8 + 2 * i + 1]); }
      const LAS unsigned char* vp_ = vp0 + sp * VSLOT; s16x4 vlo[8], vhi[8];
#pragma unroll
      for (int i = 0; i < 8; ++i) A2_VRD(i);
#pragma unroll
      for (int i = 0; i < 8; ++i) { const int d0_ = i >> 2, ks_ = i & 3; const u32x4 pw_ = ks_ == 0 ? pw0 : ks_ == 1 ? pw1 : ks_ == 2 ? pw2 : pw3;
          o[d0_] = __builtin_amdgcn_mfma_f32_32x32x16_bf16(__builtin_bit_cast(bf16x8, pw_), A2_VF(i), o[d0_], 0, 0, 0); } }
    float l = l_reg;
    { auto rr = __builtin_amdgcn_permlane32_swap(__float_as_uint(l), __float_as_uint(l), false, false); l = __uint_as_float(rr[0]) + __uint_as_float(rr[1]); }
    if (hi == 0) wsf[32 + r32] = l;
    asm volatile("s_waitcnt lgkmcnt(0)" ::: "memory");
    LAS bf16_t* stg = (LAS bf16_t*)(lds + (QF ? LDS_K : LDS_OST)) + wid * 2048;
#pragma unroll
    for (int r = 0; r < 16; ++r) { const int orow = crow(r, hi); const float rl = __builtin_amdgcn_rcpf(wsf[32 + orow]);
        stg[orow * 64 + r32] = f2bf(o[0][r] * rl); stg[orow * 64 + 32 + r32] = f2bf(o[1][r] * rl); }
    asm volatile("s_waitcnt lgkmcnt(0)" ::: "memory");
    const int b = bh >> 4, h = bh & 15;
    bf16_t* Ow = O + ((size_t)b * SQ + qb * 256 + wid * 32) * D + h * 64;
#pragma unroll
    for (int i = 0; i < 4; ++i) { const int row = i * 8 + (lane >> 3), ch = lane & 7; const u32x4 v = *(const LAS u32x4*)(stg + row * 64 + ch * 8); *(u32x4*)(Ow + (size_t)row * D + ch * 8) = v; }
    if constexpr (QF) { asm volatile("s_waitcnt lgkmcnt(0)" ::: "memory"); __builtin_amdgcn_s_barrier(); }
    else { asm volatile("s_waitcnt vmcnt(0) lgkmcnt(0)" ::: "memory"); __builtin_amdgcn_s_barrier(); }
#undef A2_GLDS
#undef A2_DMA_K
#undef A2_DMA_V
#undef A2_WAITBAR
#undef A2_KLOAD2
#undef A2_VRD
#undef A2_VF
#undef A2_PAF
#undef A2_GAPA
#undef A2_EX4
#undef A2_EX3
#undef A2_NOP
#undef A2_STEP
}
__device__ __forceinline__ void attn_phase(const Params& p, LAS unsigned char* lds) {
    const int G = gridDim.x, c = blockIdx.x;
    const float smax = *WSP(const float, WS_SMAX);
    constexpr int NU = NB * NH * (SQ / 256);
    const QfArgs qa{WSP(const bf16_t, WS_LAT), WSP(const bf16_t, WS_WQT), WSP(const float, WS_SSQP), (const float*)p.in[12], WSP(const float, WS_COS), WSP(const float, WS_SIN)};
    bf16x8 lf[24];
    auto lrow_of = [&](int bh, int qb) -> const bf16_t* { const int tid = otid(), lane = tid & 63;
        return qa.lat + ((size_t)(bh >> 4) * SQ + qb * 256 + (tid >> 6) * 32 + (lane & 31)) * LATP + (lane >> 5) * 8; };
    int cur_h = -1;
    auto stage_wq = [&](int h_) {
        if (!QFUSE || h_ == cur_h) return; cur_h = h_;
        const int tid = otid(), lane = tid & 63, r32 = lane & 31, hi = lane >> 5; const int wid = __builtin_amdgcn_readfirstlane(tid >> 6);
#pragma unroll 1
        for (int i = 0; i < 9; ++i) { const int pc = wid + 8 * i, blk = pc / 24, cp = pc - blk * 24;
            const int wrow = h_ * 128 + (blk < 2 ? blk * 32 + r32 : 64 + rope_phys_a(r32));
            const bf16_t* gsrc = qa.wqt + (size_t)wrow * QL + (2 * cp + hi) * 8; unsigned keep_;
            asm volatile("s_mov_b32 %0, m0\n\ts_mov_b32 m0, %2\n\ts_nop 0\n\tglobal_load_lds_dwordx4 %1, off\n\ts_mov_b32 m0, %0" : "=&s"(keep_) : "v"(gsrc), "s"((unsigned)__builtin_amdgcn_readfirstlane((int)((unsigned)(uintptr_t)lds + LDS_WQ + pc * 1024))) : "memory"); }
        if (tid < 96) ((LAS float*)(lds + LDS_WQ + 73728))[tid] = qa.qnorm[tid];
        asm volatile("s_waitcnt vmcnt(0) lgkmcnt(0)" ::: "memory"); __builtin_amdgcn_s_barrier(); };
    if (G == 256) {
        const int x = c & 7, r = c >> 3, g = r >> 3;
        const int h_ = 2 * x + (g & 1), qb = r & 7;
        if constexpr (QFUSE) { const bf16_t* l0 = lrow_of((g >> 1) * 16 + h_, qb);
#pragma unroll
            for (int ks = 0; ks < 24; ++ks) lf[ks] = *(const bf16x8*)(l0 + ks * 16); }
        stage_wq(h_);
#pragma unroll 1
        for (int i = 0; i < 8; ++i) { const int b_ = 2 * i + (g >> 1), bh = b_ * 16 + h_;
            attn_unit2<QFUSE>(bh, qb, WSP(const bf16_t, WS_Q), WSP(const bf16_t, WS_K), WSP(const bf16_t, WS_V), WSP(bf16_t, WS_O), lds, smax, qa, lf, lrow_of(i + 1 < 8 ? bh + 32 : bh, qb)); }
    } else {
        if constexpr (QFUSE) { if (c < NU) { const bf16_t* l0 = lrow_of(c >> 3, c & 7);
#pragma unroll
            for (int ks = 0; ks < 24; ++ks) lf[ks] = *(const bf16x8*)(l0 + ks * 16); } }
#pragma unroll 1
        for (int L = c; L < NU; L += G) { stage_wq((L >> 3) & 15);
            attn_unit2<QFUSE>(L >> 3, L & 7, WSP(const bf16_t, WS_Q), WSP(const bf16_t, WS_K), WSP(const bf16_t, WS_V), WSP(bf16_t, WS_O), lds, smax, qa, lf, lrow_of((L + G < NU ? L + G : L) >> 3, (L + G < NU ? L + G : L) & 7)); }
    }
    __builtin_amdgcn_s_setprio(0);
}
}

template <class RowMap>
__device__ __forceinline__ void xpose_item(const float* W, int ldw, const float* gain, bf16_t* Bt, int Kd, int k0, int n0, const RowMap& rm, LAS float* scr, int lane, const float wscale = 1.f) {
    float tv[32];
#pragma unroll
    for (int i = 0; i < 32; ++i) tv[i] = __builtin_nontemporal_load(W + (size_t)(k0 + 2 * i + (lane >> 5)) * ldw + n0 + (lane & 31));
    if (gain) {
#pragma unroll
        for (int i = 0; i < 32; ++i) tv[i] *= gain[k0 + 2 * i + (lane >> 5)]; }
#pragma unroll
    for (int i = 0; i < 32; ++i) scr[(2 * i + (lane >> 5)) * 33 + (lane & 31)] = tv[i] * wscale;
    asm volatile("s_waitcnt lgkmcnt(0)" ::: "memory");
    const int c = lane & 7;
#pragma unroll
    for (int j = 0; j < 4; ++j) { const int n = (lane >> 3) + 8 * j; const LAS float* sp = scr + (8 * c) * 33 + n;
        u32x4 o; o[0] = pk2(sp[0 * 33], sp[1 * 33]); o[1] = pk2(sp[2 * 33], sp[3 * 33]); o[2] = pk2(sp[4 * 33], sp[5 * 33]); o[3] = pk2(sp[6 * 33], sp[7 * 33]);
        *(u32x4*)(Bt + (size_t)rm(n0 + n) * Kd + k0 + 8 * c) = o; }
    asm volatile("s_waitcnt lgkmcnt(0)" ::: "memory");
}
template <class RowMap>
__device__ __forceinline__ void xpose_item8(const float* W, int ldw, float scale, unsigned char* Bt, int Kd, int k0, int n0, const RowMap& rm, LAS float* scr, int lane) {
    float tv[32];
#pragma unroll
    for (int i = 0; i < 32; ++i) tv[i] = __builtin_nontemporal_load(W + (size_t)(k0 + 2 * i + (lane >> 5)) * ldw + n0 + (lane & 31));
#pragma unroll
    for (int i = 0; i < 32; ++i) scr[(2 * i + (lane >> 5)) * 33 + (lane & 31)] = tv[i] * scale;
    asm volatile("s_waitcnt lgkmcnt(0)" ::: "memory");
    const int c = lane & 7;
#pragma unroll
    for (int j = 0; j < 4; ++j) { const int n = (lane >> 3) + 8 * j; const LAS float* sp = scr + (8 * c) * 33 + n;
        u32x2 o; o[0] = g8::pk4_fp8(sp[0 * 33], sp[1 * 33], sp[2 * 33], sp[3 * 33]); o[1] = g8::pk4_fp8(sp[4 * 33], sp[5 * 33], sp[6 * 33], sp[7 * 33]);
        *(u32x2*)(Bt + (size_t)rm(n0 + n) * Kd + k0 + 8 * c) = o; }
    asm volatile("s_waitcnt lgkmcnt(0)" ::: "memory");
}
struct RmId { __device__ __forceinline__ int operator()(int n) const { return n; } };
__device__ __forceinline__ int rope_phys(int d) { return 8 * ((d >> 2) & 3) + 4 * (d >> 4) + (d & 3); }
struct RmLat { __device__ __forceinline__ int operator()(int n) const { return n < 640 ? n : 640 + rope_phys(n - 640); } };
struct RmQ { __device__ __forceinline__ int operator()(int n) const { const int h = n / 96, d = n % 96; return h * 128 + (d < 64 ? d : 64 + rope_phys(d - 64)); } };
struct RmGate { int gate; __device__ __forceinline__ int operator()(int e) const { const int pn = e >> 6, ce = e & 63; return 256 * pn + 128 * (gate >> 1) + 32 * (ce >> 4) + 8 * ((ce >> 2) & 3) + 4 * (gate & 1) + (ce & 3); } };
struct RmGu { __device__ __forceinline__ int operator()(int n) const { const int a = n & 511; return 256 * (a >> 7) + 128 * (n >> 9) + (a & 127); } };

constexpr int CONV_IGU = 16 * 32, CONV_IDN = 8 * 32, CONV_NM = 64 * (CONV_IGU + CONV_IDN), CONV_LATE0 = 32 * CONV_IGU, CONV_LATE = 16 * CONV_IGU;
static_assert(!(MOE0_FP8 && MOE1_FP8) || DN1_FP8, "the late conversion ranges assume the all-e4m3 MoE path");
constexpr int CONV_LATEB = CONV_LATE0 + CONV_LATE, CONV_LATEBN = 8 * CONV_IGU, CONV_LATEC = CONV_LATEB + CONV_LATEBN, CONV_REST = CONV_LATEC + CONV_LATEBN;
__device__ __forceinline__ void conv_moe(const Params& p, LAS float* scr, int lane, int gw, int ngw, int r0, int nj) {
    constexpr int I_GU = CONV_IGU, I_DN = CONV_IDN;
    const bool paired = (nj % (2 * ngw)) == 0;
    auto item_of = [&](int j) -> int { int x = j; if (paired) { const int blk = j / (2 * ngw), w = j % ngw, h = (j / ngw) & 1; x = 2 * (blk * ngw + w) + h; }
        return r0 + x; };
    auto src_of = [&](int r) -> const float* {
        if (r < 64 * I_GU) { const int le = r / I_GU, q = r % I_GU; return IN_F(31) + (size_t)le * 1048576 + (size_t)((2 * (q / 64) + (q & 1)) * 64 + (lane >> 5)) * 1024 + ((q >> 1) & 31) * 32 + (lane & 31); }
        r -= 64 * I_GU; const int le = r / I_DN, q = r % I_DN; return IN_F(32) + (size_t)le * 524288 + (size_t)((2 * (q / 64) + (q & 1)) * 64 + (lane >> 5)) * 1024 + ((q >> 1) & 31) * 32 + (lane & 31); };
#define CV_LOAD(TV, j) do { const float* s_ = src_of(item_of(j)); _Pragma("unroll") for (int i = 0; i < 32; ++i) TV[i] = __builtin_nontemporal_load(s_ + (size_t)i * 2048); } while (0)
#define CV_PROC(TV, j) do { _Pragma("unroll") for (int i = 0; i < 32; ++i) scr[(2 * i + (lane >> 5)) * 33 + (lane & 31)] = TV[i] * F8_SW; \
        asm volatile("s_waitcnt lgkmcnt(0)" ::: "memory"); \
        const int r_ = item_of(j); const bool gu_ = r_ < 64 * I_GU; const int rr_ = gu_ ? r_ : r_ - 64 * I_GU, le_ = gu_ ? rr_ / I_GU : rr_ / I_DN, q_ = gu_ ? rr_ % I_GU : rr_ % I_DN, k0_ = (2 * (q_ / 64) + (q_ & 1)) * 64, n0_ = ((q_ >> 1) & 31) * 32, Kd_ = gu_ ? 1024 : 512; \
        unsigned char* Bt_ = gu_ ? WSP(unsigned char, WS_WGU8) + (size_t)(le_ >> 5) * 64 * MiB + (size_t)(le_ & 31) * 1048576 : WSP(unsigned char, WS_WDN8) + (size_t)(le_ >> 5) * 32 * MiB + (size_t)(le_ & 31) * 524288; \
        const int c_ = lane & 7; \
        _Pragma("unroll") for (int jj = 0; jj < 4; ++jj) { const int n_ = n0_ + (lane >> 3) + 8 * jj; const LAS float* sp = scr + (8 * c_) * 33 + (lane >> 3) + 8 * jj; \
            u32x2 o; o[0] = g8::pk4_fp8(sp[0 * 33], sp[1 * 33], sp[2 * 33], sp[3 * 33]); o[1] = g8::pk4_fp8(sp[4 * 33], sp[5 * 33], sp[6 * 33], sp[7 * 33]); \
            *(u32x2*)(Bt_ + (size_t)(gu_ ? RmGu{}(n_) : n_) * Kd_ + k0_ + 8 * c_) = o; } \
        asm volatile("s_waitcnt lgkmcnt(0)" ::: "memory"); } while (0)
    float ta[32], tb[32];
    int j = gw;
    if (j < nj) CV_LOAD(ta, j);
#pragma unroll 1
    while (j < nj) { const int j1 = j + ngw, j2 = j1 + ngw;
        if (j1 < nj) CV_LOAD(tb, j1);
        CV_PROC(ta, j);
        if (j2 < nj) CV_LOAD(ta, j2);
        if (j1 < nj) CV_PROC(tb, j1);
        j = j2; }
#undef CV_LOAD
#undef CV_PROC
}

__device__ __forceinline__ void conv_in_moe_tail(const Params& p, LAS unsigned char* ldsb, const LAS int* tab, int G, int vc, int r0, int n) {
    const int total = tab[32] * 4, rounds = (total + G - 1) / G, first_idle = total - (rounds - 1) * G, nidle = G - first_idle;
    __syncthreads();
    const int wave = otid() >> 6, lane = otid() & 63; LAS float* scr = (LAS float*)ldsb + wave * (64 * 33);
    if (nidle >= 32) { if (vc >= first_idle) conv_moe(p, scr, lane, (vc - first_idle) * 8 + wave, nidle * 8, r0, n); }
    else conv_moe(p, scr, lane, vc * 8 + wave, G * 8, r0, n);
}
__device__ __forceinline__ void ph_convert(const Params& p, LAS float* lds) {
    const int lane = otid() & 63, wave = otid() >> 6;
    LAS float* scr = lds + wave * (64 * 33);
    const int gw = blockIdx.x * 8 + wave, ngw = gridDim.x * 8;
    constexpr int I_W1 = 16 * 21, I_WQ = 6 * 48, I_WKV = 4 * 64, I_WO = 16 * 32, I_RIN = 16 * 64, I_G = 16 * 32, I_RO = 16 * 32, I_GU = 16 * 32, I_DN = 8 * 32;
    constexpr int NSMALL = I_W1 + I_WQ + I_WKV + I_WO + I_RIN + I_G + I_RO, NITEMS = NSMALL + 64 * (I_GU + I_DN);
    constexpr bool MOE_PIPE = MOE0_FP8 && MOE1_FP8;
    for (int it = gw; it < (MOE_PIPE ? NSMALL : NITEMS); it += ngw) { int r = it;
        if (r < I_W1) { xpose_item(IN_F(7), LATN, nullptr, WSP(bf16_t, WS_W1T), 1024, (r / 21) * 64, (r % 21) * 32, RmLat{}, scr, lane); continue; } r -= I_W1;
        if (r < I_WQ) { xpose_item(IN_F(10), 1536, IN_F(8), WSP(bf16_t, WS_WQT), QL, (r / 48) * 64, (r % 48) * 32, RmQ{}, scr, lane); continue; } r -= I_WQ;
        if (r < I_WKV) { xpose_item(IN_F(11), 2048, IN_F(9), WSP(bf16_t, WS_WKVT), KVL, (r / 64) * 64, (r % 64) * 32, RmId{}, scr, lane); continue; } r -= I_WKV;
        if (r < I_WO) { xpose_item(IN_F(14), 1024, nullptr, WSP(bf16_t, WS_WOT), 1024, (r / 32) * 64, (r % 32) * 32, RmId{}, scr, lane); continue; } r -= I_WO;
        if (r < I_RIN) { if (RNN_FP8) xpose_item8(IN_F(15), 2048, F8_SW, WSP(unsigned char, WS_WRINT), 1024, (r / 64) * 64, (r % 64) * 32, RmId{}, scr, lane);
            else xpose_item(IN_F(15), 2048, nullptr, WSP(bf16_t, WS_WRINT), 1024, (r / 64) * 64, (r % 64) * 32, RmId{}, scr, lane); continue; } r -= I_RIN;
        if (r < I_G) { const int nb = r >> 7, gate = (r >> 5) & 3, q = r & 31; const float* W = gate == 0 ? IN_F(19) : gate == 1 ? IN_F(21) : gate == 2 ? IN_F(24) : IN_F(26);
            xpose_item(W + (size_t)nb * 65536, 256, nullptr, WSP(bf16_t, WS_WGT) + (size_t)nb * 1024 * 256, 256, (q >> 3) * 64, (q & 7) * 32, RmGate{gate}, scr, lane, -1.4426950408889634f); continue; } r -= I_G;
        if (r < I_RO) { if (RNN_FP8) xpose_item8(IN_F(28), 1024, F8_SW, WSP(unsigned char, WS_WROT), 1024, (r / 32) * 64, (r % 32) * 32, RmId{}, scr, lane);
            else xpose_item(IN_F(28), 1024, nullptr, WSP(bf16_t, WS_WROT), 1024, (r / 32) * 64, (r % 32) * 32, RmId{}, scr, lane); continue; } r -= I_RO;
        if (r < 64 * I_GU) { const int le = r / I_GU, q = r % I_GU;
            if (le >= 32 ? MOE1_FP8 : MOE0_FP8) xpose_item8(IN_F(31) + (size_t)le * 1048576, 1024, F8_SW, WSP(unsigned char, WS_WGU8) + (size_t)(le >> 5) * 64 * MiB + (size_t)(le & 31) * 1048576, 1024, (q / 32) * 64, (q % 32) * 32, RmGu{}, scr, lane);
            else xpose_item(IN_F(31) + (size_t)le * 1048576, 1024, nullptr, WSP(bf16_t, WS_WGU) + (size_t)le * 1048576, 1024, (q / 32) * 64, (q % 32) * 32, RmGu{}, scr, lane);
            continue; } r -= 64 * I_GU;
        { const int le = r / I_DN, q = r % I_DN;
          if (le >= 32 ? MOE1_FP8 : MOE0_FP8) xpose_item8(IN_F(32) + (size_t)le * 524288, 1024, F8_SW, WSP(unsigned char, WS_WDN8) + (size_t)(le >> 5) * 32 * MiB + (size_t)(le & 31) * 524288, 512, (q / 32) * 64, (q % 32) * 32, RmId{}, scr, lane);
          else xpose_item(IN_F(32) + (size_t)le * 524288, 1024, nullptr, WSP(bf16_t, WS_WDN) + (size_t)le * 524288, 512, (q / 32) * 64, (q % 32) * 32, RmId{}, scr, lane); }
    }
    if constexpr (MOE_PIPE) { conv_moe(p, scr, lane, gw, ngw, 0, CONV_LATE0); conv_moe(p, scr, lane, gw, ngw, CONV_REST, CONV_NM - CONV_REST); }
    { u32x4 z = {0u, 0u, 0u, 0u}; const int gt = blockIdx.x * 512 + otid(), ngt = gridDim.x * 512;
      for (int i = gt; i < 96 * 1024 / 8; i += ngt) *(u32x4*)(WSP(bf16_t, WS_W1T) + (size_t)672 * 1024 + (size_t)i * 8) = z;
      for (int i = gt; i < 16 * 32 * QL / 8; i += ngt) { const int e = i * 8, hh = e / (32 * QL), rem = e % (32 * QL); *(u32x4*)(WSP(bf16_t, WS_WQT) + ((size_t)hh * 128 + 96) * QL + rem) = z; } }
}

__device__ __forceinline__ void ph_scan1(const Params& p) {
    const int lane = otid() & 63, gw = blockIdx.x * 8 + (otid() >> 6), ngw = gridDim.x * 8;
    const unsigned* sf = WSP(const unsigned, WS_SF); const unsigned* sb = WSP(const unsigned, WS_SB); float* sum = WSP(float, WS_SUM); float* gsum = sum + (size_t)2 * 1024 * 1024 * 2;
    for (int u = gw; u < 2 * 16 * 8 * 8; u += ngw) {
        const int dir = u >> 10, r = u & 1023, b = r >> 6, grp = (r >> 3) & 7, cg = r & 7, c = cg * 128 + lane * 2;
        float GA0 = 1.f, GA1 = 1.f, GH0 = 0.f, GH1 = 0.f;
        const unsigned* sdir = (dir ? sb : sf) + sf_tile_base(b * 8 + grp, c);
        u32x2 wa[16], wb2[16];
#define SC1_ROW(i) (dir ? (255 - (i)) : (i))
#define SC1_SCAN(W) do { _Pragma("unroll") for (int t = 0; t < 16; ++t) { const u32x2 x = W[t]; \
            const float a0 = 1.f - __uint_as_float(x[0] << 16), x0 = __uint_as_float(x[0] & 0xffff0000u), a1 = 1.f - __uint_as_float(x[1] << 16), x1 = __uint_as_float(x[1] & 0xffff0000u); \
            H0 = a0 * H0 + x0; A0 *= a0; H1 = a1 * H1 + x1; A1 *= a1; } } while (0)
#pragma unroll
        for (int t = 0; t < 16; ++t) wa[t] = *(const u32x2*)(sdir + (size_t)SC1_ROW(t) * 64);
#pragma unroll 1
        for (int k = 0; k < 8; ++k) {
            float A0 = 1.f, A1 = 1.f, H0 = 0.f, H1 = 0.f;
#pragma unroll
            for (int t = 0; t < 16; ++t) wb2[t] = *(const u32x2*)(sdir + (size_t)SC1_ROW(k * 32 + 16 + t) * 64);
            SC1_SCAN(wa);
            if (k + 1 < 8) {
#pragma unroll
                for (int t = 0; t < 16; ++t) wa[t] = *(const u32x2*)(sdir + (size_t)SC1_ROW(k * 32 + 32 + t) * 64); }
            SC1_SCAN(wb2);
            const int run = grp * 8 + (dir ? 7 - k : k);
            f32x4 o = {A0, H0, A1, H1};
            *(f32x4*)(sum + (((size_t)dir * 1024 + b * 64 + run) * 1024 + c) * 2) = o;
            GH0 = A0 * GH0 + H0; GA0 *= A0; GH1 = A1 * GH1 + H1; GA1 *= A1; }
#undef SC1_ROW
#undef SC1_SCAN
        f32x4 go = {GA0, GH0, GA1, GH1};
        *(f32x4*)(gsum + (((size_t)dir * 128 + b * 8 + grp) * 1024 + c) * 2) = go;
    }
}
__device__ __forceinline__ void ph_scan2(const Params& p) {
    const int lane = otid() & 63, gw = blockIdx.x * 8 + (otid() >> 6), ngw = gridDim.x * 8;
    const unsigned* sf = WSP(const unsigned, WS_SF); const unsigned* sb = WSP(const unsigned, WS_SB); const float* sum = WSP(const float, WS_SUM); const float* gsum = sum + (size_t)2 * 1024 * 1024 * 2;
    bf16_t* gy = WSP(bf16_t, WS_GG);
    for (int u = gw; u < 16 * 64 * 8; u += ngw) {
        const int b = u >> 9, run = (u >> 3) & 63, cg = u & 7, c = cg * 128 + lane * 2, grp = run >> 3, rin = run & 7;
        const size_t base = ((size_t)b * SQ + run * 32) * D + c;
        const size_t sbase = sf_tile_base(b * 8 + grp, c) + (size_t)(rin * 32) * 64;
        u32x2 wf[32];
#pragma unroll
        for (int t = 0; t < 32; ++t) wf[t] = __builtin_nontemporal_load((const u32x2*)(sf + sbase + (size_t)t * 64));
        float hf0 = 0.f, hf1 = 0.f, hb0 = 0.f, hb1 = 0.f;
        { f32x4 gq[7], rq[7];
#pragma unroll
          for (int q = 0; q < 7; ++q) { gq[q] = *(const f32x4*)(gsum + (((size_t)b * 8 + q) * 1024 + c) * 2); rq[q] = *(const f32x4*)(sum + (((size_t)b * 64 + grp * 8 + q) * 1024 + c) * 2); }
#pragma unroll
          for (int q = 0; q < 7; ++q) if (q < grp) { hf0 = gq[q][0] * hf0 + gq[q][1]; hf1 = gq[q][2] * hf1 + gq[q][3]; }
#pragma unroll
          for (int q = 0; q < 7; ++q) if (q < rin) { hf0 = rq[q][0] * hf0 + rq[q][1]; hf1 = rq[q][2] * hf1 + rq[q][3]; } }
        { f32x4 gq[7], rq[7];
#pragma unroll
          for (int q = 0; q < 7; ++q) { gq[q] = *(const f32x4*)(gsum + (((size_t)128 + b * 8 + 7 - q) * 1024 + c) * 2); rq[q] = *(const f32x4*)(sum + (((size_t)1024 + b * 64 + grp * 8 + 7 - q) * 1024 + c) * 2); }
#pragma unroll
          for (int q = 0; q < 7; ++q) if (7 - q > grp) { hb0 = gq[q][0] * hb0 + gq[q][1]; hb1 = gq[q][2] * hb1 + gq[q][3]; }
#pragma unroll
          for (int q = 0; q < 7; ++q) if (7 - q > rin) { hb0 = rq[q][0] * hb0 + rq[q][1]; hb1 = rq[q][2] * hb1 + rq[q][3]; } }
        u32x2 wb[32];
#pragma unroll
        for (int t = 0; t < 32; ++t) wb[t] = __builtin_nontemporal_load((const u32x2*)(sb + sbase + (size_t)t * 64));
        unsigned fp[32];
#pragma unroll
        for (int t = 0; t < 32; ++t) { hf0 = (1.f - __uint_as_float(wf[t][0] << 16)) * hf0 + __uint_as_float(wf[t][0] & 0xffff0000u); hf1 = (1.f - __uint_as_float(wf[t][1] << 16)) * hf1 + __uint_as_float(wf[t][1] & 0xffff0000u); fp[t] = pk2(hf0, hf1); }
        unsigned g[32];
#pragma unroll
        for (int t = 0; t < 32; ++t) g[t] = __builtin_nontemporal_load((const unsigned*)(gy + base + (size_t)t * D));
#pragma unroll
        for (int tt = 0; tt < 32; ++tt) { const int t = 31 - tt;
            hb0 = (1.f - __uint_as_float(wb[t][0] << 16)) * hb0 + __uint_as_float(wb[t][0] & 0xffff0000u); hb1 = (1.f - __uint_as_float(wb[t][1] << 16)) * hb1 + __uint_as_float(wb[t][1] & 0xffff0000u);
            const float y0 = __uint_as_float(g[t] << 16) * (__uint_as_float(fp[t] << 16) + hb0), y1 = __uint_as_float(g[t] & 0xffff0000u) * (__uint_as_float(fp[t] & 0xffff0000u) + hb1);
            if (RNN_FP8) *(unsigned short*)(WSP(unsigned char, WS_YF) + base + (size_t)t * D) = (unsigned short)pk4_fp8_(y0 * F8_SY, y1 * F8_SY, 0.f, 0.f);
            else *(unsigned*)(gy + base + (size_t)t * D) = pk2(y0, y1); }
    }
}

__device__ __forceinline__ void ph_router_opt(const Params& p, int layer, const bf16_t* xin, LAS unsigned char* ldsb) {
    const int tid = otid(), lane = tid & 63, wave = __builtin_amdgcn_readfirstlane(tid >> 6);
    constexpr int RT_STR = 1032, RT_LO = 16 * RT_STR * 2, RT_PART = 66560;
    LAS float* part = (LAS float*)(ldsb + RT_PART);
    LAS int* rinfo = (LAS int*)(ldsb + RT_PART + 16384);
    LAS int* lcnt = rinfo + 512;
    const float* g = IN_F(4) + layer * D; const float* mod = WSP(float, WS_MOD) + (size_t)layer * 16 * 6144;
    const float* wr = IN_F(29); const float* rb = IN_F(30);
    bf16_t* h2 = WSP(bf16_t, WS_H2);
    int* re = WSP(int, WS_RTE); int* rp = re + T * 2; float* rw = (float*)(rp + T * 2);
    int* tok = WSP(int, WS_TOK); int* dstp = WSP(int, WS_DST); float* wso = WSP(float, WS_WSO);
    unsigned* cnt = WSP(unsigned, WS_CTL) + CW_CNT + layer * 32;
    bf16x8 wq[4][2][3];
#pragma unroll
    for (int t = 0; t < 4; ++t)
#pragma unroll
        for (int cb = 0; cb < 2; ++cb) { float w8[8];
#pragma unroll
            for (int j = 0; j < 8; ++j) w8[j] = wr[(size_t)(wave * 128 + 32 * t + 8 * (lane >> 4) + j) * 32 + cb * 16 + (lane & 15)];
            u32x4 t0, t1, t2;
#pragma unroll
            for (int q = 0; q < 4; ++q) { const float x0 = w8[2 * q], x1 = w8[2 * q + 1];
                const unsigned a = g8::cvt_pk_bf16(x0, x1); const float r0 = x0 - __uint_as_float(a << 16), r1 = x1 - __uint_as_float(a & 0xffff0000u);
                const unsigned b = g8::cvt_pk_bf16(r0, r1); const float q0 = r0 - __uint_as_float(b << 16), q1 = r1 - __uint_as_float(b & 0xffff0000u);
                t0[q] = a; t1[q] = b; t2[q] = g8::cvt_pk_bf16(q0, q1); }
            wq[t][cb][0] = __builtin_bit_cast(bf16x8, t0); wq[t][cb][1] = __builtin_bit_cast(bf16x8, t1); wq[t][cb][2] = __builtin_bit_cast(bf16x8, t2); }
    const float bias_e = rb[tid & 31];
    for (int batch = blockIdx.x; batch < T / 128; batch += gridDim.x) {
        if (tid < 64) lcnt[tid] = 0;
        u32x2 raw[2][4];
#pragma unroll
        for (int q = 0; q < 2; ++q)
#pragma unroll
            for (int j = 0; j < 4; ++j) raw[q][j] = *(const u32x2*)(xin + (size_t)(batch * 128 + wave * 2 + q) * D + j * 256 + lane * 4);
        float gm_[16], sh_[16];
        { const float* mb = mod + (size_t)((batch * 128) >> 11) * 6144;
#pragma unroll
          for (int j = 0; j < 4; ++j) { const int c0 = j * 256 + lane * 4; const f32x4 gg = *(const f32x4*)(g + c0), s1 = *(const f32x4*)(mb + 4096 + c0), s0 = *(const f32x4*)(mb + 3072 + c0);
#pragma unroll
              for (int i = 0; i < 4; ++i) { gm_[4 * j + i] = gg[i] * (1.f + s1[i]); sh_[4 * j + i] = s0[i]; } } }
        for (int gi = 0; gi < 8; ++gi) {
            const int row0 = batch * 128 + gi * 16;
#pragma unroll
            for (int q = 0; q < 2; ++q) { const int rl = wave * 2 + q, row = row0 + rl, b = row >> 11; float v[16];
#pragma unroll
                for (int j = 0; j < 4; ++j) { const u32x2 x = raw[q][j];
                    v[4 * j] = __uint_as_float(x[0] << 16); v[4 * j + 1] = __uint_as_float(x[0] & 0xffff0000u); v[4 * j + 2] = __uint_as_float(x[1] << 16); v[4 * j + 3] = __uint_as_float(x[1] & 0xffff0000u); }
                if (gi + 1 < 8) {
#pragma unroll
                    for (int j = 0; j < 4; ++j) raw[q][j] = *(const u32x2*)(xin + (size_t)(row + 16) * D + j * 256 + lane * 4); }
                { float s = 0.f;
#pragma unroll
                  for (int i = 0; i < 16; ++i) s += v[i] * v[i];
                  const float rstd = rsqrtf(wave_sum(s) * (1.f / 1024.f) + EPS);
#pragma unroll
                  for (int i = 0; i < 16; ++i) v[i] = v[i] * rstd * gm_[i] + sh_[i]; }
                if (layer == 1 ? MOE1_FP8 : MOE0_FP8) {
#pragma unroll
                    for (int j = 0; j < 4; ++j) *(unsigned*)(WSP(unsigned char, WS_H2F) + (size_t)row * D + j * 256 + lane * 4) = g8::pk4_fp8(v[4 * j] * F8_SH, v[4 * j + 1] * F8_SH, v[4 * j + 2] * F8_SH, v[4 * j + 3] * F8_SH); }
                else row_store_bf16(h2 + (size_t)row * D, lane, v);
#pragma unroll
                for (int j = 0; j < 4; ++j) { typedef float f32x2 __attribute__((ext_vector_type(2)));
                    const unsigned ha = g8::cvt_pk_bf16(v[4 * j], v[4 * j + 1]), hb2 = g8::cvt_pk_bf16(v[4 * j + 2], v[4 * j + 3]);
                    const unsigned la = g8::cvt_pk_bf16(v[4 * j] - __uint_as_float(ha << 16), v[4 * j + 1] - __uint_as_float(ha & 0xffff0000u)), lb2 = g8::cvt_pk_bf16(v[4 * j + 2] - __uint_as_float(hb2 << 16), v[4 * j + 3] - __uint_as_float(hb2 & 0xffff0000u));
                    *(LAS u32x2*)(ldsb + (rl * RT_STR + j * 256 + lane * 4) * 2) = (u32x2){ha, hb2}; *(LAS u32x2*)(ldsb + RT_LO + (rl * RT_STR + j * 256 + lane * 4) * 2) = (u32x2){la, lb2}; } }
            __syncthreads();
            { f32x4 a0 = {0.f, 0.f, 0.f, 0.f}, a1 = {0.f, 0.f, 0.f, 0.f}; const LAS unsigned char* hp = ldsb + ((lane & 15) * RT_STR + wave * 128 + (lane >> 4) * 8) * 2;
#pragma unroll
              for (int t = 0; t < 4; ++t) { const bf16x8 ah = *(const LAS bf16x8*)(hp + t * 64), al = *(const LAS bf16x8*)(hp + RT_LO + t * 64);
                  a0 = __builtin_amdgcn_mfma_f32_16x16x32_bf16(al, wq[t][0][1], a0, 0, 0, 0); a1 = __builtin_amdgcn_mfma_f32_16x16x32_bf16(al, wq[t][1][1], a1, 0, 0, 0);
                  a0 = __builtin_amdgcn_mfma_f32_16x16x32_bf16(ah, wq[t][0][2], a0, 0, 0, 0); a1 = __builtin_amdgcn_mfma_f32_16x16x32_bf16(ah, wq[t][1][2], a1, 0, 0, 0);
                  a0 = __builtin_amdgcn_mfma_f32_16x16x32_bf16(al, wq[t][0][0], a0, 0, 0, 0); a1 = __builtin_amdgcn_mfma_f32_16x16x32_bf16(al, wq[t][1][0], a1, 0, 0, 0);
                  a0 = __builtin_amdgcn_mfma_f32_16x16x32_bf16(ah, wq[t][0][1], a0, 0, 0, 0); a1 = __builtin_amdgcn_mfma_f32_16x16x32_bf16(ah, wq[t][1][1], a1, 0, 0, 0);
                  a0 = __builtin_amdgcn_mfma_f32_16x16x32_bf16(ah, wq[t][0][0], a0, 0, 0, 0); a1 = __builtin_amdgcn_mfma_f32_16x16x32_bf16(ah, wq[t][1][0], a1, 0, 0, 0); }
#pragma unroll
              for (int r = 0; r < 4; ++r) { part[(wave * 16 + 4 * (lane >> 4) + r) * 32 + (lane & 15)] = a0[r]; part[(wave * 16 + 4 * (lane >> 4) + r) * 32 + 16 + (lane & 15)] = a1[r]; } }
            __syncthreads();
            { const int rl = tid >> 5, e = tid & 31; float lg = 0.f;
#pragma unroll
              for (int w_ = 0; w_ < 8; ++w_) lg += part[(w_ * 16 + rl) * 32 + e];
              const float sc = 1.f / (1.f + expf(-lg)), bi = sc + bias_e;
              float bq[4], tq[4];
#pragma unroll
              for (int k = 0; k < 4; ++k) { bq[k] = __shfl(bi, (lane & ~3) + k); tq[k] = __shfl(sc, (lane & ~3) + k); }
              int i1 = 0; float v1 = bq[0], t1 = tq[0];
#pragma unroll
              for (int i = 1; i < 4; ++i) if (bq[i] > v1) { v1 = bq[i]; t1 = tq[i]; i1 = i; }
              int i2 = -1; float v2 = -INFINITY, t2 = 0.f;
#pragma unroll
              for (int i = 0; i < 4; ++i) if (i != i1 && bq[i] > v2) { v2 = bq[i]; t2 = tq[i]; i2 = i; }
              float gs = v1 + v2; int gq = e >> 2; int ee = ((4 * gq + i1) << 8) | (4 * gq + i2);
#pragma unroll
              for (int o = 4; o < 32; o <<= 1) { const float pgs = __shfl_xor(gs, o); const int pgq = __shfl_xor(gq, o), pee = __shfl_xor(ee, o); const float pt1 = __shfl_xor(t1, o), pt2 = __shfl_xor(t2, o);
                  if (pgs > gs || (pgs == gs && pgq < gq)) { gs = pgs; gq = pgq; ee = pee; t1 = pt1; t2 = pt2; } }
              if (e == 0) { const float inv = 1.f / (t1 + t2); LAS int* ri = rinfo + (gi * 16 + rl) * 4; ri[0] = ee >> 8; ri[1] = ee & 255; ri[2] = __float_as_int(t1 * inv); ri[3] = __float_as_int(t2 * inv); } }
        }
        __syncthreads();
        int e1 = 0, e2 = 0, r1 = 0, r2 = 0; float w1 = 0.f, w2 = 0.f;
        if (tid < 128) { e1 = rinfo[tid * 4]; e2 = rinfo[tid * 4 + 1]; w1 = __int_as_float(rinfo[tid * 4 + 2]); w2 = __int_as_float(rinfo[tid * 4 + 3]);
            r1 = __hip_atomic_fetch_add(lcnt + e1, 1, __ATOMIC_RELAXED, __HIP_MEMORY_SCOPE_WORKGROUP); r2 = __hip_atomic_fetch_add(lcnt + e2, 1, __ATOMIC_RELAXED, __HIP_MEMORY_SCOPE_WORKGROUP); }
        __syncthreads();
        if (tid < 32) lcnt[32 + tid] = (int)atomicAdd(cnt + tid, (unsigned)lcnt[tid]);
        __syncthreads();
        if (tid < 128) { const int row = batch * 128 + tid; const int p1 = lcnt[32 + e1] + r1, p2 = lcnt[32 + e2] + r2;
            re[row * 2] = e1; re[row * 2 + 1] = e2; rp[row * 2] = p1; rp[row * 2 + 1] = p2; rw[row * 2] = w1; rw[row * 2 + 1] = w2;
            tok[(size_t)e1 * T + p1] = row; tok[(size_t)e2 * T + p2] = row; dstp[(size_t)e1 * T + p1] = row * 2; dstp[(size_t)e2 * T + p2] = row * 2 + 1; wso[(size_t)e1 * T + p1] = w1; wso[(size_t)e2 * T + p2] = w2; }
        __syncthreads();
    }
}

#define XB_TMO      128
#define XB_XCNT(j)  (256  + 64 * (j))
#define XB_XSUB(j)  (1280 + 64 * (j))
#define XB_XGEN(j)  (2304 + 64 * (j))
#define XB_TOP      3328
#define XB_TOPGEN   3392
#define XCD_BAR_WORDS 3456
#define XB_SPIN_CAP (1u << 22)
__device__ __forceinline__ unsigned xb_ld(unsigned* p)              { return __hip_atomic_load(p, __ATOMIC_RELAXED, __HIP_MEMORY_SCOPE_AGENT); }
__device__ __forceinline__ unsigned xb_add(unsigned* p, unsigned v) { return __hip_atomic_fetch_add(p, v, __ATOMIC_RELAXED, __HIP_MEMORY_SCOPE_AGENT); }
__device__ __forceinline__ unsigned xb_xcc_id() { return (unsigned)__builtin_amdgcn_s_getreg((3 << 11) | 20) & 0xFu; }
#define XB_SPIN(cond, bar) do { unsigned _sp = 0; while (cond) { __builtin_amdgcn_s_sleep(1); \
    if ((++_sp & 255u) == 0u) { if (xb_ld(&(bar)[XB_TMO])) break; if (_sp > XB_SPIN_CAP) { atomicAdd(&(bar)[XB_TMO], 1u); break; } } } } while (0)
struct XcdBarrier { unsigned* bar; unsigned x; volatile LAS unsigned* st; };
__device__ __forceinline__ XcdBarrier xcd_barrier_post(unsigned* bar, volatile LAS unsigned* st) {
    XcdBarrier b; b.bar = bar; b.x = xb_xcc_id(); b.st = st;
    if (otid() == 0) (void)xb_add(&bar[XB_XCNT(b.x)], 1u);
    return b;
}
__device__ __forceinline__ void xcd_barrier_complete(unsigned* bar, unsigned x, unsigned& nloc, unsigned& nx) {
    const unsigned G = gridDim.x * gridDim.y * gridDim.z;
    unsigned sum, cnt, mine, sp = 0u;
    for (;;) {
        sum = 0u; cnt = 0u; mine = 0u;
#pragma unroll
        for (unsigned j = 0; j < 16; ++j) { const unsigned c = xb_ld(&bar[XB_XCNT(j)]); sum += c; cnt += (c > 0u) ? 1u : 0u; mine = (j == x) ? c : mine; }
        if (sum == G) break;
        __builtin_amdgcn_s_sleep(1);
        if ((++sp & 255u) == 0u) { if (xb_ld(&bar[XB_TMO])) break; if (sp > XB_SPIN_CAP) { atomicAdd(&bar[XB_TMO], 1u); break; } }
    }
    nloc = mine > 0u ? mine : 1u; nx = cnt > 0u ? cnt : 1u;
}
__device__ __forceinline__ void xcd_barrier(const XcdBarrier& b) {
    asm volatile("s_waitcnt vmcnt(0)" ::: "memory");
    __syncthreads();
    if (otid() == 0) {
        unsigned* bar = b.bar;
        __builtin_amdgcn_s_waitcnt(0);
        unsigned nloc = b.st[0], nx = b.st[1];
        if (nloc == 0u) { xcd_barrier_complete(bar, b.x, nloc, nx); b.st[0] = nloc; b.st[1] = nx; }
        const unsigned old = xb_add(&bar[XB_XSUB(b.x)], 1u);
        const unsigned gen = old / nloc;
        if (old + 1u == (gen + 1u) * nloc) {
            __builtin_amdgcn_fence(__ATOMIC_RELEASE, "agent");
            asm volatile("s_waitcnt vmcnt(0)" ::: "memory");
            const unsigned og = xb_add(&bar[XB_TOP], 1u);
            const unsigned tg = og / nx;
            if (og + 1u == (tg + 1u) * nx) xb_add(&bar[XB_TOPGEN], 1u);
            else XB_SPIN(xb_ld(&bar[XB_TOPGEN]) == tg, bar);
            __builtin_amdgcn_fence(__ATOMIC_ACQUIRE, "agent");
            xb_add(&bar[XB_XGEN(b.x)], 1u);
            asm volatile("s_waitcnt vmcnt(0)" ::: "memory");
        } else {
            XB_SPIN(xb_ld(&bar[XB_XGEN(b.x)]) == gen, bar);
            __builtin_amdgcn_fence(__ATOMIC_ACQUIRE, "agent");
            asm volatile("s_waitcnt vmcnt(0)" ::: "memory");
        }
    }
    __syncthreads();
}

enum { PH_PRO = 0, PH_NORM0, PH_LAT, PH_QKV, PH_ATTN, PH_WO, PH_ROUTE0, PH_GU0, PH_DN0, PH_COMB0, PH_RIN, PH_CONV, PH_GATE, PH_SCAN, PH_SCAN2, PH_RO, PH_ROUTE1, PH_GU1, PH_DN1, PH_COMB1, PH_COUNT };
constexpr int LDS_PHASE = 131072;
constexpr int LDS_XTRA = 131072;
constexpr int LDS_BYTES = 147456;
constexpr int CW_BAR = 4096;
constexpr bool OPT_RES = true, OPT_RIN = true, OPT_MOE = true, OPT_MLA = true, OPT_ATT = true, OPT_RNN = true, OPT_RTE = true;

template <int PH> __device__ __forceinline__ void run_phase(const Params& p, float* lds) {
    LAS unsigned char* ldsb = (LAS unsigned char*)lds;
    LAS int* tab = (LAS int*)(ldsb + LDS_XTRA);
    const int G = gridDim.x, c = blockIdx.x, vc = (G % 8 == 0) ? (c % 8) * (G / 8) + c / 8 : c;
    if constexpr (PH == PH_PRO) { ph_prologue(p, lds); __syncthreads(); ph_convert(p, (LAS float*)lds); }
    else if constexpr (PH == PH_NORM0) ph_norm0(p);
    else if constexpr (PH == PH_LAT) {
        if constexpr (OPT_MLA) { g8::DenseSched S; S.init(WSP(const bf16_t, WS_HB), 1024, WSP(const bf16_t, WS_W1T), 1024, T, 768);
            g8::EpiLat E{WSP(bf16_t, WS_LAT), WSP(float, WS_SSQP), WSP(float, WS_ROPEK), WSP(float, WS_PESSQ), WSP(const float, WS_COS), WSP(const float, WS_SIN), IN_F(13)};
            g8::gemm_phase<g8::EpiLat, g8::DenseSched, false>(ldsb, 1024 * 2, 1024 * 2, S, E); }
        else { FLat f{p}; rowgemm<1024, LATN>(f, lds); }
        if constexpr (MOE0_FP8 && MOE1_FP8) {
            const int idle0 = (G > 128 && G <= 384) ? 384 - G : 0, nb = G - idle0;
            __syncthreads();
            if (c >= idle0) conv_moe(p, (LAS float*)ldsb + (otid() >> 6) * (64 * 33), otid() & 63, (c - idle0) * 8 + (otid() >> 6), nb * 8, CONV_LATE0, CONV_LATE); } }
    else if constexpr (PH == PH_QKV) {
        if constexpr (OPT_MLA) {
            if constexpr (!QFUSE) { g8::DenseSched S; S.init(WSP(const bf16_t, WS_LAT), LATP, WSP(const bf16_t, WS_WQT), QL, T, 2048);
              g8::EpiQ E{ldsb, WSP(const float, WS_SSQP), IN_F(12), WSP(const float, WS_COS), WSP(const float, WS_SIN), WSP(bf16_t, WS_Q)};
              g8::gemm_phase<g8::EpiQ, g8::DenseSched, false>(ldsb, QL * 2, LATP * 2, S, E); }
            { g8::DenseSched S; S.init(WSP(const bf16_t, WS_LAT) + QL, LATP, WSP(const bf16_t, WS_WKVT), KVL, T, 2048);
              g8::EpiKV E{ldsb, WSP(const float, WS_SSQP), WSP(const float, WS_PESSQ), WSP(const float, WS_ROPEK), IN_F(13), WSP(bf16_t, WS_K), WSP(bf16_t, WS_V)};
              g8::gemm_phase<g8::EpiKV, g8::DenseSched, false>(ldsb, KVL * 2, LATP * 2, S, E); } }
        else { { FQ f{p}; rowgemm<QL, 1536>(f, lds); } __syncthreads(); { FKV f{p}; rowgemm<KVL, 2048>(f, lds); } } }
    else if constexpr (PH == PH_ATTN) { if constexpr (OPT_ATT) att::attn_phase(p, ldsb); else ph_attn(p, lds); }
    else if constexpr (PH == PH_WO) {
        if constexpr (OPT_RES) { g8::DenseSched S; S.init(WSP(const bf16_t, WS_O), 1024, WSP(const bf16_t, WS_WOT), 1024, T, 1024);
            g8::EpiRes<true> E{p.in[0], WSP(const float, WS_MOD) + 2048, WSP(bf16_t, WS_X1), 1.f}; g8::gemm_phase<g8::EpiRes<true>, g8::DenseSched, false>(ldsb, 1024 * 2, 1024 * 2, S, E); }
        else { FRes<true> f{p, WSP(const bf16_t, WS_O), IN_F(14), p.in[0], WSP(const float, WS_MOD) + 2048, WSP(bf16_t, WS_X1)}; rowgemm<1024, 1024>(f, lds); } }
    else if constexpr (PH == PH_ROUTE0) { if constexpr (OPT_RTE) ph_router_opt(p, 0, WSP(const bf16_t, WS_X1), ldsb); else ph_router(p, 0, WSP(const bf16_t, WS_X1)); }
    else if constexpr (PH == PH_GU0 || PH == PH_GU1) { constexpr int layer = (PH == PH_GU1);
        if constexpr (OPT_MOE) { g8::moe_tables(p, layer, tab);
            if constexpr (layer == 1 ? MOE1_FP8 : MOE0_FP8) {
                g8::MoeSched S{tab, (const char*)WSP(const unsigned char, WS_H2F), (const char*)WSP(const unsigned char, WS_WGU8) + (size_t)layer * 64 * MiB, WSP(const int, WS_TOK), 1024, 1024, G, vc, (size_t)1048576, true};
                if constexpr (DN1_FP8) { g8::EpiGu8 E{WSP(unsigned char, WS_ACT)}; g8::gemm_phase<g8::EpiGu8, g8::MoeSched, true, true>(ldsb, 1024, 1024, S, E);
                    if constexpr (layer == 0 && MOE0_FP8 && MOE1_FP8) conv_in_moe_tail(p, ldsb, tab, G, vc, CONV_LATEB, CONV_LATEBN); }
                else { g8::EpiGu E{WSP(bf16_t, WS_ACT), 1.f / (F8_SH * F8_SW)}; g8::gemm_phase<g8::EpiGu, g8::MoeSched, true, true>(ldsb, 1024, 1024, S, E); } }
            else { g8::MoeSched S{tab, (const char*)WSP(const bf16_t, WS_H2), (const char*)(WSP(const bf16_t, WS_WGU) + (size_t)layer * 32 * 1048576), WSP(const int, WS_TOK), 1024 * 2, 1024 * 2, G, vc, (size_t)1048576 * 2, true};
                g8::EpiGu E{WSP(bf16_t, WS_ACT), 1.f}; g8::gemm_phase<g8::EpiGu, g8::MoeSched, true>(ldsb, 1024 * 2, 1024 * 2, S, E); } }
        else { FGu f{p, layer}; rowgemm<1024, 1024>(f, lds); } }
    else if constexpr (PH == PH_DN0 || PH == PH_DN1) { constexpr int layer = (PH == PH_DN1);
        if constexpr (OPT_MOE) { g8::moe_tables(p, layer, tab);
            if constexpr (layer == 1 ? MOE1_FP8 : MOE0_FP8) {
                g8::MoeSched S{tab, (const char*)WSP(const unsigned char, WS_ACT), (const char*)WSP(const unsigned char, WS_WDN8) + (size_t)layer * 32 * MiB, WSP(const int, WS_TOK), 512, 512, G, vc, (size_t)524288, false};
                g8::EpiDnLite E{WSP(const int, WS_DST), WSP(const float, WS_WSO), WSP(bf16_t, WS_YS), 1.f / (F8_SA * F8_SW)};
                g8::gemm_phase<g8::EpiDnLite, g8::MoeSched, false, true>(ldsb, 512, 512, S, E);
                if constexpr (layer == 0 && MOE0_FP8 && MOE1_FP8 && DN1_FP8) conv_in_moe_tail(p, ldsb, tab, G, vc, CONV_LATEC, CONV_LATEBN); }
            else { g8::MoeSched S{tab, (const char*)WSP(const bf16_t, WS_ACT), (const char*)(WSP(const bf16_t, WS_WDN) + (size_t)layer * 32 * 524288), WSP(const int, WS_TOK), 512 * 2, 512 * 2, G, vc, (size_t)524288 * 2, false};
                g8::EpiDn E{WSP(const int, WS_DST), WSP(const float, WS_WSO), WSP(bf16_t, WS_YS), 1.f}; g8::gemm_phase<g8::EpiDn, g8::MoeSched, false>(ldsb, 512 * 2, 512 * 2, S, E); } }
        else { FDn f{p, layer}; rowgemm<512, 1024>(f, lds); } }
    else if constexpr (PH == PH_COMB0) ph_combine(p, 0, WSP(const bf16_t, WS_X1));
    else if constexpr (PH == PH_RIN) {
        if constexpr (OPT_RIN) {
            if constexpr (RNN_FP8) { g8::DenseSched S; S.init(WSP(const bf16_t, WS_HB), 512, WSP(const bf16_t, WS_WRINT), 512, T, 2048);
                g8::EpiRin E{WSP(bf16_t, WS_GG), WSP(bf16_t, WS_X1), 1.f / (F8_SH * F8_SW)}; g8::gemm_phase<g8::EpiRin, g8::DenseSched, false, true>(ldsb, 1024, 1024, S, E); }
            else { g8::DenseSched S; S.init(WSP(const bf16_t, WS_HB), 1024, WSP(const bf16_t, WS_WRINT), 1024, T, 2048);
                g8::EpiRin E{WSP(bf16_t, WS_GG), WSP(bf16_t, WS_X1), 1.f}; g8::gemm_phase<g8::EpiRin, g8::DenseSched, false>(ldsb, 1024 * 2, 1024 * 2, S, E); } }
        else { FRin f{p}; rowgemm<1024, 2048>(f, lds); } }
    else if constexpr (PH == PH_CONV) ph_conv(p);
    else if constexpr (PH == PH_GATE) {
        if constexpr (OPT_RNN) { g8::GateSched S{(const char*)WSP(const bf16_t, WS_H2), (const char*)WSP(const bf16_t, WS_WGT), G, vc};
            g8::EpiGate E{WSP(const bf16_t, WS_H2), IN_F(20), IN_F(22), IN_F(25), IN_F(27), WSP(const float, WS_SPL), WSP(unsigned, WS_SF), WSP(unsigned, WS_SB)};
            g8::gemm_phase<g8::EpiGate, g8::GateSched, false>(ldsb, 256 * 2, 1024 * 2, S, E); }
        else { FGate f{p}; rowgemm<256, 1024>(f, lds); } }
    else if constexpr (PH == PH_SCAN) { if constexpr (OPT_RNN) ph_scan1(p); else ph_scan(p); }
    else if constexpr (PH == PH_SCAN2) { if constexpr (OPT_RNN) ph_scan2(p); }
    else if constexpr (PH == PH_RO) {
        if constexpr (OPT_RES) {
            if constexpr (RNN_FP8) { g8::DenseSched S; S.init(WSP(const bf16_t, WS_YF), 512, WSP(const bf16_t, WS_WROT), 512, T, 1024);
                g8::EpiRes<false> E{WSP(const void, WS_X2), WSP(const float, WS_MOD) + 16 * 6144 + 2048, WSP(bf16_t, WS_X1), 1.f / (F8_SY * F8_SW)}; g8::gemm_phase<g8::EpiRes<false>, g8::DenseSched, false, true>(ldsb, 1024, 1024, S, E); }
            else { g8::DenseSched S; S.init(WSP(const bf16_t, WS_GG), 1024, WSP(const bf16_t, WS_WROT), 1024, T, 1024);
                g8::EpiRes<false> E{WSP(const void, WS_X2), WSP(const float, WS_MOD) + 16 * 6144 + 2048, WSP(bf16_t, WS_X1), 1.f}; g8::gemm_phase<g8::EpiRes<false>, g8::DenseSched, false>(ldsb, 1024 * 2, 1024 * 2, S, E); } }
        else { FRes<false> f{p, WSP(const bf16_t, WS_GG), IN_F(28), WSP(const void, WS_X2), WSP(const float, WS_MOD) + 16 * 6144 + 2048, WSP(bf16_t, WS_X1)}; rowgemm<1024, 1024>(f, lds); } }
    else if constexpr (PH == PH_ROUTE1) { if constexpr (OPT_RTE) ph_router_opt(p, 1, WSP(const bf16_t, WS_X1), ldsb); else ph_router(p, 1, WSP(const bf16_t, WS_X1)); }
    else if constexpr (PH == PH_COMB1) ph_combine(p, 1, WSP(const bf16_t, WS_X1));
}
#ifndef PROBE_MASK
#define PROBE_MASK 0u
#endif
template <int PH> __device__ __forceinline__ void run_from(const Params& p, float* lds, const XcdBarrier& bar) {
    run_phase<PH>(p, lds);
    if constexpr ((PROBE_MASK >> PH) & 1u) { xcd_barrier(bar); run_phase<PH>(p, lds); }
    if constexpr (PH + 1 < PH_COUNT) { xcd_barrier(bar); run_from<PH + 1>(p, lds, bar); }
}

__global__ void __launch_bounds__(512, 2) k_mega(Params p) {
    extern __shared__ __attribute__((aligned(16))) unsigned char lds_raw[];
    float* lds = (float*)lds_raw;
    volatile LAS unsigned* st = (volatile LAS unsigned*)((LAS unsigned char*)lds_raw + LDS_BYTES - 64);
    if (otid() == 0) { st[0] = 0u; st[1] = 0u; }
    __syncthreads();
    XcdBarrier bar = xcd_barrier_post(WSP(unsigned, WS_CTL) + CW_BAR, st);
    run_from<0>(p, lds, bar);
}

extern "C" void kernel_launch(void* const* d_in, const int* in_sizes, int n_in, void* d_out, int out_size, void* d_ws, size_t ws_size, hipStream_t stream) {
    if (n_in != 33 || ws_size < WS_END) { fprintf(stderr, "kernel_launch: unexpected n_in %d / ws_size %zu\n", n_in, ws_size); return; }
    static int grid = 0;
    if (grid == 0) {
        int dev = 0, cus = 0;
        if (hipGetDevice(&dev) != hipSuccess || hipDeviceGetAttribute(&cus, hipDeviceAttributeMultiprocessorCount, dev) != hipSuccess) { grid = -1; return; }
        if (hipFuncSetAttribute((const void*)k_mega, hipFuncAttributeMaxDynamicSharedMemorySize, LDS_BYTES) != hipSuccess) { grid = -1; return; }
        int nb = 0;
        if (hipOccupancyMaxActiveBlocksPerMultiprocessor(&nb, (const void*)k_mega, 512, LDS_BYTES) != hipSuccess || nb < 1) { grid = -1; return; }
        grid = cus;
    }
    if (grid < 0) return;
    Params p{};
    for (int i = 0; i < 33; ++i) p.in[i] = d_in[i];
    p.out = (float*)d_out; p.ws = (unsigned char*)d_ws;
    (void)hipMemsetAsync((char*)d_ws + WS_CTL, 0, 1 * MiB, stream);
    k_mega<<<dim3(grid), dim3(512), LDS_BYTES, stream>>>(p);
}
#ifdef PHASE_KERNELS
template <int PH> __global__ void __launch_bounds__(512, 2) k_one(Params p) {
    extern __shared__ __attribute__((aligned(16))) unsigned char lds_raw[];
    run_phase<PH>(p, (float*)lds_raw);
}
template __global__ void k_one<0>(Params); template __global__ void k_one<1>(Params); template __global__ void k_one<2>(Params); template __global__ void k_one<3>(Params);
template __global__ void k_one<4>(Params); template __global__ void k_one<5>(Params); template __global__ void k_one<6>(Params); template __global__ void k_one<7>(Params);
template __global__ void k_one<8>(Params); template __global__ void k_one<9>(Params); template __global__ void k_one<10>(Params); template __global__ void k_one<11>(Params);
template __global__ void k_one<12>(Params); template __global__ void k_one<13>(Params); template __global__ void k_one<14>(Params); template __global__ void k_one<15>(Params);
template __global__ void k_one<16>(Params); template __global__ void k_one<17>(Params); template __global__ void k_one<18>(Params); template __global__ void k_one<19>(Params);
#endif
```
